# Optimizing an MI355X kernel written in HIP

```python
import jax, jax.numpy as jnp
from jax import lax
import numpy as np

D_MODEL = 1024
BATCH = 4
SEQ = 8192
DEPTH = 1

MEM_LEN = 256
FOURIER_GROUPS = 4
FOURIER_GROUP_DIM = 128
FOURIER_W = FOURIER_GROUPS * FOURIER_GROUP_DIM
HGRN_HEADS = 4
HGRN_DK = 128
HGRN_DV = 128
HGRN_W = HGRN_HEADS * HGRN_DK
HGRN_CHUNK = 64
XATTN_HEADS = 4
XATTN_HEAD_DIM = 128
XATTN_W = XATTN_HEADS * XATTN_HEAD_DIM
N_BRANCHES = 3
N_IN = FOURIER_W + 5 * HGRN_W + XATTN_W + N_BRANCHES * D_MODEL
N_EXPERTS = 256
TOP_K = 8
N_GROUPS = 8
TOPK_GROUPS = 4
EXPERT_FF = 256
SHARED_FF = 256
ROUTED_SCALE = 2.5
MOE_BLOCK = 128
LN_EPS = 1e-5
DEEPNORM_ALPHA = (2 * DEPTH) ** 0.25
DEEPNORM_BETA = (8 * DEPTH) ** -0.25

kernel_name = "hybrid_fnet_hgrn2_memxattn_moe_deepnorm"


def layer_norm(x, g, b):
    xf = x.astype(jnp.float32)
    mu = jnp.mean(xf, axis=-1, keepdims=True)
    var = jnp.mean(jnp.square(xf - mu), axis=-1, keepdims=True)
    y = (xf - mu) * lax.rsqrt(var + LN_EPS) * g.astype(jnp.float32) + b.astype(jnp.float32)
    return y.astype(x.dtype)


def hgrn_lower_bounds(p):
    sm = jax.nn.softmax(p.astype(jnp.float32), axis=0)
    return jnp.cumsum(sm, axis=0)[:DEPTH]


def _heads(t, n_heads):
    b, s, w = t.shape
    return t.reshape(b, s, n_heads, w // n_heads).transpose(0, 2, 1, 3)


def fourier_mix(u):
    b, s, _ = u.shape
    ug = u.astype(jnp.float32).reshape(b, s, FOURIER_GROUPS, FOURIER_GROUP_DIM)
    z = jnp.fft.fft2(ug, axes=(1, 3), norm="ortho")
    return jnp.real(z).reshape(b, s, FOURIER_W).astype(u.dtype)


def hgrn2_chunkwise(q, k, v, log_f):
    b, h, s, dk = q.shape
    dv = v.shape[-1]
    c = HGRN_CHUNK
    n = s // c
    q, k, log_f = (t.reshape(b, h, n, c, dk) for t in (q, k, log_f))
    v = v.reshape(b, h, n, c, dv)
    a = jnp.cumsum(log_f, axis=3)
    a_end = a[:, :, :, -1:, :]
    q_dec = q * jnp.exp(a)
    k_inv = k * jnp.exp(-a)
    scores = jnp.einsum('bhntd,bhnsd->bhnts', q_dec, k_inv)
    mask = jnp.tril(jnp.ones((c, c), dtype=bool))
    scores = jnp.where(mask, scores, 0.0)
    o_intra = jnp.einsum('bhnts,bhnse->bhnte', scores, v)
    k_end = k * jnp.exp(a_end - a)
    chunk_update = jnp.einsum('bhnsd,bhnse->bhnde', k_end, v)
    chunk_decay = jnp.exp(a_end[:, :, :, 0, :])

    def step(state, inp):
        dec, upd = inp
        return dec[..., None] * state + upd, state

    init = jnp.zeros((b, h, dk, dv), q.dtype)
    _, starts = lax.scan(step, init, (jnp.moveaxis(chunk_decay, 2, 0), jnp.moveaxis(chunk_update, 2, 0)))
    starts = jnp.moveaxis(starts, 0, 2)
    o_inter = jnp.einsum('bhntd,bhnde->bhnte', q_dec, starts)
    return (o_intra + o_inter).reshape(b, h, s, dv)


def hgrn2_bidirectional(q_raw, i_raw, z_fwd, z_bwd, g_raw, lb_fwd, lb_bwd, norm_g):
    f32 = jnp.float32
    q = _heads(jax.nn.silu(q_raw.astype(f32)), HGRN_HEADS)
    v = _heads(i_raw.astype(f32), HGRN_HEADS)

    def forget(z, lb):
        f = lb + (1.0 - lb) * jax.nn.sigmoid(z.astype(f32))
        return _heads(1.0 - f, HGRN_HEADS), _heads(jnp.log(f), HGRN_HEADS)

    k_f, lf_f = forget(z_fwd, lb_fwd)
    k_b, lf_b = forget(z_bwd, lb_bwd)
    o_fwd = hgrn2_chunkwise(q, k_f, v, lf_f)
    rev = lambda t: jnp.flip(t, axis=2)
    o_bwd = rev(hgrn2_chunkwise(rev(q), rev(k_b), rev(v), rev(lf_b)))
    o = o_fwd + o_bwd
    o = o * lax.rsqrt(jnp.mean(o * o, axis=-1, keepdims=True) + LN_EPS) * norm_g.astype(f32).reshape(HGRN_HEADS, 1, HGRN_DV)
    b, h, s, dv = o.shape
    o = o.transpose(0, 2, 1, 3).reshape(b, s, h * dv)
    return (o * jax.nn.silu(g_raw.astype(f32))).astype(q_raw.dtype)


def memory_cross_attention(q_raw, mem_n, w_kv):
    b, s, _ = q_raw.shape
    m = mem_n.shape[1]
    q = q_raw.reshape(b, s, XATTN_HEADS, XATTN_HEAD_DIM)
    k, v = jnp.split(mem_n @ w_kv, 2, axis=-1)
    k = k.reshape(b, m, XATTN_HEADS, XATTN_HEAD_DIM)
    v = v.reshape(b, m, XATTN_HEADS, XATTN_HEAD_DIM)
    scores = jnp.einsum('bshd,bmhd->bhsm', q, k).astype(jnp.float32) * (XATTN_HEAD_DIM ** -0.5)
    p = jax.nn.softmax(scores, axis=-1).astype(v.dtype)
    return jnp.einsum('bhsm,bmhd->bshd', p, v).reshape(b, s, XATTN_W)


def route(x_flat, w_router, router_bias):
    t = x_flat.shape[0]
    affinity = jax.nn.sigmoid((x_flat @ w_router).astype(jnp.float32))
    sel = affinity + router_bias.astype(jnp.float32)
    grp = sel.reshape(t, N_GROUPS, N_EXPERTS // N_GROUPS)
    grp_score = jnp.sum(lax.top_k(grp, 2)[0], axis=-1)
    _, top_groups = lax.top_k(grp_score, TOPK_GROUPS)
    group_mask = jnp.any(top_groups[:, :, None] == jnp.arange(N_GROUPS)[None, None, :], axis=1)
    expert_mask = jnp.repeat(group_mask, N_EXPERTS // N_GROUPS, axis=1)
    sel = jnp.where(expert_mask, sel, -jnp.inf)
    _, expert_idx = lax.top_k(sel, TOP_K)
    w = jnp.take_along_axis(affinity, expert_idx, axis=1)
    w = w / jnp.sum(w, axis=-1, keepdims=True) * ROUTED_SCALE
    return expert_idx, w


def routed_experts(x_flat, expert_idx, gate_w, w_gate, w_up, w_down):
    t, d = x_flat.shape
    n_rows = t * TOP_K
    flat_e = expert_idx.reshape(-1)
    order = jnp.argsort(flat_e)
    sorted_e = flat_e[order]
    sorted_tok = (order // TOP_K).astype(jnp.int32)
    sorted_gate = gate_w.reshape(-1)[order].astype(x_flat.dtype)
    counts = jnp.bincount(flat_e, length=N_EXPERTS)
    padded = (counts + MOE_BLOCK - 1) // MOE_BLOCK * MOE_BLOCK
    start = jnp.cumsum(counts) - counts
    pend = jnp.cumsum(padded)
    pstart = pend - padded
    dest = pstart[sorted_e] + (jnp.arange(n_rows) - start[sorted_e])
    n_blocks = -(-n_rows // MOE_BLOCK) + N_EXPERTS
    r_pad = n_blocks * MOE_BLOCK
    row_tok = jnp.full((r_pad,), t, dtype=jnp.int32).at[dest].set(sorted_tok)
    row_gate = jnp.zeros((r_pad,), x_flat.dtype).at[dest].set(sorted_gate)
    block_start = jnp.arange(n_blocks) * MOE_BLOCK
    block_exp = jnp.minimum(jnp.searchsorted(pend, block_start, side='right'), N_EXPERTS - 1)
    x_pad = jnp.concatenate([x_flat, jnp.zeros((1, d), x_flat.dtype)], axis=0)

    def body(acc, blk):
        tok, g, e = blk
        xb = x_pad[tok]
        hb = jax.nn.silu(xb @ w_gate[e]) * (xb @ w_up[e])
        return acc.at[tok].add((hb @ w_down[e]) * g[:, None]), None

    acc0 = jnp.zeros((t + 1, d), x_flat.dtype)
    acc, _ = lax.scan(body, acc0, (row_tok.reshape(n_blocks, MOE_BLOCK), row_gate.reshape(n_blocks, MOE_BLOCK), block_exp))
    return acc[:t]


def setup_inputs(seed: int = 0) -> dict:
    key = jax.random.key(seed)
    ks = iter(jax.random.split(key, 40))
    L, D = DEPTH, D_MODEL

    def nrm(shape, scale):
        return jax.random.normal(next(ks), shape, jnp.float32) * scale

    return {
        "x": nrm((BATCH, SEQ, D), 1.0),
        "mem": nrm((BATCH, MEM_LEN, D), 1.0),
        "ln_in_g": 1.0 + nrm((D,), 0.02),
        "ln_in_b": nrm((D,), 0.02),
        "ln_mem_g": 1.0 + nrm((D,), 0.02),
        "ln_mem_b": nrm((D,), 0.02),
        "hgrn_lb_fwd": 1.0 + nrm((DEPTH + 1, HGRN_W), 0.1),
        "hgrn_lb_bwd": 1.0 + nrm((DEPTH + 1, HGRN_W), 0.1),
        "w_in": nrm((L, D, N_IN), D ** -0.5),
        "b_gate": nrm((L, N_BRANCHES * D), 0.02),
        "hgrn_norm_g": 1.0 + nrm((L, HGRN_W), 0.02),
        "w_mem_kv": nrm((L, D, 2 * XATTN_W), D ** -0.5),
        "w_fourier_o": nrm((L, FOURIER_W, D), FOURIER_W ** -0.5),
        "b_fourier_o": nrm((L, D), 0.02),
        "w_hgrn_o": nrm((L, HGRN_W, D), HGRN_W ** -0.5),
        "w_xattn_o": nrm((L, XATTN_W, D), XATTN_W ** -0.5),
        "w_out": nrm((L, D, D), DEEPNORM_BETA * D ** -0.5),
        "ln1_g": 1.0 + nrm((L, D), 0.02),
        "ln1_b": nrm((L, D), 0.02),
        "w_router": nrm((L, D, N_EXPERTS), D ** -0.5),
        "router_bias": nrm((L, N_EXPERTS), 0.01),
        "w_exp_gate": nrm((L, N_EXPERTS, D, EXPERT_FF), D ** -0.5),
        "w_exp_up": nrm((L, N_EXPERTS, D, EXPERT_FF), D ** -0.5),
        "w_exp_down": nrm((L, N_EXPERTS, EXPERT_FF, D), DEEPNORM_BETA * EXPERT_FF ** -0.5),
        "w_sh_gate": nrm((L, D, SHARED_FF), D ** -0.5),
        "w_sh_up": nrm((L, D, SHARED_FF), D ** -0.5),
        "w_sh_down": nrm((L, SHARED_FF, D), DEEPNORM_BETA * SHARED_FF ** -0.5),
        "ln2_g": 1.0 + nrm((L, D), 0.02),
        "ln2_b": nrm((L, D), 0.02),
    }


def reference(x, mem, ln_in_g, ln_in_b, ln_mem_g, ln_mem_b, hgrn_lb_fwd, hgrn_lb_bwd,
              w_in, b_gate, hgrn_norm_g, w_mem_kv, w_fourier_o, b_fourier_o, w_hgrn_o, w_xattn_o,
              w_out, ln1_g, ln1_b, w_router, router_bias, w_exp_gate, w_exp_up, w_exp_down,
              w_sh_gate, w_sh_up, w_sh_down, ln2_g, ln2_b):
    b, s, d = x.shape
    h = layer_norm(x, ln_in_g, ln_in_b)
    mem_n = layer_norm(mem, ln_mem_g, ln_mem_b)
    lb_fwd = hgrn_lower_bounds(hgrn_lb_fwd)
    lb_bwd = hgrn_lower_bounds(hgrn_lb_bwd)
    splits = [int(v) for v in np.cumsum([FOURIER_W, HGRN_W, HGRN_W, HGRN_W, HGRN_W, HGRN_W, XATTN_W])]

    for l in range(DEPTH):
        proj = h @ w_in[l]
        u_f, hq, hi, zf, zb, hg, xq, gate_logits = jnp.split(proj, splits, axis=-1)
        y_f = fourier_mix(u_f) @ w_fourier_o[l] + b_fourier_o[l]
        y_h = hgrn2_bidirectional(hq, hi, zf, zb, hg, lb_fwd[l], lb_bwd[l], hgrn_norm_g[l]) @ w_hgrn_o[l]
        y_x = memory_cross_attention(xq, mem_n, w_mem_kv[l]) @ w_xattn_o[l]
        g = jax.nn.sigmoid(gate_logits + b_gate[l]).reshape(b, s, N_BRANCHES, d)
        merged = g[:, :, 0, :] * y_f + g[:, :, 1, :] * y_h + g[:, :, 2, :] * y_x
        h = layer_norm(DEEPNORM_ALPHA * h + merged @ w_out[l], ln1_g[l], ln1_b[l])

        x_flat = h.reshape(b * s, d)
        expert_idx, gate_w = route(x_flat, w_router[l], router_bias[l])
        routed = routed_experts(x_flat, expert_idx, gate_w, w_exp_gate[l], w_exp_up[l], w_exp_down[l])
        shared = (jax.nn.silu(x_flat @ w_sh_gate[l]) * (x_flat @ w_sh_up[l])) @ w_sh_down[l]
        h = layer_norm(DEEPNORM_ALPHA * h + (routed + shared).reshape(b, s, d), ln2_g[l], ln2_b[l])

    return h
```

```cpp
#include <hip/hip_runtime.h>
#include <cstdio>
#include <cstdint>

#define GAS __attribute__((address_space(1)))
#define LAS __attribute__((address_space(3)))
typedef unsigned short bf16;
typedef unsigned v4u __attribute__((ext_vector_type(4)));
typedef unsigned v2u __attribute__((ext_vector_type(2)));
typedef float f32x4 __attribute__((ext_vector_type(4)));
typedef float f32x2 __attribute__((ext_vector_type(2)));
typedef short bf16x8 __attribute__((ext_vector_type(8)));
typedef short s16x4 __attribute__((ext_vector_type(4)));

constexpr int NB = 4, SEQ = 8192, D = 1024, T = NB * SEQ, MEM = 256;
constexpr int NPROJ = 7168;
constexpr int NE = 256, TOPK = 8, FF = 256;
constexpr float LN_EPS = 1e-5f;
constexpr float ALPHA = 1.189207115002721f;
constexpr int NWAVES = 8, NTHR = 512;
constexpr int SEG = 512, NSEG = SEQ / SEG, CH = 64;

constexpr size_t MiB = 1u << 20;
constexpr size_t WS_CTL = 0, CTL_ZERO_BYTES = 1 * MiB;
constexpr size_t WS_WIN = 1 * MiB;
constexpr size_t WS_WKV = 15 * MiB;
constexpr size_t WS_WFO = 17 * MiB;
constexpr size_t WS_WHO = 18 * MiB;
constexpr size_t WS_WXO = 19 * MiB;
constexpr size_t WS_WOUT = 20 * MiB;
constexpr size_t WS_WRS = 22 * MiB;
constexpr size_t WS_WSD = 24 * MiB;
constexpr size_t WS_A1 = 25 * MiB;
constexpr size_t WS_A3 = 26 * MiB;
constexpr size_t WS_MEMN = 30 * MiB;
constexpr size_t WS_EXPD = 32 * MiB;
constexpr size_t WS_H0 = 32 * MiB;
constexpr size_t WS_F = 96 * MiB;
constexpr size_t WS_Q = 160 * MiB;
constexpr size_t SEC_STRIDE = 32 * MiB;
constexpr size_t WS_S1 = 160 * MiB;
constexpr size_t WS_HACT = 160 * MiB;
constexpr size_t WS_GATES = 352 * MiB;
constexpr size_t WS_S2 = 320 * MiB;
constexpr size_t WS_ROUTE = 448 * MiB;
constexpr size_t WS_KV = 544 * MiB;
constexpr size_t WS_Y = 546 * MiB;
constexpr size_t WS_FM = 610 * MiB;
constexpr size_t WS_OLF = 642 * MiB, WS_OLB = 674 * MiB;
constexpr size_t WS_QSF = 706 * MiB, WS_QSB = 738 * MiB;
constexpr size_t WS_U = 770 * MiB;
constexpr size_t WS_DEC = 802 * MiB;
constexpr size_t WS_SST = 803 * MiB;
constexpr size_t WS_HO = 819 * MiB;
constexpr size_t WS_XO = 851 * MiB;
constexpr size_t WS_MERGED = 883 * MiB;
constexpr size_t WS_EXPGU = 512 * MiB;
constexpr size_t WS_H1 = 768 * MiB;
constexpr size_t WS_LOGIT = 832 * MiB;
constexpr size_t WS_HS = 864 * MiB;
constexpr size_t WS_YR = 512 * MiB;
constexpr size_t WS_END = 1024 * MiB;
constexpr size_t RT_EIDX = 0, RT_WGT = 1 * MiB, RT_POS = 2 * MiB, RT_ROWTOK = 3 * MiB, RT_ROWSLOT = 5 * MiB, RT_ROWGATE = 6 * MiB + 512 * 1024, RT_TRASH = 7 * MiB + 768 * 1024;
constexpr int RPAD_MAX = T * TOPK + NE * 255;
constexpr int CW_BAR = 4096;
constexpr int CW_CNT = 16384;

#define LDS_WAIT() asm volatile("s_waitcnt lgkmcnt(0)" ::: "memory")
#define VM_WAIT() asm volatile("s_waitcnt vmcnt(0)" ::: "memory")
typedef __bf16 bf16x2v __attribute__((ext_vector_type(2)));
__device__ __forceinline__ unsigned cvt_pk_bf16_c(float lo, float hi) { const f32x2 v = {lo, hi}; const bf16x2v b = __builtin_convertvector(v, bf16x2v); return __builtin_bit_cast(unsigned, b); }
__device__ __forceinline__ unsigned cvt_pk_bf16(float lo, float hi) { unsigned r; asm volatile("v_cvt_pk_bf16_f32 %0, %1, %2" : "=v"(r) : "v"(lo), "v"(hi)); return r; }
__device__ __forceinline__ float bflo(unsigned w) { return __uint_as_float(w << 16); }
__device__ __forceinline__ float bfhi(unsigned w) { return __uint_as_float(w & 0xffff0000u); }
__device__ __forceinline__ float bf2f(bf16 h) { return __uint_as_float(((unsigned)h) << 16); }
__device__ __forceinline__ bf16 f2bf(float f) { return (bf16)(cvt_pk_bf16(f, 0.f) & 0xffffu); }
__device__ __forceinline__ float sigmoidf_(float x) { return 1.0f / (1.0f + __expf(-x)); }
__device__ __forceinline__ float siluf_(float x) { return x / (1.0f + __expf(-x)); }
__device__ __forceinline__ float wave_sum(float v) {
#pragma unroll
    for (int o = 1; o < 64; o <<= 1) v += __shfl_xor(v, o);
    return v;
}

#define XB_TMO      128
#define XB_XCNT(j)  (256  + 64 * (j))
#define XB_XSUB(j)  (1280 + 64 * (j))
#define XB_XGEN(j)  (2304 + 64 * (j))
#define XB_TOP      3328
#define XB_TOPGEN   3392
#define XCD_BAR_WORDS 3456
#define XB_SPIN_CAP (1u << 22)
__device__ __forceinline__ unsigned xb_ld(unsigned* p)              { return __hip_atomic_load(p, __ATOMIC_RELAXED, __HIP_MEMORY_SCOPE_AGENT); }
__device__ __forceinline__ unsigned xb_add(unsigned* p, unsigned v) { return __hip_atomic_fetch_add(p, v, __ATOMIC_RELAXED, __HIP_MEMORY_SCOPE_AGENT); }
__device__ __forceinline__ unsigned xb_xcc_id() { return (unsigned)__builtin_amdgcn_s_getreg((3 << 11) | 20) & 0xFu; }
#define XB_SPIN(cond, bar) do { unsigned _sp = 0; while (cond) { __builtin_amdgcn_s_sleep(1); \
    if ((++_sp & 255u) == 0u) { if (xb_ld(&(bar)[XB_TMO])) break; if (_sp > XB_SPIN_CAP) { atomicAdd(&(bar)[XB_TMO], 1u); break; } } } } while (0)
struct XcdBarrier { unsigned* bar; unsigned x; volatile LAS unsigned* st; };
__device__ __forceinline__ XcdBarrier xcd_barrier_post(unsigned* bar, volatile LAS unsigned* st) {
    XcdBarrier b; b.bar = bar; b.x = xb_xcc_id(); b.st = st;
    if (threadIdx.x == 0) (void)xb_add(&bar[XB_XCNT(b.x)], 1u);
    return b;
}
__device__ __forceinline__ void xcd_barrier_complete(unsigned* bar, unsigned x, unsigned& nloc, unsigned& nx) {
    const unsigned G = gridDim.x * gridDim.y * gridDim.z;
    unsigned sum, cnt, mine, sp = 0u;
    for (;;) {
        sum = 0u; cnt = 0u; mine = 0u;
#pragma unroll
        for (unsigned j = 0; j < 16; ++j) { const unsigned c = xb_ld(&bar[XB_XCNT(j)]); sum += c; cnt += (c > 0u) ? 1u : 0u; mine = (j == x) ? c : mine; }
        if (sum == G) break;
        __builtin_amdgcn_s_sleep(1);
        if ((++sp & 255u) == 0u) { if (xb_ld(&bar[XB_TMO])) break; if (sp > XB_SPIN_CAP) { atomicAdd(&bar[XB_TMO], 1u); break; } }
    }
    nloc = mine > 0u ? mine : 1u; nx = cnt > 0u ? cnt : 1u;
}
__device__ __forceinline__ void xcd_barrier(const XcdBarrier& b) {
    asm volatile("s_waitcnt vmcnt(0)" ::: "memory");
    __syncthreads();
    if (threadIdx.x == 0) {
        unsigned* bar = b.bar;
        __builtin_amdgcn_s_waitcnt(0);
        unsigned nloc = b.st[0], nx = b.st[1];
        if (nloc == 0u) { xcd_barrier_complete(bar, b.x, nloc, nx); b.st[0] = nloc; b.st[1] = nx; }
        const unsigned old = xb_add(&bar[XB_XSUB(b.x)], 1u);
        const unsigned gen = old / nloc;
        if (old + 1u == (gen + 1u) * nloc) {
            __builtin_amdgcn_fence(__ATOMIC_RELEASE, "agent");
            asm volatile("s_waitcnt vmcnt(0)" ::: "memory");
            const unsigned og = xb_add(&bar[XB_TOP], 1u);
            const unsigned tg = og / nx;
            if (og + 1u == (tg + 1u) * nx) xb_add(&bar[XB_TOPGEN], 1u);
            else XB_SPIN(xb_ld(&bar[XB_TOPGEN]) == tg, bar);
            __builtin_amdgcn_fence(__ATOMIC_ACQUIRE, "agent");
            xb_add(&bar[XB_XGEN(b.x)], 1u);
            asm volatile("s_waitcnt vmcnt(0)" ::: "memory");
        } else {
            XB_SPIN(xb_ld(&bar[XB_XGEN(b.x)]) == gen, bar);
            __builtin_amdgcn_fence(__ATOMIC_ACQUIRE, "agent");
            asm volatile("s_waitcnt vmcnt(0)" ::: "memory");
        }
    }
    __syncthreads();
}

namespace pg8 {
constexpr int BM = 256, BK = 64, HALF = 128, HTB = HALF * BK * 2, STAGE_BYTES = 8 * HTB, NXCD = 8, WGM = 8;
__host__ __device__ __forceinline__ int lds_byte(int r, int c) { const int st = (r >> 4) * 2 + (c >> 5), rr = r & 15, cc = c & 31, ob = rr * 64 + cc * 2; return st * 1024 + (ob ^ (((ob >> 9) & 1) << 5)); }
__host__ __device__ __forceinline__ void stage_rc(int b, int& R, int& C) { const int st = b / 1024, sb = b % 1024, swz = sb ^ (((sb >> 9) & 1) << 5); R = (st >> 1) * 16 + swz / 64; C = (st & 1) * 32 + (swz % 64) / 2; }
__host__ __device__ __forceinline__ int perm32(int rho) { const int n = rho >> 4, i = rho & 15; return 8 * (i >> 2) + 4 * n + (i & 3); }
struct Unit { int pm, pn; };
struct Gemm { const bf16* A; const bf16* Bt; int K; };
struct StaticOrder {
    int nM, nN, nwg, G, c;
    __device__ void init(int M, int N, int G_, int c_) { nM = M / BM; nN = N / BM; nwg = nM * nN; G = G_; c = c_; }
    __device__ bool next(int i, Unit& u) const {
        const long L = (long)i * G + c; if (L >= nwg) return false;
        int wgid = (int)L; { const int q = nwg / NXCD, r = nwg % NXCD, xcd = wgid % NXCD, off = wgid / NXCD; wgid = (xcd < r ? xcd * (q + 1) : r * (q + 1) + (xcd - r) * q) + off; }
        const int nig = WGM * nN, gid = wgid / nig, fm = gid * WGM, gsz = (nM - fm) < WGM ? (nM - fm) : WGM;
        u.pm = fm + ((wgid % nig) % gsz); u.pn = (wgid % nig) / gsz; return true;
    }
};
template <int J> struct ExpertOrder {
    int nunits, G, c; const LAS unsigned short* te;
    __device__ bool next(int i, Unit& u) const {
        const int L = i * G + c; if (L >= nunits) return false;
        const int tau = L / J, j = L - tau * J; u.pm = tau; u.pn = (int)te[tau] * J + j; return true;
    }
};

template <class Epi, class Sched, bool GATHER>
__device__ __forceinline__ void gemm_phase(LAS unsigned char* lds, const Gemm g, const Sched& S, const Epi& E, const int* rowidx) {
    const int tid = threadIdx.x, wid = __builtin_amdgcn_readfirstlane(tid >> 6), lane = tid & 63, wr = wid >> 2, wc = wid & 3, fr = lane & 15, fq = lane >> 4;
    const int K = g.K, nt = K / BK;
    unsigned voffB[2], voffC[2][2];
    LAS v4u* gsl = (LAS v4u*)(lds + STAGE_BYTES + 8192) + tid;
    const size_t kstep = (size_t)(BK * 2);
    const size_t hstep = (size_t)HALF * K * 2;
    const size_t tstep = 2 * hstep;
#pragma unroll
    for (int i = 0; i < 2; ++i) { int R, C; stage_rc(tid * 16 + i * 8192, R, C); const int Rb = Epi::PERM ? ((R & ~31) + perm32(R & 31)) : R;
        voffB[i] = (unsigned)(Rb * K + C) * 2u; voffC[0][i] = (unsigned)(R * K + C) * 2u; voffC[1][i] = voffC[0][i] + (unsigned)hstep; }
    const unsigned ldsw = (unsigned)wid * 1024u;
    const int aoff = lds_byte(wr * 64 + fr, fq * 8), boff = lds_byte(wc * 32 + fr, fq * 8);
#define PG8_SA(b, h) (((b) * 2 + (h)) * HTB)
#define PG8_SB(b, h) ((4 + (b) * 2 + (h)) * HTB)
#define PG8_STAGE(bufoff, gbase, voff) do { const char* _gb = (const char*)(gbase); _Pragma("unroll") for (int _i = 0; _i < 2; ++_i) { unsigned _keep; \
        asm volatile("s_mov_b32 %0, m0\n\ts_mov_b32 m0, %3\n\ts_nop 0\n\tglobal_load_lds_dwordx4 %1, %2\n\ts_mov_b32 m0, %0" : "=&s"(_keep) : "v"((voff)[_i]), "s"(_gb), "s"((unsigned)(size_t)(lds + (bufoff) + ldsw + _i * 8192)) : "memory"); } } while (0)
#define PG8_LDA(dst, b, h) do { _Pragma("unroll") for (int m = 0; m < 4; ++m) _Pragma("unroll") for (int k = 0; k < 2; ++k) dst[m][k] = *(const LAS bf16x8*)(lds + PG8_SA(b, h) + aoff + m * 2048 + k * 1024); } while (0)
#define PG8_LDB(dst, b, h) do { _Pragma("unroll") for (int n = 0; n < 2; ++n) _Pragma("unroll") for (int k = 0; k < 2; ++k) dst[n][k] = *(const LAS bf16x8*)(lds + PG8_SB(b, h) + boff + n * 2048 + k * 1024); } while (0)
#define PG8_MMA(ai, bj, At, Bt) do { __builtin_amdgcn_s_setprio(1); _Pragma("unroll") for (int m = 0; m < 4; ++m) _Pragma("unroll") for (int n = 0; n < 2; ++n) _Pragma("unroll") for (int k = 0; k < 2; ++k) \
        acc[ai][bj][m][n] = __builtin_amdgcn_mfma_f32_16x16x32_bf16(Bt[n][k], At[m][k], acc[ai][bj][m][n], 0, 0, 0); __builtin_amdgcn_s_setprio(0); } while (0)
#define PG8_WAIT_V(n) asm volatile("s_waitcnt vmcnt(" #n ")" ::: "memory")
#define PG8_WAIT_L(n) asm volatile("s_waitcnt lgkmcnt(" #n ")" ::: "memory")
#define PG8_BAR __builtin_amdgcn_s_barrier()
#define PG8_SCHED __builtin_amdgcn_sched_barrier(0)
#define PG8_GSTORE(set, u) do { unsigned _v[2][2]; _Pragma("unroll") for (int _i = 0; _i < 2; ++_i) { int _R, _C; stage_rc(tid * 16 + _i * 8192, _R, _C); \
        _Pragma("unroll") for (int _h = 0; _h < 2; ++_h) _v[_h][_i] = ((unsigned)rowidx[(u).pm * BM + _h * HALF + _R] * (unsigned)K + (unsigned)_C) * 2u; } \
        gsl[(set) * 512] = (v4u){_v[0][0], _v[0][1], _v[1][0], _v[1][1]}; } while (0)
#define PG8_GRD(dst, h, set) unsigned dst[2]; do { if constexpr (GATHER) { const v2u _o = ((const LAS v2u*)(gsl + (set) * 512))[h]; dst[0] = _o.x; dst[1] = _o.y; } else { dst[0] = voffC[h][0]; dst[1] = voffC[h][1]; } } while (0)
    Unit cur, nxt; int ui = 0;
    if (!S.next(0, cur)) return;
    f32x4 acc[2][2][4][2];
#pragma unroll
    for (int a = 0; a < 2; ++a)
#pragma unroll
        for (int b = 0; b < 2; ++b)
#pragma unroll
            for (int m = 0; m < 4; ++m)
#pragma unroll
                for (int n = 0; n < 2; ++n) acc[a][b][m][n] = (f32x4){0.f, 0.f, 0.f, 0.f};
    bf16x8 At[4][2], B0[2][2], B1[2][2];
    const char* cA = GATHER ? (const char*)g.A : (const char*)g.A + (size_t)cur.pm * tstep; const char* cB = (const char*)g.Bt + (size_t)cur.pn * tstep;
    int par = 0;
    if constexpr (GATHER) { PG8_GSTORE(0, cur); }
    { PG8_GRD(p0, 0, 0); PG8_GRD(p1, 1, 0);
    PG8_STAGE(PG8_SB(0, 0), cB, voffB); PG8_STAGE(PG8_SB(0, 1), cB + hstep, voffB); PG8_STAGE(PG8_SA(0, 0), cA, p0); PG8_STAGE(PG8_SA(0, 1), cA, p1);
    if (wr == 1) PG8_BAR;
    PG8_WAIT_V(2); PG8_BAR;
    PG8_STAGE(PG8_SB(1, 0), cB + kstep, voffB); PG8_STAGE(PG8_SA(1, 0), cA + kstep, p0); PG8_STAGE(PG8_SB(1, 1), cB + hstep + kstep, voffB); }
    PG8_WAIT_V(6); PG8_BAR;
    for (;;) {
        const bool has_next = S.next(ui + 1, nxt);
        const char* nA = GATHER ? (const char*)g.A : (has_next ? (const char*)g.A + (size_t)nxt.pm * tstep : cA); const char* nB = has_next ? (const char*)g.Bt + (size_t)nxt.pn * tstep : cB;
        if constexpr (GATHER) { if (has_next) { PG8_GSTORE(par ^ 1, nxt); } else { gsl[(par ^ 1) * 512] = gsl[par * 512]; } }
        for (int t = 0; t < nt; t += 2) {
            const bool last = (t == nt - 2);
            const char* a1 = cA + (size_t)(t + 1) * kstep;
            const char* a2 = last ? nA : cA + (size_t)(t + 2) * kstep; const char* b2 = last ? nB : cB + (size_t)(t + 2) * kstep;
            const char* a3 = a2 + kstep; const char* b3 = b2 + kstep;
            const int s2 = (GATHER && last) ? (par ^ 1) : par;
            { PG8_GRD(o, 1, par); PG8_LDB(B0, 0, 0); PG8_LDB(B1, 0, 1); PG8_SCHED; PG8_LDA(At, 0, 0); PG8_STAGE(PG8_SA(1, 1), a1, o); }
            PG8_WAIT_V(8); PG8_WAIT_L(0); PG8_BAR; PG8_MMA(0, 0, At, B0); PG8_MMA(0, 1, At, B1); PG8_BAR; PG8_SCHED;
            { PG8_GRD(o, 0, s2); PG8_LDA(At, 0, 1); PG8_STAGE(PG8_SB(0, 0), b2, voffB); PG8_STAGE(PG8_SB(0, 1), b2 + hstep, voffB); PG8_STAGE(PG8_SA(0, 0), a2, o); }
            PG8_WAIT_V(8); PG8_WAIT_L(0); PG8_BAR; PG8_MMA(1, 0, At, B0); PG8_MMA(1, 1, At, B1); PG8_BAR; PG8_SCHED;
            { PG8_GRD(o, 1, s2); PG8_LDB(B0, 1, 0); PG8_LDB(B1, 1, 1); PG8_SCHED; PG8_LDA(At, 1, 0); PG8_STAGE(PG8_SA(0, 1), a2, o); }
            PG8_WAIT_V(8); PG8_WAIT_L(0); PG8_BAR; PG8_MMA(0, 0, At, B0); PG8_MMA(0, 1, At, B1); PG8_BAR; PG8_SCHED;
            { PG8_GRD(o, 0, s2); PG8_LDA(At, 1, 1); PG8_STAGE(PG8_SB(1, 0), b3, voffB); PG8_STAGE(PG8_SB(1, 1), b3 + hstep, voffB); PG8_STAGE(PG8_SA(1, 0), a3, o); }
            PG8_WAIT_V(8); PG8_WAIT_L(0); PG8_BAR; PG8_MMA(1, 0, At, B0); PG8_MMA(1, 1, At, B1); PG8_BAR; PG8_SCHED;
        }
        if (wr == 0) PG8_BAR;
        asm volatile("s_nop 15\n\ts_nop 15" ::: "memory");
        E(acc, cur, wr, wc, fr, fq);
        if (!has_next) break;
#pragma unroll
        for (int a = 0; a < 2; ++a)
#pragma unroll
            for (int b = 0; b < 2; ++b)
#pragma unroll
                for (int m = 0; m < 4; ++m)
#pragma unroll
                    for (int n = 0; n < 2; ++n) acc[a][b][m][n] = (f32x4){0.f, 0.f, 0.f, 0.f};
        cur = nxt; cA = nA; cB = nB; ++ui; par ^= 1;
        if (wr == 1) PG8_BAR;
    }
    PG8_WAIT_V(0);
    PG8_BAR;
#undef PG8_SA
#undef PG8_SB
#undef PG8_STAGE
#undef PG8_LDA
#undef PG8_LDB
#undef PG8_MMA
#undef PG8_WAIT_V
#undef PG8_WAIT_L
#undef PG8_BAR
#undef PG8_SCHED
#undef PG8_GSTORE
#undef PG8_GRD
}
}
using pg8::Unit;

typedef f32x4 AccT[2][2][4][2];
__device__ __forceinline__ v4u pack8(const f32x4 a, const f32x4 b) { v4u w; w.x = cvt_pk_bf16(a[0], a[1]); w.y = cvt_pk_bf16(a[2], a[3]); w.z = cvt_pk_bf16(b[0], b[1]); w.w = cvt_pk_bf16(b[2], b[3]); return w; }

struct EpiProj {
    static constexpr bool PERM = true;
    bf16* F; bf16* SEC; bf16* GATES; const float* bgate;
    __device__ __forceinline__ void operator()(const AccT& acc, const Unit& u, int wr, int wc, int fr, int fq) const {
        const int pn = u.pn; bf16* base; int ldc, colt, mode;
        if (pn < 4) { base = F; ldc = 1024; colt = pn * 256; mode = 0; }
        else if (pn < 16) { const int s = (pn - 4) >> 1; base = SEC + (size_t)s * (SEC_STRIDE / 2); ldc = 512; colt = ((pn - 4) & 1) * 256; mode = (s == 0 || s == 4) ? 1 : (s == 5 ? 3 : 0); }
        else { base = GATES; ldc = 3072; colt = (pn - 16) * 256; mode = 2; }
        const int row0 = u.pm * 256 + wr * 64 + fr, col0 = colt + wc * 32 + 8 * fq;
        f32x4 bv[2][2];
#pragma unroll
        for (int bj = 0; bj < 2; ++bj)
#pragma unroll
            for (int n = 0; n < 2; ++n) bv[bj][n] = (mode == 2) ? *(const f32x4*)(bgate + col0 + bj * 128 + 4 * n) : (f32x4){0.f, 0.f, 0.f, 0.f};
#pragma unroll
        for (int ai = 0; ai < 2; ++ai)
#pragma unroll
            for (int m = 0; m < 4; ++m) { bf16* rowp = base + (size_t)(row0 + ai * 128 + m * 16) * ldc + col0;
#pragma unroll
                for (int bj = 0; bj < 2; ++bj) { f32x4 v0 = acc[ai][bj][m][0] + bv[bj][0], v1 = acc[ai][bj][m][1] + bv[bj][1];
                    if (mode == 1) {
#pragma unroll
                        for (int j = 0; j < 4; ++j) { v0[j] = siluf_(v0[j]); v1[j] = siluf_(v1[j]); } }
                    else if (mode == 2) {
#pragma unroll
                        for (int j = 0; j < 4; ++j) { v0[j] = sigmoidf_(v0[j]); v1[j] = sigmoidf_(v1[j]); } }
                    else if (mode == 3) { v0 = v0 * 0.12751743f; v1 = v1 * 0.12751743f; }
                    *(v4u*)(rowp + bj * 128) = pack8(v0, v1); } }
    }
};
struct EpiPlain {
    static constexpr bool PERM = true;
    bf16* O; int ldc;
    __device__ __forceinline__ void operator()(const AccT& acc, const Unit& u, int wr, int wc, int fr, int fq) const {
        const int row0 = u.pm * 256 + wr * 64 + fr, col0 = u.pn * 256 + wc * 32 + 8 * fq;
#pragma unroll
        for (int ai = 0; ai < 2; ++ai)
#pragma unroll
            for (int m = 0; m < 4; ++m) { bf16* rowp = O + (size_t)(row0 + ai * 128 + m * 16) * ldc + col0;
#pragma unroll
                for (int bj = 0; bj < 2; ++bj) *(v4u*)(rowp + bj * 128) = pack8(acc[ai][bj][m][0], acc[ai][bj][m][1]); }
    }
};
struct EpiMerge {
    static constexpr bool PERM = true;
    bf16* M; const bf16* gates; const float* bias; int br; int first;
    __device__ __forceinline__ void operator()(const AccT& acc, const Unit& u, int wr, int wc, int fr, int fq) const {
        const int row0 = u.pm * 256 + wr * 64 + fr, col0 = u.pn * 256 + wc * 32 + 8 * fq;
        f32x4 bv[2][2];
#pragma unroll
        for (int bj = 0; bj < 2; ++bj)
#pragma unroll
            for (int n = 0; n < 2; ++n) bv[bj][n] = bias ? *(const f32x4*)(bias + col0 + bj * 128 + 4 * n) : (f32x4){0.f, 0.f, 0.f, 0.f};
#pragma unroll
        for (int ai = 0; ai < 2; ++ai)
#pragma unroll
            for (int m = 0; m < 4; ++m) { const size_t row = (size_t)(row0 + ai * 128 + m * 16);
#pragma unroll
                for (int bj = 0; bj < 2; ++bj) {
                    const v4u gw = *(const v4u*)(gates + row * 3072 + br * 1024 + col0 + bj * 128);
                    bf16* mp = M + row * 1024 + col0 + bj * 128;
                    v4u ow = (v4u){0u, 0u, 0u, 0u}; if (!first) ow = *(const v4u*)mp;
                    const f32x4 v0 = acc[ai][bj][m][0] + bv[bj][0], v1 = acc[ai][bj][m][1] + bv[bj][1];
                    f32x4 o0, o1;
                    o0[0] = bflo(ow.x) + bflo(gw.x) * v0[0]; o0[1] = bfhi(ow.x) + bfhi(gw.x) * v0[1]; o0[2] = bflo(ow.y) + bflo(gw.y) * v0[2]; o0[3] = bfhi(ow.y) + bfhi(gw.y) * v0[3];
                    o1[0] = bflo(ow.z) + bflo(gw.z) * v1[0]; o1[1] = bfhi(ow.z) + bfhi(gw.z) * v1[1]; o1[2] = bflo(ow.w) + bflo(gw.w) * v1[2]; o1[3] = bfhi(ow.w) + bfhi(gw.w) * v1[3];
                    *(v4u*)mp = pack8(o0, o1); } }
    }
};
struct EpiResid {
    static constexpr bool PERM = false;
    float* O; const bf16* R;
    __device__ __forceinline__ void operator()(const AccT& acc, const Unit& u, int wr, int wc, int fr, int fq) const {
        const int row0 = u.pm * 256 + wr * 64 + fr, col0 = u.pn * 256 + wc * 32 + 4 * fq;
#pragma unroll
        for (int ai = 0; ai < 2; ++ai)
#pragma unroll
            for (int m = 0; m < 4; ++m) { const size_t off = (size_t)(row0 + ai * 128 + m * 16) * 1024 + col0;
#pragma unroll
                for (int bj = 0; bj < 2; ++bj)
#pragma unroll
                    for (int n = 0; n < 2; ++n) { const v2u rw = *(const v2u*)(R + off + bj * 128 + n * 16);
                        f32x4 o = acc[ai][bj][m][n]; o[0] += ALPHA * bflo(rw.x); o[1] += ALPHA * bfhi(rw.x); o[2] += ALPHA * bflo(rw.y); o[3] += ALPHA * bfhi(rw.y);
                        *(f32x4*)(O + off + bj * 128 + n * 16) = o; } }
    }
};
struct EpiRouterShared {
    static constexpr bool PERM = true;
    float* L; bf16* HS;
    __device__ __forceinline__ void operator()(const AccT& acc, const Unit& u, int wr, int wc, int fr, int fq) const {
        const int row0 = u.pm * 256 + wr * 64 + fr, cl = wc * 32 + 8 * fq;
        if (u.pn == 0) {
#pragma unroll
            for (int ai = 0; ai < 2; ++ai)
#pragma unroll
                for (int m = 0; m < 4; ++m) { float* rowp = L + (size_t)(row0 + ai * 128 + m * 16) * 256 + cl;
#pragma unroll
                    for (int bj = 0; bj < 2; ++bj)
#pragma unroll
                        for (int n = 0; n < 2; ++n) *(f32x4*)(rowp + bj * 128 + 4 * n) = acc[ai][bj][m][n]; }
        } else {
            const int colt = (u.pn - 1) * 128;
#pragma unroll
            for (int ai = 0; ai < 2; ++ai)
#pragma unroll
                for (int m = 0; m < 4; ++m) { bf16* rowp = HS + (size_t)(row0 + ai * 128 + m * 16) * 256 + colt + cl;
                    f32x4 h0, h1;
#pragma unroll
                    for (int j = 0; j < 4; ++j) { h0[j] = siluf_(acc[ai][0][m][0][j]) * acc[ai][1][m][0][j]; h1[j] = siluf_(acc[ai][0][m][1][j]) * acc[ai][1][m][1][j]; }
                    *(v4u*)rowp = pack8(h0, h1); }
        }
    }
};
struct EpiExpGU {
    static constexpr bool PERM = true;
    bf16* H;
    __device__ __forceinline__ void operator()(const AccT& acc, const Unit& u, int wr, int wc, int fr, int fq) const {
        const int row0 = u.pm * 256 + wr * 64 + fr, col0 = (u.pn & 1) * 128 + wc * 32 + 8 * fq;
#pragma unroll
        for (int ai = 0; ai < 2; ++ai)
#pragma unroll
            for (int m = 0; m < 4; ++m) { bf16* rowp = H + (size_t)(row0 + ai * 128 + m * 16) * 256 + col0;
                f32x4 h0, h1;
#pragma unroll
                for (int j = 0; j < 4; ++j) { h0[j] = siluf_(acc[ai][0][m][0][j]) * acc[ai][1][m][0][j]; h1[j] = siluf_(acc[ai][0][m][1][j]) * acc[ai][1][m][1][j]; }
                *(v4u*)rowp = pack8(h0, h1); }
    }
};
struct EpiExpDown {
    static constexpr bool PERM = true;
    bf16* Y; const v2u* rowinfo; bf16* trash;
    __device__ __forceinline__ void operator()(const AccT& acc, const Unit& u, int wr, int wc, int fr, int fq) const {
        const int row0 = u.pm * 256 + wr * 64 + fr, col0 = (u.pn & 3) * 256 + wc * 32 + 8 * fq;
#pragma unroll
        for (int ai = 0; ai < 2; ++ai)
#pragma unroll
            for (int m = 0; m < 4; ++m) { const int r = row0 + ai * 128 + m * 16; const v2u ri = rowinfo[r]; const int slot = (int)ri.x; const float gt = __uint_as_float(ri.y);
                bf16* rowp = (slot >= 0 ? Y + (size_t)slot * 1024 : trash) + col0;
#pragma unroll
                for (int bj = 0; bj < 2; ++bj) *(v4u*)(rowp + bj * 128) = pack8(acc[ai][bj][m][0] * gt, acc[ai][bj][m][1] * gt);
                asm volatile("" ::: "memory"); }
    }
};

constexpr int RING_OFF = 0, RING_BYTES = 131072;
constexpr int LDSX_OFF = RING_BYTES;
constexpr int LDS_BYTES = 163840;
constexpr int LDSCTL_OFF = LDS_BYTES - 256;

struct Frame {
    LAS unsigned char* lds;
    unsigned* ctl;
    unsigned char* ws;
    int tid, lane, wave, G, bid;
    float* out;
};
__device__ __forceinline__ const float* in_ptr(int i) { const float* const* ka = (const float* const*)__builtin_amdgcn_kernarg_segment_ptr(); asm volatile("" : "+s"(ka)); return ka[i]; }
enum { I_X = 0, I_MEM, I_LNIG, I_LNIB, I_LNMG, I_LNMB, I_LBF, I_LBB, I_WIN, I_BGATE, I_HNG, I_WKV, I_WFO, I_BFO, I_WHO, I_WXO, I_WOUT, I_LN1G, I_LN1B, I_WR, I_RB, I_WEG, I_WEU, I_WED, I_WSG, I_WSU, I_WSD, I_LN2G, I_LN2B };

__device__ __forceinline__ void tr_item(const float* src0, int lds_, bf16* dst0, int ldd, LAS float* scr, int lane) {
#pragma unroll 8
    for (int i = 0; i < 32; ++i) { const int kk = 2 * i + (lane >> 5); scr[kk * 33 + (lane & 31)] = src0[(size_t)kk * lds_ + (lane & 31)]; }
    LDS_WAIT(); asm volatile("" ::: "memory");
    const int c = lane & 7;
#pragma unroll
    for (int j = 0; j < 4; ++j) { const int n = (lane >> 3) + 8 * j; const LAS float* s = scr + (8 * c) * 33 + n;
        v4u o; o.x = cvt_pk_bf16(s[0 * 33], s[1 * 33]); o.y = cvt_pk_bf16(s[2 * 33], s[3 * 33]); o.z = cvt_pk_bf16(s[4 * 33], s[5 * 33]); o.w = cvt_pk_bf16(s[6 * 33], s[7 * 33]);
        *(v4u*)(dst0 + (size_t)n * ldd + 8 * c) = o; }
    LDS_WAIT(); asm volatile("" ::: "memory");
}
__device__ __forceinline__ void conv_matrix(Frame& F, const float* src, size_t mat_stride, int nmat, int K, int ldsrc, int n_lo, int ncols, bf16* dst, int rbase, int rstride, int rmul) {
    LAS float* scr = (LAS float*)(F.lds + RING_OFF + F.wave * 16384);
    const int gw = F.bid * NWAVES + F.wave, NGW = F.G * NWAVES;
    const int nkb = K / 64, nnb = ncols / 32, per = nkb * nnb, total = per * nmat;
    for (int it = gw; it < total; it += NGW) {
        const int e = it / per, r = it - e * per, kb = r / nnb, nb = r - kb * nnb, n = nb * 32;
        const int drow = rbase + e * rstride + (n >> 7) * rmul + (n & 127);
        tr_item(src + (size_t)e * mat_stride + (size_t)(kb * 64) * ldsrc + n_lo + n, ldsrc, dst + (size_t)drow * K + kb * 64, K, scr, F.lane);
    }
}
__device__ __forceinline__ void ln_row_bf16(const float* xrow, const float* g, const float* b, bf16* orow, int lane) {
    const f32x4* xr = (const f32x4*)xrow + lane;
    f32x4 v[4]; float s = 0.f;
#pragma unroll
    for (int j = 0; j < 4; ++j) { v[j] = xr[64 * j]; s += (v[j][0] + v[j][1]) + (v[j][2] + v[j][3]); }
    const float mean = wave_sum(s) * (1.f / 1024.f); float s2 = 0.f;
#pragma unroll
    for (int j = 0; j < 4; ++j) { v[j] = v[j] - mean; s2 += (v[j][0] * v[j][0] + v[j][1] * v[j][1]) + (v[j][2] * v[j][2] + v[j][3] * v[j][3]); }
    const float rstd = 1.f / sqrtf(wave_sum(s2) * (1.f / 1024.f) + LN_EPS);
    v2u* o8 = (v2u*)orow + lane;
#pragma unroll
    for (int j = 0; j < 4; ++j) { const f32x4 gg = ((const f32x4*)g)[lane + 64 * j], bb = ((const f32x4*)b)[lane + 64 * j]; const f32x4 y = v[j] * rstd * gg + bb;
        v2u w; w.x = cvt_pk_bf16(y[0], y[1]); w.y = cvt_pk_bf16(y[2], y[3]); o8[64 * j] = w; }
}

__device__ __forceinline__ void p0_prologue(Frame& F) {
    const int gw = F.bid * NWAVES + F.wave, NGW = F.G * NWAVES;
    unsigned char* ws = F.ws;
    conv_matrix(F, in_ptr(I_WIN), 0, 1, 1024, 6656, 512, 6144, (bf16*)(ws + WS_WIN), 1024, 0, 128);
    conv_matrix(F, in_ptr(I_WKV), 0, 1, 1024, 1024, 0, 1024, (bf16*)(ws + WS_WKV), 0, 0, 128);
    conv_matrix(F, in_ptr(I_WFO), 0, 1, 512, 1024, 0, 1024, (bf16*)(ws + WS_WFO), 0, 0, 128);
    conv_matrix(F, in_ptr(I_WHO), 0, 1, 512, 1024, 0, 1024, (bf16*)(ws + WS_WHO), 0, 0, 128);
    conv_matrix(F, in_ptr(I_WXO), 0, 1, 512, 1024, 0, 1024, (bf16*)(ws + WS_WXO), 0, 0, 128);
    conv_matrix(F, in_ptr(I_WOUT), 0, 1, 1024, 1024, 0, 1024, (bf16*)(ws + WS_WOUT), 0, 0, 128);
    conv_matrix(F, in_ptr(I_WR), 0, 1, 1024, 256, 0, 256, (bf16*)(ws + WS_WRS), 0, 0, 128);
    conv_matrix(F, in_ptr(I_WSG), 0, 1, 1024, 256, 0, 256, (bf16*)(ws + WS_WRS), 256, 0, 256);
    conv_matrix(F, in_ptr(I_WSU), 0, 1, 1024, 256, 0, 256, (bf16*)(ws + WS_WRS), 384, 0, 256);
    conv_matrix(F, in_ptr(I_WSD), 0, 1, 256, 1024, 0, 1024, (bf16*)(ws + WS_WSD), 0, 0, 128);
    {
        LAS float* ct = (LAS float*)(F.lds + LDSX_OFF);
        if (F.tid < 128) { float sn, cs; __sincosf(6.283185307179586f * (float)F.tid / 128.f, &sn, &cs); ct[F.tid] = cs; ct[128 + F.tid] = sn; }
        __syncthreads();
        const float* win = in_ptr(I_WIN); bf16* wt = (bf16*)(ws + WS_WIN);
        for (int it = gw; it < 1024 * 8; it += NGW) {
            const int k = it >> 3, g = (it >> 1) & 3, j = (it & 1) * 64 + F.lane;
            const float* wr = win + (size_t)k * 6656 + g * 128; float ac = 0.f, as = 0.f;
            for (int c = 0; c < 128; ++c) { const float wv = wr[c]; const int a = (j * c) & 127; ac += wv * ct[a]; as += wv * ct[128 + a]; }
            wt[(size_t)(g * 128 + j) * 1024 + k] = f2bf(ac); wt[(size_t)(512 + g * 128 + j) * 1024 + k] = f2bf(as);
        }
        bf16* a1 = (bf16*)(ws + WS_A1);
        for (int i = F.bid * NTHR + F.tid; i < 128 * 128; i += F.G * NTHR) {
            const int m = i >> 7, kk = i & 127, po = m >> 6, k1 = m & 63, pi = kk >> 6, s1 = kk & 63;
            float sn, cs; __sincosf(6.283185307179586f * (float)((s1 * k1) & 63) / 64.f, &sn, &cs);
            const float v = (po == pi) ? cs : (po == 0 ? -sn : sn);
            a1[i] = f2bf(v * 0.125f);
        }
        bf16* a3 = (bf16*)(ws + WS_A3);
        for (int i = F.bid * NTHR + F.tid; i < 64 * 128 * 256; i += F.G * NTHR) {
            const int k1 = i >> 15, k2 = (i >> 8) & 127, kk = i & 255, s2 = kk >> 1, part = kk & 1, k = k1 + 64 * k2;
            float sn, cs; __sincosf(6.283185307179586f * (float)((s2 * k) & 8191) / 8192.f, &sn, &cs);
            a3[i] = f2bf((part == 0 ? cs : -sn) * (1.f / 128.f));
        }
    }
    for (int m = gw; m < T; m += NGW) ln_row_bf16(in_ptr(I_X) + (size_t)m * D, in_ptr(I_LNIG), in_ptr(I_LNIB), (bf16*)(ws + WS_H0) + (size_t)m * D, F.lane);
    for (int m = gw; m < NB * MEM; m += NGW) ln_row_bf16(in_ptr(I_MEM) + (size_t)m * D, in_ptr(I_LNMG), in_ptr(I_LNMB), (bf16*)(ws + WS_MEMN) + (size_t)m * D, F.lane);
}
__device__ __forceinline__ void p_convert_experts(Frame& F) {
    unsigned char* ws = F.ws;
    conv_matrix(F, in_ptr(I_WEG), (size_t)1024 * 256, NE, 1024, 256, 0, 256, (bf16*)(ws + WS_EXPGU), 0, 512, 256);
    conv_matrix(F, in_ptr(I_WEU), (size_t)1024 * 256, NE, 1024, 256, 0, 256, (bf16*)(ws + WS_EXPGU), 128, 512, 256);
    conv_matrix(F, in_ptr(I_WED), (size_t)256 * 1024, NE, 256, 1024, 0, 1024, (bf16*)(ws + WS_EXPD), 0, 1024, 128);
}
__device__ __forceinline__ void p_ln1(Frame& F) {
    const int gw = F.bid * NWAVES + F.wave, NGW = F.G * NWAVES;
    for (int m = gw; m < T; m += NGW) ln_row_bf16((const float*)(F.ws + WS_S1) + (size_t)m * D, in_ptr(I_LN1G), in_ptr(I_LN1B), (bf16*)(F.ws + WS_H1) + (size_t)m * D, F.lane);
}
template <bool ROUTED>
__device__ __forceinline__ void p_final(Frame& F) {
    const int gw = F.bid * NWAVES + F.wave, NGW = F.G * NWAVES, lane = F.lane;
    const float* g = in_ptr(I_LN2G); const float* b = in_ptr(I_LN2B);
    for (int m = gw; m < T; m += NGW) {
        const f32x4* xr = (const f32x4*)((const float*)(F.ws + WS_S2) + (size_t)m * D) + lane;
        f32x4 v[4];
#pragma unroll
        for (int j = 0; j < 4; ++j) v[j] = xr[64 * j];
        if (ROUTED) {
            const bf16* yb = (const bf16*)(F.ws + WS_YR) + (size_t)m * 8 * 1024;
#pragma unroll
            for (int k = 0; k < 8; ++k)
#pragma unroll
                for (int j = 0; j < 4; ++j) { const v2u w = ((const v2u*)(yb + (size_t)k * 1024))[lane + 64 * j];
                    v[j][0] += bflo(w.x); v[j][1] += bfhi(w.x); v[j][2] += bflo(w.y); v[j][3] += bfhi(w.y); }
        }
        float s = 0.f;
#pragma unroll
        for (int j = 0; j < 4; ++j) s += (v[j][0] + v[j][1]) + (v[j][2] + v[j][3]);
        const float mean = wave_sum(s) * (1.f / 1024.f); float s2 = 0.f;
#pragma unroll
        for (int j = 0; j < 4; ++j) { v[j] = v[j] - mean; s2 += (v[j][0] * v[j][0] + v[j][1] * v[j][1]) + (v[j][2] * v[j][2] + v[j][3] * v[j][3]); }
        const float rstd = 1.f / sqrtf(wave_sum(s2) * (1.f / 1024.f) + LN_EPS);
        f32x4* o = (f32x4*)(F.out + (size_t)m * D) + lane;
#pragma unroll
        for (int j = 0; j < 4; ++j) { const f32x4 gg = ((const f32x4*)g)[lane + 64 * j], bb = ((const f32x4*)b)[lane + 64 * j]; o[64 * j] = v[j] * rstd * gg + bb; }
    }
}
__device__ __forceinline__ void p_scale_copy(Frame& F, const bf16* src, float* dst) {
    for (size_t i = (size_t)F.bid * NTHR + F.tid; i < (size_t)T * D / 4; i += (size_t)F.G * NTHR) {
        const v2u w = ((const v2u*)src)[i]; f32x4 o; o[0] = ALPHA * bflo(w.x); o[1] = ALPHA * bfhi(w.x); o[2] = ALPHA * bflo(w.y); o[3] = ALPHA * bfhi(w.y); ((f32x4*)dst)[i] = o; }
}


__device__ __forceinline__ void p_proj(Frame& F) {
    pg8::Gemm g{(const bf16*)(F.ws + WS_H0), (const bf16*)(F.ws + WS_WIN), 1024};
    pg8::StaticOrder S; S.init(T, NPROJ, F.G, F.bid);
    EpiProj E{(bf16*)(F.ws + WS_F), (bf16*)(F.ws + WS_Q), (bf16*)(F.ws + WS_GATES), in_ptr(I_BGATE)};
    pg8::gemm_phase<EpiProj, pg8::StaticOrder, false>(F.lds + RING_OFF, g, S, E, nullptr);
}
__device__ __forceinline__ void p_kv(Frame& F) {
    pg8::Gemm g{(const bf16*)(F.ws + WS_MEMN), (const bf16*)(F.ws + WS_WKV), 1024};
    pg8::StaticOrder S; S.init(NB * MEM, 1024, F.G, F.bid);
    EpiPlain E{(bf16*)(F.ws + WS_KV), 1024};
    pg8::gemm_phase<EpiPlain, pg8::StaticOrder, false>(F.lds + RING_OFF, g, S, E, nullptr);
}
__device__ __forceinline__ void p_branch(Frame& F, size_t a_off, size_t w_off, const float* bias, int br, int first) {
    pg8::Gemm g{(const bf16*)(F.ws + a_off), (const bf16*)(F.ws + w_off), 512};
    pg8::StaticOrder S; S.init(T, 1024, F.G, F.bid);
    EpiMerge E{(bf16*)(F.ws + WS_MERGED), (const bf16*)(F.ws + WS_GATES), bias, br, first};
    pg8::gemm_phase<EpiMerge, pg8::StaticOrder, false>(F.lds + RING_OFF, g, S, E, nullptr);
}
__device__ __forceinline__ void p_wout(Frame& F) {
    pg8::Gemm g{(const bf16*)(F.ws + WS_MERGED), (const bf16*)(F.ws + WS_WOUT), 1024};
    pg8::StaticOrder S; S.init(T, 1024, F.G, F.bid);
    EpiResid E{(float*)(F.ws + WS_S1), (const bf16*)(F.ws + WS_H0)};
    pg8::gemm_phase<EpiResid, pg8::StaticOrder, false>(F.lds + RING_OFF, g, S, E, nullptr);
}
__device__ __forceinline__ void p_router_shared(Frame& F) {
    pg8::Gemm g{(const bf16*)(F.ws + WS_H1), (const bf16*)(F.ws + WS_WRS), 1024};
    pg8::StaticOrder S; S.init(T, 768, F.G, F.bid);
    EpiRouterShared E{(float*)(F.ws + WS_LOGIT), (bf16*)(F.ws + WS_HS)};
    pg8::gemm_phase<EpiRouterShared, pg8::StaticOrder, false>(F.lds + RING_OFF, g, S, E, nullptr);
}
__device__ __forceinline__ void p_shared_down(Frame& F) {
    pg8::Gemm g{(const bf16*)(F.ws + WS_HS), (const bf16*)(F.ws + WS_WSD), 256};
    pg8::StaticOrder S; S.init(T, 1024, F.G, F.bid);
    EpiResid E{(float*)(F.ws + WS_S2), (const bf16*)(F.ws + WS_H1)};
    pg8::gemm_phase<EpiResid, pg8::StaticOrder, false>(F.lds + RING_OFF, g, S, E, nullptr);
}

constexpr int XA_PITCH = 136;
__device__ __forceinline__ void p_xattn(Frame& F) {
    LAS bf16* Ks = (LAS bf16*)(F.lds); LAS bf16* Vs = Ks + 256 * XA_PITCH;
    const bf16* KV = (const bf16*)(F.ws + WS_KV); const bf16* XQ = (const bf16*)(F.ws + WS_Q + 5 * SEC_STRIDE); bf16* XO = (bf16*)(F.ws + WS_XO);
    const int lane = F.lane, r = lane & 15, q = lane >> 4, qp = (lane & 15) >> 2, pp = lane & 3;
    int cur_bh = -1;
    for (int u = F.bid; u < 512; u += F.G) {
        const int bh = u & 15, tile = u >> 4, b = bh >> 2, h = bh & 3;
        if (bh != cur_bh) {
            __syncthreads();
            for (int c = F.tid; c < 256 * 16; c += NTHR) { const int key = c >> 4, ch = c & 15;
                const v4u kv = *(const v4u*)(KV + (size_t)(b * 256 + key) * 1024 + h * 128 + ch * 8);
                const v4u vv = *(const v4u*)(KV + (size_t)(b * 256 + key) * 1024 + 512 + h * 128 + ch * 8);
                *(LAS v4u*)(Ks + key * XA_PITCH + ch * 8) = kv; *(LAS v4u*)(Vs + key * XA_PITCH + ch * 8) = vv; }
            __syncthreads();
            cur_bh = bh;
        }
        const int t0 = b * SEQ + tile * 256 + F.wave * 32;
#pragma unroll 1
        for (int mq = 0; mq < 2; ++mq) {
            const bf16* qrow = XQ + (size_t)(t0 + 16 * mq + r) * 512 + h * 128 + 8 * q;
            bf16x8 qf[4];
#pragma unroll
            for (int ks = 0; ks < 4; ++ks) qf[ks] = *(const bf16x8*)(qrow + 32 * ks);
            f32x4 sc[16];
#pragma unroll
            for (int nk = 0; nk < 16; ++nk) { sc[nk] = (f32x4){0.f, 0.f, 0.f, 0.f};
#pragma unroll
                for (int ks = 0; ks < 4; ++ks) { const bf16x8 kf = *(const LAS bf16x8*)(Ks + (16 * nk + r) * XA_PITCH + 32 * ks + 8 * q);
                    sc[nk] = __builtin_amdgcn_mfma_f32_16x16x32_bf16(kf, qf[ks], sc[nk], 0, 0, 0); } }
            float mx = -3.0e38f;
#pragma unroll
            for (int nk = 0; nk < 16; ++nk) mx = fmaxf(mx, fmaxf(fmaxf(sc[nk][0], sc[nk][1]), fmaxf(sc[nk][2], sc[nk][3])));
            mx = fmaxf(mx, __shfl_xor(mx, 16)); mx = fmaxf(mx, __shfl_xor(mx, 32));
            float l = 0.f;
#pragma unroll
            for (int nk = 0; nk < 16; ++nk) {
#pragma unroll
                for (int j = 0; j < 4; ++j) { sc[nk][j] = __builtin_amdgcn_exp2f(sc[nk][j] - mx); l += sc[nk][j]; } }
            l += __shfl_xor(l, 16); l += __shfl_xor(l, 32);
            const float inv = 1.0f / l;
            bf16x8 pf[8];
#pragma unroll
            for (int s = 0; s < 8; ++s) { v4u w; w.x = cvt_pk_bf16(sc[2 * s][0], sc[2 * s][1]); w.y = cvt_pk_bf16(sc[2 * s][2], sc[2 * s][3]);
                w.z = cvt_pk_bf16(sc[2 * s + 1][0], sc[2 * s + 1][1]); w.w = cvt_pk_bf16(sc[2 * s + 1][2], sc[2 * s + 1][3]); pf[s] = __builtin_bit_cast(bf16x8, w); }
            bf16* orow = XO + (size_t)(t0 + 16 * mq + r) * 512 + h * 128 + 4 * q;
#pragma unroll
            for (int nd = 0; nd < 8; ++nd) { f32x4 o = (f32x4){0.f, 0.f, 0.f, 0.f};
#pragma unroll
                for (int s = 0; s < 8; ++s) {
                    const s16x4 v0 = __builtin_amdgcn_ds_read_tr16_b64_v4i16((LAS s16x4*)(Vs + (32 * s + 4 * q + qp) * XA_PITCH + 16 * nd + 4 * pp));
                    const s16x4 v1 = __builtin_amdgcn_ds_read_tr16_b64_v4i16((LAS s16x4*)(Vs + (32 * s + 16 + 4 * q + qp) * XA_PITCH + 16 * nd + 4 * pp));
                    const bf16x8 vf = {v0[0], v0[1], v0[2], v0[3], v1[0], v1[1], v1[2], v1[3]};
                    o = __builtin_amdgcn_mfma_f32_16x16x32_bf16(vf, pf[s], o, 0, 0, 0); }
                o = o * inv;
                v2u w; w.x = cvt_pk_bf16(o[0], o[1]); w.y = cvt_pk_bf16(o[2], o[3]); *(v2u*)(orow + 16 * nd) = w; }
        }
    }
    __syncthreads();
}

__device__ __forceinline__ void p_routing(Frame& F) {
    const int gw = F.bid * NWAVES + F.wave, NGW = F.G * NWAVES, lane = F.lane;
    const float* L = (const float*)(F.ws + WS_LOGIT);
    int* eidx = (int*)(F.ws + WS_ROUTE + RT_EIDX); float* wgt = (float*)(F.ws + WS_ROUTE + RT_WGT); int* pos = (int*)(F.ws + WS_ROUTE + RT_POS);
    unsigned* cnt = F.ctl + CW_CNT;
    const f32x4 rb = ((const f32x4*)in_ptr(I_RB))[lane];
    const float NEG = -__builtin_inff();
    for (int t = gw; t < T; t += NGW) {
        const f32x4 lg = ((const f32x4*)(L + (size_t)t * 256))[lane];
        float a0 = sigmoidf_(lg[0]), a1 = sigmoidf_(lg[1]), a2 = sigmoidf_(lg[2]), a3 = sigmoidf_(lg[3]);
        float s0 = a0 + rb[0], s1 = a1 + rb[1], s2 = a2 + rb[2], s3 = a3 + rb[3];
        float m1 = fmaxf(s0, s1), m2 = fminf(s0, s1);
        { const float n1 = fmaxf(m1, s2), n2 = fmaxf(fminf(m1, s2), m2); m1 = n1; m2 = n2; }
        { const float n1 = fmaxf(m1, s3), n2 = fmaxf(fminf(m1, s3), m2); m1 = n1; m2 = n2; }
#pragma unroll
        for (int o = 1; o < 8; o <<= 1) { const float p1 = __shfl_xor(m1, o), p2 = __shfl_xor(m2, o); const float n1 = fmaxf(m1, p1), n2 = fmaxf(fminf(m1, p1), fmaxf(m2, p2)); m1 = n1; m2 = n2; }
        const float gs = m1 + m2; const int grp = lane >> 3; int rank = 0;
#pragma unroll
        for (int g2 = 0; g2 < 8; ++g2) { const float o = __shfl(gs, g2 * 8); rank += (o > gs || (o == gs && g2 < grp)) ? 1 : 0; }
        if (rank >= 4) { s0 = NEG; s1 = NEG; s2 = NEG; s3 = NEG; }
        int my_e = 0; float my_a = 0.f, asum = 0.f;
#pragma unroll 1
        for (int k = 0; k < 8; ++k) {
            float bv = s0; int bi = 4 * lane; float ba = a0;
            if (s1 > bv) { bv = s1; bi = 4 * lane + 1; ba = a1; }
            if (s2 > bv) { bv = s2; bi = 4 * lane + 2; ba = a2; }
            if (s3 > bv) { bv = s3; bi = 4 * lane + 3; ba = a3; }
#pragma unroll
            for (int o = 1; o < 64; o <<= 1) { const float pv = __shfl_xor(bv, o); const int pi = __shfl_xor(bi, o); const float pa = __shfl_xor(ba, o);
                if (pv > bv || (pv == bv && pi < bi)) { bv = pv; bi = pi; ba = pa; } }
            if ((bi >> 2) == lane) { const int j = bi & 3; if (j == 0) s0 = NEG; else if (j == 1) s1 = NEG; else if (j == 2) s2 = NEG; else s3 = NEG; }
            if (lane == k) { my_e = bi; my_a = ba; }
            asum += ba;
        }
        if (lane < 8) {
            const unsigned p = __hip_atomic_fetch_add(cnt + my_e, 1u, __ATOMIC_RELAXED, __HIP_MEMORY_SCOPE_AGENT);
            eidx[(size_t)t * 8 + lane] = my_e; wgt[(size_t)t * 8 + lane] = my_a / asum * 2.5f; pos[(size_t)t * 8 + lane] = (int)p;
        }
    }
}
__device__ __forceinline__ int build_expert_tables(Frame& F, LAS unsigned short* te, LAS int* roff) {
    LAS int* tmp = (LAS int*)(F.lds + LDSX_OFF + 4096);
    const unsigned* cnt = F.ctl + CW_CNT;
    __syncthreads();
    if (F.tid < 256) tmp[F.tid] = (int)((__hip_atomic_load(cnt + F.tid, __ATOMIC_RELAXED, __HIP_MEMORY_SCOPE_AGENT) + 255u) >> 8);
    __syncthreads();
    if (F.tid < 256) { int s = 0; for (int j = 0; j < F.tid; ++j) s += tmp[j]; const int nt = tmp[F.tid];
        for (int i = 0; i < nt; ++i) te[s + i] = (unsigned short)F.tid;
        if (roff) roff[F.tid] = s * 256;
        if (F.tid == 255) tmp[256] = s + nt; }
    __syncthreads();
    return tmp[256];
}
__device__ __forceinline__ void p_fill(Frame& F) {
    LAS unsigned short* te = (LAS unsigned short*)(F.lds + LDSX_OFF); LAS int* roff = (LAS int*)(F.lds + LDSX_OFF + 6144);
    (void)build_expert_tables(F, te, roff);
    const int* eidx = (const int*)(F.ws + WS_ROUTE + RT_EIDX); const float* wgt = (const float*)(F.ws + WS_ROUTE + RT_WGT); const int* pos = (const int*)(F.ws + WS_ROUTE + RT_POS);
    int* rowtok = (int*)(F.ws + WS_ROUTE + RT_ROWTOK); v2u* rowinfo = (v2u*)(F.ws + WS_ROUTE + RT_ROWSLOT);
    for (int i = F.bid * NTHR + F.tid; i < T * TOPK; i += F.G * NTHR) { const int e = eidx[i]; const int r = roff[e] + pos[i]; rowtok[r] = i >> 3; rowinfo[r] = (v2u){(unsigned)i, __float_as_uint(wgt[i])}; }
    const unsigned* cnt = F.ctl + CW_CNT;
    for (int e = F.bid; e < NE; e += F.G) { const int c = (int)__hip_atomic_load(cnt + e, __ATOMIC_RELAXED, __HIP_MEMORY_SCOPE_AGENT), r0 = roff[e] + c, r1 = roff[e] + ((c + 255) & ~255);
        for (int r = r0 + F.tid; r < r1; r += NTHR) { rowtok[r] = 0; rowinfo[r] = (v2u){0xffffffffu, 0u}; } }
    __syncthreads();
}
__device__ __forceinline__ void p_exp_gu(Frame& F) {
    LAS unsigned short* te = (LAS unsigned short*)(F.lds + LDSX_OFF);
    const int ntiles = build_expert_tables(F, te, nullptr);
    pg8::Gemm g{(const bf16*)(F.ws + WS_H1), (const bf16*)(F.ws + WS_EXPGU), 1024};
    pg8::ExpertOrder<2> S{ntiles * 2, F.G, F.bid, te};
    EpiExpGU E{(bf16*)(F.ws + WS_HACT)};
    pg8::gemm_phase<EpiExpGU, pg8::ExpertOrder<2>, true>(F.lds + RING_OFF, g, S, E, (const int*)(F.ws + WS_ROUTE + RT_ROWTOK));
}
__device__ __forceinline__ void p_exp_down(Frame& F) {
    LAS unsigned short* te = (LAS unsigned short*)(F.lds + LDSX_OFF);
    const int ntiles = build_expert_tables(F, te, nullptr);
    pg8::Gemm g{(const bf16*)(F.ws + WS_HACT), (const bf16*)(F.ws + WS_EXPD), 256};
    pg8::ExpertOrder<4> S{ntiles * 4, F.G, F.bid, te};
    EpiExpDown E{(bf16*)(F.ws + WS_YR), (const v2u*)(F.ws + WS_ROUTE + RT_ROWSLOT), (bf16*)(F.ws + WS_ROUTE + RT_TRASH)};
    pg8::gemm_phase<EpiExpDown, pg8::ExpertOrder<4>, false>(F.lds + RING_OFF, g, S, E, nullptr);
}

template <int STEP>
__device__ __forceinline__ void p_dft(Frame& F) {
    constexpr int K = STEP == 1 ? 128 : 256, NBC = STEP == 1 ? 256 : 128, WM = STEP == 1 ? 1 : 2, WN = 8 / WM;
    constexpr int MT = 128 / WM / 16, NT = NBC / WN / 16, PITCH = NBC + 8, CPR = NBC / 8;
    LAS bf16* Bs = (LAS bf16*)F.lds;
    const bf16* Fb = (const bf16*)(F.ws + WS_F); bf16* Yb = (bf16*)(F.ws + WS_Y); bf16* FM = (bf16*)(F.ws + WS_FM);
    const int lane = F.lane, r = lane & 15, q = lane >> 4, qp = (lane & 15) >> 2, pp = lane & 3;
    const int wm = F.wave / WN, wn = F.wave % WN;
    for (int u = F.bid; u < 1024; u += F.G) {
        const int b = u >> 8, mid = STEP == 1 ? (u >> 1) & 127 : (u >> 2) & 63, n0 = STEP == 1 ? (u & 1) * 256 : (u & 3) * 128;
        __syncthreads();
        for (int c = F.tid; c < K * CPR; c += NTHR) { const int kk = c / CPR, ch = c % CPR;
            const bf16* src = STEP == 1 ? Fb + (size_t)(b * SEQ + 128 * (kk & 63) + mid) * 1024 + (kk >> 6) * 512 + n0 + ch * 8
                                        : Yb + ((size_t)(b * 64 + mid) * 256 + kk) * 512 + n0 + ch * 8;
            *(LAS v4u*)(Bs + kk * PITCH + ch * 8) = *(const v4u*)src; }
        __syncthreads();
        const bf16* A = STEP == 1 ? (const bf16*)(F.ws + WS_A1) : (const bf16*)(F.ws + WS_A3) + (size_t)mid * 128 * 256;
        f32x4 acc[MT][NT];
#pragma unroll
        for (int mi = 0; mi < MT; ++mi)
#pragma unroll
            for (int ni = 0; ni < NT; ++ni) acc[mi][ni] = (f32x4){0.f, 0.f, 0.f, 0.f};
#pragma unroll 2
        for (int ks = 0; ks < K / 32; ++ks) {
            bf16x8 af[MT];
#pragma unroll
            for (int mi = 0; mi < MT; ++mi) af[mi] = *(const bf16x8*)(A + (size_t)(wm * (128 / WM) + 16 * mi + r) * K + 32 * ks + 8 * q);
#pragma unroll
            for (int ni = 0; ni < NT; ++ni) { const int n = wn * (NBC / WN) + 16 * ni;
                const s16x4 v0 = __builtin_amdgcn_ds_read_tr16_b64_v4i16((LAS s16x4*)(Bs + (32 * ks + 8 * q + qp) * PITCH + n + 4 * pp));
                const s16x4 v1 = __builtin_amdgcn_ds_read_tr16_b64_v4i16((LAS s16x4*)(Bs + (32 * ks + 8 * q + 4 + qp) * PITCH + n + 4 * pp));
                const bf16x8 xf = {v0[0], v0[1], v0[2], v0[3], v1[0], v1[1], v1[2], v1[3]};
#pragma unroll
                for (int mi = 0; mi < MT; ++mi) acc[mi][ni] = __builtin_amdgcn_mfma_f32_16x16x32_bf16(xf, af[mi], acc[mi][ni], 0, 0, 0); }
        }
#pragma unroll
        for (int mi = 0; mi < MT; ++mi) { const int m = wm * (128 / WM) + 16 * mi + r;
            bf16* drow = STEP == 1 ? Yb + ((((size_t)(b * 64 + (m & 63)) * 128 + mid) * 2 + (m >> 6)) * 512)
                                   : FM + (size_t)(b * SEQ + mid + 64 * m) * 512;
#pragma unroll
            for (int ni = 0; ni < NT; ++ni) { const int n = n0 + wn * (NBC / WN) + 16 * ni + 4 * q; const f32x4 o = acc[mi][ni];
                v2u w; w.x = cvt_pk_bf16_c(o[0], o[1]); w.y = cvt_pk_bf16_c(o[2], o[3]); *(v2u*)(drow + n) = w; } }
    }
    __syncthreads();
}

__device__ __forceinline__ v2u pack4c(const f32x4 o) { v2u w; w.x = cvt_pk_bf16_c(o[0], o[1]); w.y = cvt_pk_bf16_c(o[2], o[3]); return w; }
__device__ __forceinline__ bf16x8 tr8(const LAS bf16* p0, const LAS bf16* p1) {
    const s16x4 a = __builtin_amdgcn_ds_read_tr16_b64_v4i16((LAS s16x4*)p0), b = __builtin_amdgcn_ds_read_tr16_b64_v4i16((LAS s16x4*)p1);
    return (bf16x8){a[0], a[1], a[2], a[3], b[0], b[1], b[2], b[3]};
}
constexpr int HP = 136;
__device__ __forceinline__ void p_hgrn1(Frame& F) {
    LAS bf16* Qd = (LAS bf16*)F.lds; LAS bf16* Ki = Qd + 64 * HP; LAS bf16* Ke = Ki + 64 * HP; LAS bf16* Vs = Ke + 64 * HP; LAS bf16* Sb = Vs + 64 * HP;
    LAS float* tot = (LAS float*)(Sb + 128 * HP); LAS float* dec = tot + 512;
    const int tid = F.tid, lane = F.lane, r = lane & 15, q = lane >> 4, qp = (lane & 15) >> 2, pp = lane & 3, w = F.wave, tb = w & 3, dh = w >> 2, d = tid & 127, qt = tid >> 7;
    for (int u = F.bid; u < 512; u += F.G) {
        const int sg = u & 15, dir = (u >> 4) & 1, h = (u >> 5) & 3, b = u >> 7;
        const bf16* Qg = (const bf16*)(F.ws + WS_Q) + h * 128; const bf16* Vg = (const bf16*)(F.ws + WS_Q + SEC_STRIDE) + h * 128;
        const bf16* Zg = (const bf16*)(F.ws + WS_Q + (dir ? 3 : 2) * SEC_STRIDE) + h * 128;
        bf16* OL = (bf16*)(F.ws + (dir ? WS_OLB : WS_OLF)) + h * 128; bf16* QS = (bf16*)(F.ws + (dir ? WS_QSB : WS_QSF)) + h * 128;
        const float* lbp = in_ptr(dir ? I_LBB : I_LBF);
        const float lb = 1.0f / (1.0f + __expf(lbp[512 + h * 128 + d] - lbp[h * 128 + d]));
        float G = 0.f;
        f32x4 sS[8];
#pragma unroll
        for (int nd = 0; nd < 8; ++nd) sS[nd] = (f32x4){0.f, 0.f, 0.f, 0.f};
        __syncthreads();
        for (int i = tid; i < 128 * HP / 8; i += NTHR) ((LAS v4u*)Sb)[i] = (v4u){0u, 0u, 0u, 0u};
#pragma unroll 1
        for (int c = 0; c < 8; ++c) {
            __syncthreads();
            const int tbase = sg * SEG + 64 * c;
            float qv[16], kv[16], cs[16]; float run = 0.f;
#pragma unroll
            for (int i = 0; i < 16; ++i) { const int pos = tbase + 16 * qt + i; const size_t tok = (size_t)(b * SEQ + (dir ? SEQ - 1 - pos : pos));
                const float zf = bf2f(Zg[tok * 512 + d]); qv[i] = bf2f(Qg[tok * 512 + d]);
                const float f = lb + (1.0f - lb) * sigmoidf_(zf); kv[i] = 1.0f - f; run += __logf(f); cs[i] = run; }
            tot[qt * 128 + d] = run;
            for (int cc = tid; cc < 1024; cc += NTHR) { const int tp = cc >> 4, ch = cc & 15, pos = tbase + tp; const size_t tok = (size_t)(b * SEQ + (dir ? SEQ - 1 - pos : pos));
                *(LAS v4u*)(Vs + tp * HP + ch * 8) = *(const v4u*)(Vg + tok * 512 + ch * 8); }
            __syncthreads();
            float pre = 0.f, aend = 0.f;
#pragma unroll
            for (int j = 0; j < 4; ++j) { const float x = tot[j * 128 + d]; aend += x; pre += (j < qt) ? x : 0.f; }
            const float eG = __expf(G);
#pragma unroll
            for (int i = 0; i < 16; ++i) { const int tp = 16 * qt + i, pos = tbase + tp; const size_t tok = (size_t)(b * SEQ + (dir ? SEQ - 1 - pos : pos));
                const float a = pre + cs[i], qd = qv[i] * __expf(a);
                Qd[tp * HP + d] = f2bf(qd); Ki[tp * HP + d] = f2bf(kv[i] * __expf(-a)); Ke[tp * HP + d] = f2bf(kv[i] * __expf(aend - a));
                QS[tok * 512 + d] = f2bf(qd * eG); }
            if (qt == 0) dec[d] = __expf(aend);
            G += aend;
            __syncthreads();
            bf16x8 qf[4];
#pragma unroll
            for (int ks = 0; ks < 4; ++ks) qf[ks] = *(const LAS bf16x8*)(Qd + (16 * tb + r) * HP + 32 * ks + 8 * q);
            f32x4 sc[4];
#pragma unroll
            for (int sb = 0; sb < 4; ++sb) { sc[sb] = (f32x4){0.f, 0.f, 0.f, 0.f};
#pragma unroll
                for (int ks = 0; ks < 4; ++ks) { const bf16x8 kf = *(const LAS bf16x8*)(Ki + (16 * sb + r) * HP + 32 * ks + 8 * q); sc[sb] = __builtin_amdgcn_mfma_f32_16x16x32_bf16(kf, qf[ks], sc[sb], 0, 0, 0); }
#pragma unroll
                for (int j = 0; j < 4; ++j) sc[sb][j] = (16 * sb + 4 * q + j > 16 * tb + r) ? 0.f : sc[sb][j]; }
            bf16x8 pf[2];
#pragma unroll
            for (int k2 = 0; k2 < 2; ++k2) { v4u wv; wv.x = cvt_pk_bf16(sc[2 * k2][0], sc[2 * k2][1]); wv.y = cvt_pk_bf16(sc[2 * k2][2], sc[2 * k2][3]);
                wv.z = cvt_pk_bf16(sc[2 * k2 + 1][0], sc[2 * k2 + 1][1]); wv.w = cvt_pk_bf16(sc[2 * k2 + 1][2], sc[2 * k2 + 1][3]); pf[k2] = __builtin_bit_cast(bf16x8, wv); }
            { const int pos = tbase + 16 * tb + r; const size_t tok = (size_t)(b * SEQ + (dir ? SEQ - 1 - pos : pos));
#pragma unroll
            for (int nd = 0; nd < 4; ++nd) { f32x4 o = (f32x4){0.f, 0.f, 0.f, 0.f}; const int cb = 64 * dh + 16 * nd + 4 * pp;
#pragma unroll
                for (int k2 = 0; k2 < 2; ++k2) o = __builtin_amdgcn_mfma_f32_16x16x32_bf16(tr8(Vs + (32 * k2 + 4 * q + qp) * HP + cb, Vs + (32 * k2 + 16 + 4 * q + qp) * HP + cb), pf[k2], o, 0, 0, 0);
#pragma unroll
                for (int ks = 0; ks < 4; ++ks) o = __builtin_amdgcn_mfma_f32_16x16x32_bf16(tr8(Sb + (32 * ks + 8 * q + qp) * HP + cb, Sb + (32 * ks + 8 * q + 4 + qp) * HP + cb), qf[ks], o, 0, 0, 0);
                *(v2u*)(OL + tok * 512 + 64 * dh + 16 * nd + 4 * q) = pack4c(o); } }
            { const float dc = dec[16 * w + r];
#pragma unroll
            for (int nd = 0; nd < 8; ++nd) { sS[nd] = sS[nd] * dc;
#pragma unroll
                for (int k2 = 0; k2 < 2; ++k2) sS[nd] = __builtin_amdgcn_mfma_f32_16x16x32_bf16(tr8(Vs + (32 * k2 + 8 * q + qp) * HP + 16 * nd + 4 * pp, Vs + (32 * k2 + 8 * q + 4 + qp) * HP + 16 * nd + 4 * pp),
                                                                                              tr8(Ke + (32 * k2 + 8 * q + qp) * HP + 16 * w + 4 * pp, Ke + (32 * k2 + 8 * q + 4 + qp) * HP + 16 * w + 4 * pp), sS[nd], 0, 0, 0); } }
            __syncthreads();
#pragma unroll
            for (int nd = 0; nd < 8; ++nd) *(LAS v2u*)(Sb + (16 * w + r) * HP + 16 * nd + 4 * q) = pack4c(sS[nd]);
        }
        float* U = (float*)(F.ws + WS_U) + (size_t)u * 16384;
#pragma unroll
        for (int nd = 0; nd < 8; ++nd) *(f32x4*)(U + (16 * w + r) * 128 + 16 * nd + 4 * q) = sS[nd];
        if (qt == 0) ((float*)(F.ws + WS_DEC))[u * 128 + d] = __expf(G);
    }
    __syncthreads();
}
__device__ __forceinline__ void p_hgrn_scan(Frame& F) {
    const float* U = (const float*)(F.ws + WS_U); const float* DEC = (const float*)(F.ws + WS_DEC); bf16* SST = (bf16*)(F.ws + WS_SST);
    for (int it = F.bid * NTHR + F.tid; it < 32 * 128 * 32; it += F.G * NTHR) {
        const int cmb = it >> 12, dk = (it >> 5) & 127, dv4 = it & 31;
        f32x4 st = (f32x4){0.f, 0.f, 0.f, 0.f};
#pragma unroll 4
        for (int sg = 0; sg < NSEG; ++sg) { const size_t un = (size_t)(cmb * 16 + sg);
            v2u wv; wv.x = cvt_pk_bf16(st[0], st[1]); wv.y = cvt_pk_bf16(st[2], st[3]); *(v2u*)(SST + un * 16384 + dk * 128 + dv4 * 4) = wv;
            const float dcy = DEC[un * 128 + dk]; const f32x4 uu = *(const f32x4*)(U + un * 16384 + dk * 128 + dv4 * 4); st = st * dcy + uu; }
    }
}
__device__ __forceinline__ void p_hgrn2(Frame& F) {
    LAS bf16* Sf = (LAS bf16*)F.lds; LAS bf16* Sw = Sf + 128 * HP;
    const int lane = F.lane, r = lane & 15, q = lane >> 4, qp = (lane & 15) >> 2, pp = lane & 3;
    const bf16* SST = (const bf16*)(F.ws + WS_SST);
    for (int u = F.bid; u < 512; u += F.G) {
        const int tile = u & 31, h = (u >> 5) & 3, b = u >> 7;
        const int unf = ((b * 4 + h) * 2 + 0) * 16 + (tile >> 1), unb = ((b * 4 + h) * 2 + 1) * 16 + ((31 - tile) >> 1);
        __syncthreads();
        for (int c = F.tid; c < 128 * 16; c += NTHR) { const int dk = c >> 4, ch = c & 15;
            *(LAS v4u*)(Sf + dk * HP + ch * 8) = *(const v4u*)(SST + (size_t)unf * 16384 + dk * 128 + ch * 8);
            *(LAS v4u*)(Sw + dk * HP + ch * 8) = *(const v4u*)(SST + (size_t)unb * 16384 + dk * 128 + ch * 8); }
        __syncthreads();
        const float* ng = in_ptr(I_HNG) + h * 128;
#pragma unroll 1
        for (int mq = 0; mq < 2; ++mq) {
            const size_t tok = (size_t)(b * SEQ + tile * 256 + F.wave * 32 + 16 * mq + r);
            const bf16* qsf = (const bf16*)(F.ws + WS_QSF) + tok * 512 + h * 128 + 8 * q; const bf16* qsb = (const bf16*)(F.ws + WS_QSB) + tok * 512 + h * 128 + 8 * q;
            bf16x8 ff[4], fb[4];
#pragma unroll
            for (int ks = 0; ks < 4; ++ks) { ff[ks] = *(const bf16x8*)(qsf + 32 * ks); fb[ks] = *(const bf16x8*)(qsb + 32 * ks); }
            f32x4 o[8]; float ss = 0.f;
            const size_t rb = tok * 512 + h * 128 + 4 * q;
#pragma unroll
            for (int nd = 0; nd < 8; ++nd) { f32x4 a = (f32x4){0.f, 0.f, 0.f, 0.f}; const int cb = 16 * nd + 4 * pp;
#pragma unroll
                for (int ks = 0; ks < 4; ++ks) { a = __builtin_amdgcn_mfma_f32_16x16x32_bf16(tr8(Sf + (32 * ks + 8 * q + qp) * HP + cb, Sf + (32 * ks + 8 * q + 4 + qp) * HP + cb), ff[ks], a, 0, 0, 0);
                    a = __builtin_amdgcn_mfma_f32_16x16x32_bf16(tr8(Sw + (32 * ks + 8 * q + qp) * HP + cb, Sw + (32 * ks + 8 * q + 4 + qp) * HP + cb), fb[ks], a, 0, 0, 0); }
                const v2u lf = *(const v2u*)((const bf16*)(F.ws + WS_OLF) + rb + 16 * nd), lw = *(const v2u*)((const bf16*)(F.ws + WS_OLB) + rb + 16 * nd);
                a[0] += bflo(lf.x) + bflo(lw.x); a[1] += bfhi(lf.x) + bfhi(lw.x); a[2] += bflo(lf.y) + bflo(lw.y); a[3] += bfhi(lf.y) + bfhi(lw.y);
                ss += (a[0] * a[0] + a[1] * a[1]) + (a[2] * a[2] + a[3] * a[3]); o[nd] = a; }
            ss += __shfl_xor(ss, 16); ss += __shfl_xor(ss, 32);
            const float rs = 1.0f / sqrtf(ss * (1.0f / 128.0f) + LN_EPS);
#pragma unroll
            for (int nd = 0; nd < 8; ++nd) { const f32x4 gn = *(const f32x4*)(ng + 16 * nd + 4 * q); const v2u gw = *(const v2u*)((const bf16*)(F.ws + WS_Q + 4 * SEC_STRIDE) + rb + 16 * nd);
                f32x4 y; y[0] = o[nd][0] * rs * gn[0] * bflo(gw.x); y[1] = o[nd][1] * rs * gn[1] * bfhi(gw.x); y[2] = o[nd][2] * rs * gn[2] * bflo(gw.y); y[3] = o[nd][3] * rs * gn[3] * bfhi(gw.y);
                v2u wv; wv.x = cvt_pk_bf16(y[0], y[1]); wv.y = cvt_pk_bf16(y[2], y[3]); *(v2u*)((bf16*)(F.ws + WS_HO) + rb + 16 * nd) = wv; }
        }
    }
    __syncthreads();
}
#ifndef LEVEL
#define LEVEL 4
#endif
struct Args { const float* in[29]; float* out; unsigned char* ws; };
__global__ void __launch_bounds__(NTHR, 2) fwd(Args args) {
    extern __shared__ __attribute__((aligned(16))) unsigned char lds[];
    Frame F;
    F.lds = (LAS unsigned char*)lds;
    F.tid = threadIdx.x; F.lane = F.tid & 63; F.wave = __builtin_amdgcn_readfirstlane(F.tid >> 6);
    F.G = gridDim.x; F.bid = blockIdx.x;
    F.ws = args.ws; F.ctl = (unsigned*)(args.ws + WS_CTL); F.out = args.out;
    if (F.tid < 64) ((LAS unsigned*)(F.lds + LDSCTL_OFF))[F.tid] = 0u;
    __syncthreads();
    XcdBarrier bar = xcd_barrier_post(F.ctl + CW_BAR, (volatile LAS unsigned*)(F.lds + LDSCTL_OFF + 32));
#define GRID_BAR() xcd_barrier(bar)

    p0_prologue(F);
    GRID_BAR();
#if LEVEL == 0
    p_scale_copy(F, (const bf16*)(F.ws + WS_H0), (float*)(F.ws + WS_S1));
    GRID_BAR();
#else
    p_proj(F);
    p_kv(F);
    GRID_BAR();
    p_xattn(F);
#if LEVEL >= 4
    p_dft<1>(F);
    p_hgrn1(F);
    GRID_BAR();
    p_dft<3>(F);
    p_hgrn_scan(F);
    GRID_BAR();
    p_hgrn2(F);
    GRID_BAR();
    p_branch(F, WS_FM, WS_WFO, in_ptr(I_BFO), 0, 1);
    p_branch(F, WS_HO, WS_WHO, nullptr, 1, 0);
    p_branch(F, WS_XO, WS_WXO, nullptr, 2, 0);
#elif LEVEL >= 3
    p_dft<1>(F);
    GRID_BAR();
    p_dft<3>(F);
    GRID_BAR();
    p_branch(F, WS_FM, WS_WFO, in_ptr(I_BFO), 0, 1);
    p_branch(F, WS_XO, WS_WXO, nullptr, 2, 0);
#else
    GRID_BAR();
    p_branch(F, WS_XO, WS_WXO, nullptr, 2, 1);
#endif
    GRID_BAR();
    p_wout(F);
    GRID_BAR();
#endif
    p_ln1(F);
#if LEVEL >= 2
    p_convert_experts(F);
#endif
    GRID_BAR();
#if LEVEL < 2
    p_scale_copy(F, (const bf16*)(F.ws + WS_H1), (float*)(F.ws + WS_S2));
    GRID_BAR();
    p_final<false>(F);
#else
    p_router_shared(F);
    GRID_BAR();
    p_routing(F);
    GRID_BAR();
    p_fill(F);
    p_shared_down(F);
    GRID_BAR();
    p_exp_gu(F);
    GRID_BAR();
    p_exp_down(F);
    GRID_BAR();
    p_final<true>(F);
#endif
}

extern "C" void kernel_launch(void* const* d_in, const int* in_sizes, int n_in, void* d_out, int out_size, void* d_ws, size_t ws_size, hipStream_t stream) {
    static int grid = 0;
    if (grid == 0) {
        int dev = 0, cus = 0, per_cu = 0;
        if (n_in != 29 || ws_size < WS_END) { fprintf(stderr, "kernel_launch: unexpected n_in %d / ws_size %zu\n", n_in, ws_size); }
        if (hipGetDevice(&dev) != hipSuccess || hipDeviceGetAttribute(&cus, hipDeviceAttributeMultiprocessorCount, dev) != hipSuccess) { grid = -1; return; }
        if (hipFuncSetAttribute((const void*)fwd, hipFuncAttributeMaxDynamicSharedMemorySize, LDS_BYTES) != hipSuccess) { grid = -1; return; }
        if (hipOccupancyMaxActiveBlocksPerMultiprocessor(&per_cu, (const void*)fwd, NTHR, LDS_BYTES) != hipSuccess || per_cu < 1) fprintf(stderr, "kernel_launch: occupancy query says %d\n", per_cu);
        (void)hipGetLastError();
        grid = cus;
    }
    if (grid < 0) return;
    (void)hipMemsetAsync((char*)d_ws + WS_CTL, 0, CTL_ZERO_BYTES, stream);
    Args a{};
    for (int i = 0; i < 29; ++i) a.in[i] = (const float*)d_in[i];
    a.out = (float*)d_out; a.ws = (unsigned char*)d_ws;
    hipLaunchKernelGGL(fwd, dim3(grid), dim3(NTHR), LDS_BYTES, stream, a);
}
```

```cpp
#define DUP 0
#include <hip/hip_runtime.h>
#include <cstdio>
#include <cstdint>

#define GAS __attribute__((address_space(1)))
#define LAS __attribute__((address_space(3)))
typedef unsigned short bf16;
typedef unsigned v4u __attribute__((ext_vector_type(4)));
typedef unsigned v2u __attribute__((ext_vector_type(2)));
typedef float f32x4 __attribute__((ext_vector_type(4)));
typedef float f32x2 __attribute__((ext_vector_type(2)));
typedef short bf16x8 __attribute__((ext_vector_type(8)));
typedef short s16x4 __attribute__((ext_vector_type(4)));

constexpr int NB = 4, SEQ = 8192, D = 1024, T = NB * SEQ, MEM = 256;
constexpr int NPROJ = 7168;
constexpr int NE = 256, TOPK = 8, FF = 256;
constexpr float LN_EPS = 1e-5f;
constexpr float ALPHA = 1.189207115002721f;
constexpr int NWAVES = 8, NTHR = 512;
constexpr int SEG = 512, NSEG = SEQ / SEG, CH = 64;

constexpr size_t MiB = 1u << 20;
constexpr size_t WS_CTL = 0, CTL_ZERO_BYTES = 1 * MiB;
constexpr size_t WS_WIN = 1 * MiB;
constexpr size_t WS_WKV = 15 * MiB;
constexpr size_t WS_WFO = 17 * MiB;
constexpr size_t WS_WHO = 18 * MiB;
constexpr size_t WS_WXO = 19 * MiB;
constexpr size_t WS_WOUT = 20 * MiB;
constexpr size_t WS_WRS = 22 * MiB;
constexpr size_t WS_WSD = 24 * MiB;
constexpr size_t WS_A1 = 25 * MiB;
constexpr size_t WS_A3 = 26 * MiB;
constexpr size_t WS_MEMN = 30 * MiB;
constexpr size_t WS_EXPD = 32 * MiB;
constexpr size_t WS_H0 = 32 * MiB;
constexpr size_t WS_F = 96 * MiB;
constexpr size_t WS_MIX = 883 * MiB;
constexpr size_t WS_WBR = 17 * MiB;
constexpr size_t WS_Q = 160 * MiB;
constexpr size_t SEC_STRIDE = 32 * MiB;
constexpr size_t WS_S1 = 160 * MiB;
constexpr size_t WS_HACT = 160 * MiB;
constexpr size_t WS_GATES = 352 * MiB;
constexpr size_t WS_S2 = 320 * MiB;
constexpr size_t WS_ROUTE = 448 * MiB;
constexpr size_t WS_KV = 544 * MiB;
constexpr size_t WS_Y = 546 * MiB;
constexpr size_t WS_FM = 610 * MiB;
constexpr size_t WS_OLF = 642 * MiB, WS_OLB = 674 * MiB;
constexpr size_t WS_QSF = 706 * MiB, WS_QSB = 738 * MiB;
constexpr size_t WS_U = 770 * MiB;
constexpr size_t WS_DEC = 802 * MiB;
constexpr size_t WS_SST = 803 * MiB;
constexpr size_t WS_HO = 819 * MiB;
constexpr size_t WS_XO = 851 * MiB;
constexpr size_t WS_MERGED = 96 * MiB;
constexpr size_t WS_EXPGU = 512 * MiB;
constexpr size_t WS_H1 = 768 * MiB;
constexpr size_t WS_LOGIT = 832 * MiB;
constexpr size_t WS_HS = 864 * MiB;
constexpr size_t WS_YR = 512 * MiB;
constexpr size_t WS_END = 1024 * MiB;
constexpr size_t RT_EIDX = 0, RT_WGT = 1 * MiB, RT_POS = 2 * MiB, RT_ROWTOK = 3 * MiB, RT_ROWSLOT = 5 * MiB, RT_ROWGATE = 6 * MiB + 512 * 1024, RT_TRASH = 7 * MiB + 768 * 1024;
constexpr int RPAD_MAX = T * TOPK + NE * 255;
constexpr int CW_BAR = 4096;
constexpr int CW_CNT = 16384;

#define LDS_WAIT() asm volatile("s_waitcnt lgkmcnt(0)" ::: "memory")
#define VM_WAIT() asm volatile("s_waitcnt vmcnt(0)" ::: "memory")
typedef __bf16 bf16x2v __attribute__((ext_vector_type(2)));
__device__ __forceinline__ unsigned cvt_pk_bf16_c(float lo, float hi) { const f32x2 v = {lo, hi}; const bf16x2v b = __builtin_convertvector(v, bf16x2v); return __builtin_bit_cast(unsigned, b); }
__device__ __forceinline__ unsigned cvt_pk_bf16(float lo, float hi) { unsigned r; asm volatile("v_cvt_pk_bf16_f32 %0, %1, %2" : "=v"(r) : "v"(lo), "v"(hi)); return r; }
__device__ __forceinline__ float bflo(unsigned w) { return __uint_as_float(w << 16); }
__device__ __forceinline__ float bfhi(unsigned w) { return __uint_as_float(w & 0xffff0000u); }
__device__ __forceinline__ float bf2f(bf16 h) { return __uint_as_float(((unsigned)h) << 16); }
__device__ __forceinline__ bf16 f2bf(float f) { return (bf16)(cvt_pk_bf16(f, 0.f) & 0xffffu); }
__device__ __forceinline__ float sigmoidf_(float x) { return __builtin_amdgcn_rcpf(1.0f + __builtin_amdgcn_exp2f(-1.4426950408889634f * x)); }
__device__ __forceinline__ float siluf_(float x) { return x * __builtin_amdgcn_rcpf(1.0f + __builtin_amdgcn_exp2f(-1.4426950408889634f * x)); }
__device__ __forceinline__ float wave_sum(float v) {
#pragma unroll
    for (int o = 1; o < 64; o <<= 1) v += __shfl_xor(v, o);
    return v;
}

#define XB_TMO      128
#define XB_XCNT(j)  (256  + 64 * (j))
#define XB_XSUB(j)  (1280 + 64 * (j))
#define XB_XGEN(j)  (2304 + 64 * (j))
#define XB_TOP      3328
#define XB_TOPGEN   3392
#define XCD_BAR_WORDS 3456
#define XB_SPIN_CAP (1u << 22)
__device__ __forceinline__ unsigned xb_ld(unsigned* p)              { return __hip_atomic_load(p, __ATOMIC_RELAXED, __HIP_MEMORY_SCOPE_AGENT); }
__device__ __forceinline__ unsigned xb_add(unsigned* p, unsigned v) { return __hip_atomic_fetch_add(p, v, __ATOMIC_RELAXED, __HIP_MEMORY_SCOPE_AGENT); }
__device__ __forceinline__ unsigned xb_xcc_id() { return (unsigned)__builtin_amdgcn_s_getreg((3 << 11) | 20) & 0xFu; }
#define XB_SPIN(cond, bar) do { unsigned _sp = 0; while (cond) { __builtin_amdgcn_s_sleep(1); \
    if ((++_sp & 255u) == 0u) { if (xb_ld(&(bar)[XB_TMO])) break; if (_sp > XB_SPIN_CAP) { atomicAdd(&(bar)[XB_TMO], 1u); break; } } } } while (0)
struct XcdBarrier { unsigned* bar; unsigned x; volatile LAS unsigned* st; };
__device__ __forceinline__ XcdBarrier xcd_barrier_post(unsigned* bar, volatile LAS unsigned* st) {
    XcdBarrier b; b.bar = bar; b.x = xb_xcc_id(); b.st = st;
    if (threadIdx.x == 0) (void)xb_add(&bar[XB_XCNT(b.x)], 1u);
    return b;
}
__device__ __forceinline__ void xcd_barrier_complete(unsigned* bar, unsigned x, unsigned& nloc, unsigned& nx) {
    const unsigned G = gridDim.x * gridDim.y * gridDim.z;
    unsigned sum, cnt, mine, sp = 0u;
    for (;;) {
        sum = 0u; cnt = 0u; mine = 0u;
#pragma unroll
        for (unsigned j = 0; j < 16; ++j) { const unsigned c = xb_ld(&bar[XB_XCNT(j)]); sum += c; cnt += (c > 0u) ? 1u : 0u; mine = (j == x) ? c : mine; }
        if (sum == G) break;
        __builtin_amdgcn_s_sleep(1);
        if ((++sp & 255u) == 0u) { if (xb_ld(&bar[XB_TMO])) break; if (sp > XB_SPIN_CAP) { atomicAdd(&bar[XB_TMO], 1u); break; } }
    }
    nloc = mine > 0u ? mine : 1u; nx = cnt > 0u ? cnt : 1u;
}
__device__ __forceinline__ void xcd_barrier(const XcdBarrier& b) {
    asm volatile("s_waitcnt vmcnt(0)" ::: "memory");
    __syncthreads();
    if (threadIdx.x == 0) {
        unsigned* bar = b.bar;
        __builtin_amdgcn_s_waitcnt(0);
        unsigned nloc = b.st[0], nx = b.st[1];
        if (nloc == 0u) { xcd_barrier_complete(bar, b.x, nloc, nx); b.st[0] = nloc; b.st[1] = nx; }
        const unsigned old = xb_add(&bar[XB_XSUB(b.x)], 1u);
        const unsigned gen = old / nloc;
        if (old + 1u == (gen + 1u) * nloc) {
            __builtin_amdgcn_fence(__ATOMIC_RELEASE, "agent");
            asm volatile("s_waitcnt vmcnt(0)" ::: "memory");
            const unsigned og = xb_add(&bar[XB_TOP], 1u);
            const unsigned tg = og / nx;
            if (og + 1u == (tg + 1u) * nx) xb_add(&bar[XB_TOPGEN], 1u);
            else XB_SPIN(xb_ld(&bar[XB_TOPGEN]) == tg, bar);
            __builtin_amdgcn_fence(__ATOMIC_ACQUIRE, "agent");
            xb_add(&bar[XB_XGEN(b.x)], 1u);
            asm volatile("s_waitcnt vmcnt(0)" ::: "memory");
        } else {
            XB_SPIN(xb_ld(&bar[XB_XGEN(b.x)]) == gen, bar);
            __builtin_amdgcn_fence(__ATOMIC_ACQUIRE, "agent");
            asm volatile("s_waitcnt vmcnt(0)" ::: "memory");
        }
    }
    __syncthreads();
}

namespace pg8 {
constexpr int BM = 256, BK = 64, HALF = 128, HTB = HALF * BK * 2, STAGE_BYTES = 8 * HTB, NXCD = 8, WGM = 8;
__host__ __device__ __forceinline__ int lds_byte(int r, int c) { const int st = (r >> 4) * 2 + (c >> 5), rr = r & 15, cc = c & 31, ob = rr * 64 + cc * 2; return st * 1024 + (ob ^ (((ob >> 9) & 1) << 5)); }
__host__ __device__ __forceinline__ void stage_rc(int b, int& R, int& C) { const int st = b / 1024, sb = b % 1024, swz = sb ^ (((sb >> 9) & 1) << 5); R = (st >> 1) * 16 + swz / 64; C = (st & 1) * 32 + (swz % 64) / 2; }
__host__ __device__ __forceinline__ int perm32(int rho) { const int n = rho >> 4, i = rho & 15; return 8 * (i >> 2) + 4 * n + (i & 3); }
struct Unit { int pm, pn; };
struct Gemm { const bf16* A; const bf16* Bt; int K; };
struct StaticOrder {
    int nM, nN, nwg, G, c;
    __device__ void init(int M, int N, int G_, int c_) { nM = M / BM; nN = N / BM; nwg = nM * nN; G = G_; c = c_; }
    __device__ bool next(int i, Unit& u) const {
        const long L = (long)i * G + c; if (L >= nwg) return false;
        int wgid = (int)L; { const int q = nwg / NXCD, r = nwg % NXCD, xcd = wgid % NXCD, off = wgid / NXCD; wgid = (xcd < r ? xcd * (q + 1) : r * (q + 1) + (xcd - r) * q) + off; }
        const int nig = WGM * nN, gid = wgid / nig, fm = gid * WGM, gsz = (nM - fm) < WGM ? (nM - fm) : WGM;
        u.pm = fm + ((wgid % nig) % gsz); u.pn = (wgid % nig) / gsz; return true;
    }
};
template <int J> struct ExpertOrder {
    int nunits, G, c; const LAS unsigned short* te;
    __device__ bool next(int i, Unit& u) const {
        const int nb = G >> 3, tpx = nb / J, x = c & 7, k = c >> 3;
        int tau, j;
        if ((G & 7) == 0 && tpx * J == nb) { tau = (i * 8 + x) * tpx + k / J; j = k % J; }
        else { const int L = i * G + c; tau = L / J; j = L - tau * J; }
        if (tau * J + j >= nunits) return false;
        u.pm = tau; u.pn = (int)te[tau] * J + j; return true;
    }
};
template <class Epi, class Sched, bool GATHER>
__device__ __forceinline__ void gemm_phase(LAS unsigned char* lds, const Gemm g, const Sched& S, const Epi& E, const int* rowidx) {
    int tid_ = threadIdx.x; asm volatile("" : "+v"(tid_));
    const int tid = tid_, wid = __builtin_amdgcn_readfirstlane(tid >> 6), lane = tid & 63, wr = wid >> 2, wc = wid & 3, fr = lane & 15, fq = lane >> 4;
    const int K = g.K, nt = K / BK;
    unsigned voffB[2], voffC[2][2];
    LAS v4u* gsl = (LAS v4u*)(lds + STAGE_BYTES + 8192) + tid;
    const size_t kstep = (size_t)(BK * 2);
    const size_t hstep = (size_t)HALF * K * 2;
    const size_t tstep = 2 * hstep;
#pragma unroll
    for (int i = 0; i < 2; ++i) { int R, C; stage_rc(tid * 16 + i * 8192, R, C); const int Rb = Epi::PERM ? ((R & ~31) + perm32(R & 31)) : R;
        voffB[i] = (unsigned)(Rb * K + C) * 2u; voffC[0][i] = (unsigned)(R * K + C) * 2u; voffC[1][i] = voffC[0][i] + (unsigned)hstep; }
    const unsigned ldsw = (unsigned)wid * 1024u;
    const int aoff = lds_byte(wr * 64 + fr, fq * 8), boff = lds_byte(wc * 32 + fr, fq * 8);
#define PG8_SA(b, h) (((b) * 2 + (h)) * HTB)
#define PG8_SB(b, h) ((4 + (b) * 2 + (h)) * HTB)
#define PG8_STAGE(bufoff, gbase, voff) do { const char* _gb = (const char*)(gbase); _Pragma("unroll") for (int _i = 0; _i < 2; ++_i) { unsigned _keep; \
        asm volatile("s_mov_b32 %0, m0\n\ts_mov_b32 m0, %3\n\ts_nop 0\n\tglobal_load_lds_dwordx4 %1, %2\n\ts_mov_b32 m0, %0" : "=&s"(_keep) : "v"((voff)[_i]), "s"(_gb), "s"((unsigned)(size_t)(lds + (bufoff) + ldsw + _i * 8192)) : "memory"); } } while (0)
#define PG8_LDA(dst, b, h) do { _Pragma("unroll") for (int m = 0; m < 4; ++m) _Pragma("unroll") for (int k = 0; k < 2; ++k) dst[m][k] = *(const LAS bf16x8*)(lds + PG8_SA(b, h) + aoff + m * 2048 + k * 1024); } while (0)
#define PG8_LDB(dst, b, h) do { _Pragma("unroll") for (int n = 0; n < 2; ++n) _Pragma("unroll") for (int k = 0; k < 2; ++k) dst[n][k] = *(const LAS bf16x8*)(lds + PG8_SB(b, h) + boff + n * 2048 + k * 1024); } while (0)
#define PG8_MMA(ai, bj, At, Bt) do { __builtin_amdgcn_s_setprio(1); _Pragma("unroll") for (int m = 0; m < 4; ++m) _Pragma("unroll") for (int n = 0; n < 2; ++n) _Pragma("unroll") for (int k = 0; k < 2; ++k) \
        acc[ai][bj][m][n] = __builtin_amdgcn_mfma_f32_16x16x32_bf16(Bt[n][k], At[m][k], acc[ai][bj][m][n], 0, 0, 0); __builtin_amdgcn_s_setprio(0); } while (0)
#define PG8_WAIT_V(n) asm volatile("s_waitcnt vmcnt(" #n ")" ::: "memory")
#define PG8_WAIT_L(n) asm volatile("s_waitcnt lgkmcnt(" #n ")" ::: "memory")
#define PG8_BAR __builtin_amdgcn_s_barrier()
#define PG8_SCHED __builtin_amdgcn_sched_barrier(0)
#define PG8_GSTORE(set, u) do { unsigned _v[2][2]; _Pragma("unroll") for (int _i = 0; _i < 2; ++_i) { int _R, _C; stage_rc(tid * 16 + _i * 8192, _R, _C); \
        _Pragma("unroll") for (int _h = 0; _h < 2; ++_h) _v[_h][_i] = ((unsigned)rowidx[(u).pm * BM + _h * HALF + _R] * (unsigned)K + (unsigned)_C) * 2u; } \
        gsl[(set) * 512] = (v4u){_v[0][0], _v[0][1], _v[1][0], _v[1][1]}; } while (0)
#define PG8_GRD(dst, h, set) unsigned dst[2]; do { if constexpr (GATHER) { const v2u _o = ((const LAS v2u*)(gsl + (set) * 512))[h]; dst[0] = _o.x; dst[1] = _o.y; } else { dst[0] = voffC[h][0]; dst[1] = voffC[h][1]; } } while (0)
    Unit cur, nxt; int ui = 0;
    if (!S.next(0, cur)) return;
    f32x4 acc[2][2][4][2];
#pragma unroll
    for (int a = 0; a < 2; ++a)
#pragma unroll
        for (int b = 0; b < 2; ++b)
#pragma unroll
            for (int m = 0; m < 4; ++m)
#pragma unroll
                for (int n = 0; n < 2; ++n) acc[a][b][m][n] = (f32x4){0.f, 0.f, 0.f, 0.f};
    bf16x8 At[4][2], B0[2][2], B1[2][2];
    const char* cA = GATHER ? (const char*)g.A : (const char*)g.A + (size_t)cur.pm * tstep; const char* cB = (const char*)g.Bt + (size_t)cur.pn * tstep;
    int par = 0;
    LAS v2u* const rib = (LAS v2u*)(lds + STAGE_BYTES + 2560);
    if constexpr (GATHER) { PG8_GSTORE(0, cur); }
    if constexpr (Epi::PRE) E.pre(cur, rib, tid);
    { PG8_GRD(p0, 0, 0); PG8_GRD(p1, 1, 0);
    PG8_STAGE(PG8_SB(0, 0), cB, voffB); PG8_STAGE(PG8_SB(0, 1), cB + hstep, voffB); PG8_STAGE(PG8_SA(0, 0), cA, p0); PG8_STAGE(PG8_SA(0, 1), cA, p1);
    if (wr == 1) PG8_BAR;
    PG8_WAIT_V(2); PG8_BAR;
    PG8_STAGE(PG8_SB(1, 0), cB + kstep, voffB); PG8_STAGE(PG8_SA(1, 0), cA + kstep, p0); PG8_STAGE(PG8_SB(1, 1), cB + hstep + kstep, voffB); }
    PG8_WAIT_V(6); PG8_BAR;
    for (;;) {
        const bool has_next = S.next(ui + 1, nxt);
        const char* nA = GATHER ? (const char*)g.A : (has_next ? (const char*)g.A + (size_t)nxt.pm * tstep : cA); const char* nB = has_next ? (const char*)g.Bt + (size_t)nxt.pn * tstep : cB;
        if constexpr (GATHER) { if (has_next) { PG8_GSTORE(par ^ 1, nxt); } else { gsl[(par ^ 1) * 512] = gsl[par * 512]; } }
        for (int t = 0; t < nt; t += 2) {
            const bool last = (t == nt - 2);
            const char* a1 = cA + (size_t)(t + 1) * kstep;
            const char* a2 = last ? nA : cA + (size_t)(t + 2) * kstep; const char* b2 = last ? nB : cB + (size_t)(t + 2) * kstep;
            const char* a3 = a2 + kstep; const char* b3 = b2 + kstep;
            const int s2 = (GATHER && last) ? (par ^ 1) : par;
            { PG8_GRD(o, 1, par); PG8_LDB(B0, 0, 0); PG8_LDB(B1, 0, 1); PG8_SCHED; PG8_LDA(At, 0, 0); PG8_STAGE(PG8_SA(1, 1), a1, o); }
            PG8_WAIT_V(8); PG8_WAIT_L(0); PG8_BAR; PG8_MMA(0, 0, At, B0); PG8_MMA(0, 1, At, B1); PG8_BAR; PG8_SCHED;
            { PG8_GRD(o, 0, s2); PG8_LDA(At, 0, 1); PG8_STAGE(PG8_SB(0, 0), b2, voffB); PG8_STAGE(PG8_SB(0, 1), b2 + hstep, voffB); PG8_STAGE(PG8_SA(0, 0), a2, o); }
            PG8_WAIT_V(8); PG8_WAIT_L(0); PG8_BAR; PG8_MMA(1, 0, At, B0); PG8_MMA(1, 1, At, B1); PG8_BAR; PG8_SCHED;
            { PG8_GRD(o, 1, s2); PG8_LDB(B0, 1, 0); PG8_LDB(B1, 1, 1); PG8_SCHED; PG8_LDA(At, 1, 0); PG8_STAGE(PG8_SA(0, 1), a2, o); }
            PG8_WAIT_V(8); PG8_WAIT_L(0); PG8_BAR; PG8_MMA(0, 0, At, B0); PG8_MMA(0, 1, At, B1); PG8_BAR; PG8_SCHED;
            { PG8_GRD(o, 0, s2); PG8_LDA(At, 1, 1); PG8_STAGE(PG8_SB(1, 0), b3, voffB); PG8_STAGE(PG8_SB(1, 1), b3 + hstep, voffB); PG8_STAGE(PG8_SA(1, 0), a3, o); }
            PG8_WAIT_V(8); PG8_WAIT_L(0); PG8_BAR; PG8_MMA(1, 0, At, B0); PG8_MMA(1, 1, At, B1); PG8_BAR; PG8_SCHED;
        }
        if (wr == 0) PG8_BAR;
        asm volatile("s_nop 15\n\ts_nop 15" ::: "memory");
        if constexpr (Epi::PRE) E(acc, cur, wr, wc, fr, fq, rib + par * 256); else E(acc, cur, wr, wc, fr, fq);
        if (!has_next) break;
        bool zero = true;
        if constexpr (Epi::CHAIN) zero = !E.keep(cur);
        if (zero) {
#pragma unroll
        for (int a = 0; a < 2; ++a)
#pragma unroll
            for (int b = 0; b < 2; ++b)
#pragma unroll
                for (int m = 0; m < 4; ++m)
#pragma unroll
                    for (int n = 0; n < 2; ++n) acc[a][b][m][n] = (f32x4){0.f, 0.f, 0.f, 0.f};
        }
        cur = nxt; cA = nA; cB = nB; ++ui; par ^= 1;
        if constexpr (Epi::PRE) E.pre(cur, rib + par * 256, tid);
        if (wr == 1) PG8_BAR;
    }
    PG8_WAIT_V(0);
    PG8_BAR;
#undef PG8_SA
#undef PG8_SB
#undef PG8_STAGE
#undef PG8_LDA
#undef PG8_LDB
#undef PG8_MMA
#undef PG8_WAIT_V
#undef PG8_WAIT_L
#undef PG8_BAR
#undef PG8_SCHED
#undef PG8_GSTORE
#undef PG8_GRD
}
}
using pg8::Unit;

typedef f32x4 AccT[2][2][4][2];
__device__ __forceinline__ v4u pack8(const f32x4 a, const f32x4 b) { v4u w; w.x = cvt_pk_bf16(a[0], a[1]); w.y = cvt_pk_bf16(a[2], a[3]); w.z = cvt_pk_bf16(b[0], b[1]); w.w = cvt_pk_bf16(b[2], b[3]); return w; }

struct EpiProj {
    static constexpr bool PERM = true, PRE = false, CHAIN = false;
    bf16* F; bf16* SEC; bf16* GATES; const float* bgate;
    __device__ __forceinline__ void operator()(const AccT& acc, const Unit& u, int wr, int wc, int fr, int fq) const {
        const int pn = u.pn; bf16* base; int ldc, colt, mode;
        if (pn < 4) { base = F; ldc = 1024; colt = pn * 256; mode = 0; }
        else if (pn < 16) { const int s = (pn - 4) >> 1; base = SEC + (size_t)s * (SEC_STRIDE / 2); ldc = 512; colt = ((pn - 4) & 1) * 256; mode = (s == 0 || s == 4) ? 1 : (s == 5 ? 3 : 0); }
        else { base = GATES; ldc = 3072; colt = (pn - 16) * 256; mode = 2; }
        const int row0 = u.pm * 256 + wr * 64 + fr, col0 = colt + wc * 32 + 8 * fq;
        f32x4 bv[2][2];
#pragma unroll
        for (int bj = 0; bj < 2; ++bj)
#pragma unroll
            for (int n = 0; n < 2; ++n) bv[bj][n] = (mode == 2) ? *(const f32x4*)(bgate + col0 + bj * 128 + 4 * n) : (f32x4){0.f, 0.f, 0.f, 0.f};
#pragma unroll
        for (int ai = 0; ai < 2; ++ai)
#pragma unroll
            for (int m = 0; m < 4; ++m) { bf16* rowp = base + (size_t)(row0 + ai * 128 + m * 16) * ldc + col0;
#pragma unroll
                for (int bj = 0; bj < 2; ++bj) { f32x4 v0 = acc[ai][bj][m][0] + bv[bj][0], v1 = acc[ai][bj][m][1] + bv[bj][1];
                    if (mode == 1) {
#pragma unroll
                        for (int j = 0; j < 4; ++j) { v0[j] = siluf_(v0[j]); v1[j] = siluf_(v1[j]); } }
                    else if (mode == 2) {
#pragma unroll
                        for (int j = 0; j < 4; ++j) { v0[j] = sigmoidf_(v0[j]); v1[j] = sigmoidf_(v1[j]); } }
                    else if (mode == 3) { v0 = v0 * 0.12751743f; v1 = v1 * 0.12751743f; }
                    *(v4u*)(rowp + bj * 128) = pack8(v0, v1); } }
    }
};
struct EpiPlain {
    static constexpr bool PERM = true, PRE = false, CHAIN = false;
    bf16* O; int ldc;
    __device__ __forceinline__ void operator()(const AccT& acc, const Unit& u, int wr, int wc, int fr, int fq) const {
        const int row0 = u.pm * 256 + wr * 64 + fr, col0 = u.pn * 256 + wc * 32 + 8 * fq;
#pragma unroll
        for (int ai = 0; ai < 2; ++ai)
#pragma unroll
            for (int m = 0; m < 4; ++m) { bf16* rowp = O + (size_t)(row0 + ai * 128 + m * 16) * ldc + col0;
#pragma unroll
                for (int bj = 0; bj < 2; ++bj) *(v4u*)(rowp + bj * 128) = pack8(acc[ai][bj][m][0], acc[ai][bj][m][1]); }
    }
};
struct EpiMix {
    static constexpr bool PERM = true, PRE = false, CHAIN = true;
    bf16* M; const bf16* gates; const float* bias;
    static __device__ __forceinline__ float rt(float n, float d) { return fmaxf(n, 1e-7f) * __builtin_amdgcn_rcpf(fmaxf(d, 1e-7f)); }
    __device__ __forceinline__ bool keep(const Unit& u) const { return (u.pn >> 2) < 2; }
    __device__ __forceinline__ void operator()(AccT& acc, const Unit& u, int wr, int wc, int fr, int fq) const {
        const int s = u.pn >> 2, row0 = (u.pm & 127) * 256 + wr * 64 + fr, col0 = (u.pn & 3) * 256 + wc * 32 + 8 * fq;
        if (s < 2) {
#pragma unroll
            for (int bj = 0; bj < 2; ++bj) {
                f32x4 b0 = (f32x4){0.f, 0.f, 0.f, 0.f}, b1 = b0;
                if (s == 0) { b0 = *(const f32x4*)(bias + col0 + bj * 128); b1 = *(const f32x4*)(bias + col0 + bj * 128 + 4); }
#pragma unroll
                for (int ai = 0; ai < 2; ++ai)
#pragma unroll
                    for (int m = 0; m < 4; ++m) { const bf16* gp = gates + (size_t)(row0 + ai * 128 + m * 16) * 3072 + s * 1024 + col0 + bj * 128;
                        const v4u gn = *(const v4u*)gp, gd = *(const v4u*)(gp + 1024);
                        f32x4 r0, r1;
                        r0[0] = rt(bflo(gn.x), bflo(gd.x)); r0[1] = rt(bfhi(gn.x), bfhi(gd.x)); r0[2] = rt(bflo(gn.y), bflo(gd.y)); r0[3] = rt(bfhi(gn.y), bfhi(gd.y));
                        r1[0] = rt(bflo(gn.z), bflo(gd.z)); r1[1] = rt(bfhi(gn.z), bfhi(gd.z)); r1[2] = rt(bflo(gn.w), bflo(gd.w)); r1[3] = rt(bfhi(gn.w), bfhi(gd.w));
                        acc[ai][bj][m][0] = (acc[ai][bj][m][0] + b0) * r0; acc[ai][bj][m][1] = (acc[ai][bj][m][1] + b1) * r1;
                        asm volatile("" ::: "memory"); }
            }
        } else {
#pragma unroll
            for (int ai = 0; ai < 2; ++ai)
#pragma unroll
                for (int m = 0; m < 4; ++m) { const size_t row = (size_t)(row0 + ai * 128 + m * 16);
#pragma unroll
                    for (int bj = 0; bj < 2; ++bj) { const v4u gw = *(const v4u*)(gates + row * 3072 + 2048 + col0 + bj * 128);
                        const f32x4 v0 = acc[ai][bj][m][0], v1 = acc[ai][bj][m][1]; f32x4 o0, o1;
                        o0[0] = fmaxf(bflo(gw.x), 1e-7f) * v0[0]; o0[1] = fmaxf(bfhi(gw.x), 1e-7f) * v0[1]; o0[2] = fmaxf(bflo(gw.y), 1e-7f) * v0[2]; o0[3] = fmaxf(bfhi(gw.y), 1e-7f) * v0[3];
                        o1[0] = fmaxf(bflo(gw.z), 1e-7f) * v1[0]; o1[1] = fmaxf(bfhi(gw.z), 1e-7f) * v1[1]; o1[2] = fmaxf(bflo(gw.w), 1e-7f) * v1[2]; o1[3] = fmaxf(bfhi(gw.w), 1e-7f) * v1[3];
                        *(v4u*)(M + row * 1024 + col0 + bj * 128) = pack8(o0, o1); } }
        }
    }
};
struct ChainOrder {
    pg8::StaticOrder S;
    __device__ bool next(int i, Unit& u) const { const int ti = i / 3, s = i - 3 * ti; if (!S.next(ti, u)) return false; u.pm += 128 * s; u.pn += 4 * s; return true; }
};
struct EpiResid {
    static constexpr bool PERM = true, PRE = false, CHAIN = false;
    bf16* O; const bf16* R;
    __device__ __forceinline__ void operator()(const AccT& acc, const Unit& u, int wr, int wc, int fr, int fq) const {
        const int row0 = u.pm * 256 + wr * 64 + fr, col0 = u.pn * 256 + wc * 32 + 8 * fq;
#pragma unroll
        for (int ai = 0; ai < 2; ++ai)
#pragma unroll
            for (int m = 0; m < 4; ++m) { const size_t off = (size_t)(row0 + ai * 128 + m * 16) * 1024 + col0;
#pragma unroll
                for (int bj = 0; bj < 2; ++bj) { const v4u rw = *(const v4u*)(R + off + bj * 128);
                    f32x4 o0 = acc[ai][bj][m][0], o1 = acc[ai][bj][m][1];
                    o0[0] += ALPHA * bflo(rw.x); o0[1] += ALPHA * bfhi(rw.x); o0[2] += ALPHA * bflo(rw.y); o0[3] += ALPHA * bfhi(rw.y);
                    o1[0] += ALPHA * bflo(rw.z); o1[1] += ALPHA * bfhi(rw.z); o1[2] += ALPHA * bflo(rw.w); o1[3] += ALPHA * bfhi(rw.w);
                    *(v4u*)(O + off + bj * 128) = pack8(o0, o1); } }
    }
};
struct EpiRouterShared {
    static constexpr bool PERM = true, PRE = false, CHAIN = false;
    float* L; bf16* HS;
    __device__ __forceinline__ void operator()(const AccT& acc, const Unit& u, int wr, int wc, int fr, int fq) const {
        const int row0 = u.pm * 256 + wr * 64 + fr, cl = wc * 32 + 8 * fq;
        if (u.pn == 0) {
#pragma unroll
            for (int ai = 0; ai < 2; ++ai)
#pragma unroll
                for (int m = 0; m < 4; ++m) { float* rowp = L + (size_t)(row0 + ai * 128 + m * 16) * 256 + cl;
#pragma unroll
                    for (int bj = 0; bj < 2; ++bj)
#pragma unroll
                        for (int n = 0; n < 2; ++n) *(f32x4*)(rowp + bj * 128 + 4 * n) = acc[ai][bj][m][n]; }
        } else {
            const int colt = (u.pn - 1) * 128;
#pragma unroll
            for (int ai = 0; ai < 2; ++ai)
#pragma unroll
                for (int m = 0; m < 4; ++m) { bf16* rowp = HS + (size_t)(row0 + ai * 128 + m * 16) * 256 + colt + cl;
                    f32x4 h0, h1;
#pragma unroll
                    for (int j = 0; j < 4; ++j) { h0[j] = siluf_(acc[ai][0][m][0][j]) * acc[ai][1][m][0][j]; h1[j] = siluf_(acc[ai][0][m][1][j]) * acc[ai][1][m][1][j]; }
                    *(v4u*)rowp = pack8(h0, h1); }
        }
    }
};
struct EpiExpGU {
    static constexpr bool PERM = true, PRE = false, CHAIN = false;
    bf16* H;
    __device__ __forceinline__ void operator()(const AccT& acc, const Unit& u, int wr, int wc, int fr, int fq) const {
        const int row0 = u.pm * 256 + wr * 64 + fr, col0 = (u.pn & 1) * 128 + wc * 32 + 8 * fq;
#pragma unroll
        for (int ai = 0; ai < 2; ++ai)
#pragma unroll
            for (int m = 0; m < 4; ++m) { bf16* rowp = H + (size_t)(row0 + ai * 128 + m * 16) * 256 + col0;
                f32x4 h0, h1;
#pragma unroll
                for (int j = 0; j < 4; ++j) { h0[j] = siluf_(acc[ai][0][m][0][j]) * acc[ai][1][m][0][j]; h1[j] = siluf_(acc[ai][0][m][1][j]) * acc[ai][1][m][1][j]; }
                *(v4u*)rowp = pack8(h0, h1); }
    }
};
struct EpiExpDown {
    static constexpr bool PERM = true, PRE = true, CHAIN = false;
    bf16* Y; const v2u* rowinfo; bf16* trash;
    __device__ __forceinline__ void pre(const Unit& u, LAS v2u* ri, int tid) const { if (tid < 256) ri[tid] = rowinfo[(size_t)u.pm * 256 + tid]; }
    __device__ __forceinline__ void operator()(const AccT& acc, const Unit& u, int wr, int wc, int fr, int fq, const LAS v2u* ri) const {
        const int rl0 = wr * 64 + fr, col0 = (u.pn & 3) * 256 + wc * 32 + 8 * fq;
#pragma unroll
        for (int ai = 0; ai < 2; ++ai)
#pragma unroll
            for (int m = 0; m < 4; ++m) { const v2u info = ri[rl0 + ai * 128 + m * 16]; const int slot = (int)info.x; const float gt = __uint_as_float(info.y);
                bf16* rowp = (slot >= 0 ? Y + (size_t)slot * 1024 : trash) + col0;
#pragma unroll
                for (int bj = 0; bj < 2; ++bj) *(v4u*)(rowp + bj * 128) = pack8(acc[ai][bj][m][0] * gt, acc[ai][bj][m][1] * gt); }
    }
};

constexpr int RING_OFF = 0, RING_BYTES = 131072;
constexpr int LDSX_OFF = RING_BYTES;
constexpr int LDS_BYTES = 163840;
constexpr int LDSCTL_OFF = LDS_BYTES - 256;

struct Frame {
    LAS unsigned char* lds;
    unsigned* ctl;
    unsigned char* ws;
    int tid, lane, wave, G, bid;
    float* out;
};
__device__ __forceinline__ const float* in_ptr(int i) { const float* const* ka = (const float* const*)__builtin_amdgcn_kernarg_segment_ptr(); asm volatile("" : "+s"(ka)); return ka[i]; }
enum { I_X = 0, I_MEM, I_LNIG, I_LNIB, I_LNMG, I_LNMB, I_LBF, I_LBB, I_WIN, I_BGATE, I_HNG, I_WKV, I_WFO, I_BFO, I_WHO, I_WXO, I_WOUT, I_LN1G, I_LN1B, I_WR, I_RB, I_WEG, I_WEU, I_WED, I_WSG, I_WSU, I_WSD, I_LN2G, I_LN2B };

__device__ __forceinline__ void tr_item(const float* src0, int lds_, bf16* dst0, int ldd, LAS float* scr, int lane) {
    f32x4 v[8];
#pragma unroll
    for (int i = 0; i < 8; ++i) v[i] = *(const f32x4*)(src0 + (size_t)((lane >> 3) + 8 * i) * lds_ + 4 * (lane & 7));
#pragma unroll
    for (int i = 0; i < 8; ++i) { LAS float* d = scr + ((lane >> 3) + 8 * i) * 33 + 4 * (lane & 7); d[0] = v[i][0]; d[1] = v[i][1]; d[2] = v[i][2]; d[3] = v[i][3]; }
    LDS_WAIT(); asm volatile("" ::: "memory");
    const int c = lane & 7;
#pragma unroll
    for (int j = 0; j < 4; ++j) { const int n = (lane >> 3) + 8 * j; const LAS float* s = scr + (8 * c) * 33 + n;
        v4u o; o.x = cvt_pk_bf16(s[0 * 33], s[1 * 33]); o.y = cvt_pk_bf16(s[2 * 33], s[3 * 33]); o.z = cvt_pk_bf16(s[4 * 33], s[5 * 33]); o.w = cvt_pk_bf16(s[6 * 33], s[7 * 33]);
        *(v4u*)(dst0 + (size_t)n * ldd + 8 * c) = o; }
    LDS_WAIT(); asm volatile("" ::: "memory");
}
__device__ __forceinline__ void conv_matrix(Frame& F, const float* src, size_t mat_stride, int nmat, int K, int ldsrc, int n_lo, int ncols, bf16* dst, int rbase, int rstride, int rmul, int dld = 0, int dko = 0) {
    if (dld == 0) dld = K;
    LAS float* scr = (LAS float*)(F.lds + RING_OFF + F.wave * 16384);
    const int gw = F.bid * NWAVES + F.wave, NGW = F.G * NWAVES;
    const int nkb = K / 64, nnb = ncols / 32, per = nkb * nnb, total = per * nmat;
    for (int it = gw; it < total; it += NGW) {
        const int e = it / per, r = it - e * per, kb = r / nnb, nb = r - kb * nnb, n = nb * 32;
        const int drow = rbase + e * rstride + (n >> 7) * rmul + (n & 127);
        tr_item(src + (size_t)e * mat_stride + (size_t)(kb * 64) * ldsrc + n_lo + n, ldsrc, dst + (size_t)drow * dld + dko + kb * 64, dld, scr, F.lane);
    }
}
__device__ __forceinline__ void ln_row_bf16(const float* xrow, const float* g, const float* b, bf16* orow, int lane) {
    const f32x4* xr = (const f32x4*)xrow + lane;
    f32x4 v[4]; float s = 0.f;
#pragma unroll
    for (int j = 0; j < 4; ++j) { v[j] = xr[64 * j]; s += (v[j][0] + v[j][1]) + (v[j][2] + v[j][3]); }
    const float mean = wave_sum(s) * (1.f / 1024.f); float s2 = 0.f;
#pragma unroll
    for (int j = 0; j < 4; ++j) { v[j] = v[j] - mean; s2 += (v[j][0] * v[j][0] + v[j][1] * v[j][1]) + (v[j][2] * v[j][2] + v[j][3] * v[j][3]); }
    const float rstd = 1.f / sqrtf(wave_sum(s2) * (1.f / 1024.f) + LN_EPS);
    v2u* o8 = (v2u*)orow + lane;
#pragma unroll
    for (int j = 0; j < 4; ++j) { const f32x4 gg = ((const f32x4*)g)[lane + 64 * j], bb = ((const f32x4*)b)[lane + 64 * j]; const f32x4 y = v[j] * rstd * gg + bb;
        v2u w; w.x = cvt_pk_bf16(y[0], y[1]); w.y = cvt_pk_bf16(y[2], y[3]); o8[64 * j] = w; }
}

__device__ __forceinline__ void ln_rowb_bf16(const bf16* xrow, const float* g, const float* b, bf16* orow, int lane) {
    const v2u* xr = (const v2u*)xrow + lane;
    f32x4 v[4]; float s = 0.f;
#pragma unroll
    for (int j = 0; j < 4; ++j) { const v2u w = xr[64 * j]; v[j][0] = bflo(w.x); v[j][1] = bfhi(w.x); v[j][2] = bflo(w.y); v[j][3] = bfhi(w.y); s += (v[j][0] + v[j][1]) + (v[j][2] + v[j][3]); }
    const float mean = wave_sum(s) * (1.f / 1024.f); float s2 = 0.f;
#pragma unroll
    for (int j = 0; j < 4; ++j) { v[j] = v[j] - mean; s2 += (v[j][0] * v[j][0] + v[j][1] * v[j][1]) + (v[j][2] * v[j][2] + v[j][3] * v[j][3]); }
    const float rstd = 1.f / sqrtf(wave_sum(s2) * (1.f / 1024.f) + LN_EPS);
    v2u* o8 = (v2u*)orow + lane;
#pragma unroll
    for (int j = 0; j < 4; ++j) { const f32x4 gg = ((const f32x4*)g)[lane + 64 * j], bb = ((const f32x4*)b)[lane + 64 * j]; const f32x4 y = v[j] * rstd * gg + bb;
        v2u w; w.x = cvt_pk_bf16(y[0], y[1]); w.y = cvt_pk_bf16(y[2], y[3]); o8[64 * j] = w; }
}
__device__ __forceinline__ void p0_prologue(Frame& F) {
    const int gw = F.bid * NWAVES + F.wave, NGW = F.G * NWAVES;
    unsigned char* ws = F.ws;
    conv_matrix(F, in_ptr(I_WIN), 0, 1, 1024, 6656, 512, 6144, (bf16*)(ws + WS_WIN), 1024, 0, 128);
    conv_matrix(F, in_ptr(I_WKV), 0, 1, 1024, 1024, 0, 1024, (bf16*)(ws + WS_WKV), 0, 0, 128);
    conv_matrix(F, in_ptr(I_WFO), 0, 1, 512, 1024, 0, 1024, (bf16*)(ws + WS_WBR), 0, 0, 128);
    conv_matrix(F, in_ptr(I_WHO), 0, 1, 512, 1024, 0, 1024, (bf16*)(ws + WS_WBR), 1024, 0, 128);
    conv_matrix(F, in_ptr(I_WXO), 0, 1, 512, 1024, 0, 1024, (bf16*)(ws + WS_WBR), 2048, 0, 128);
    conv_matrix(F, in_ptr(I_WOUT), 0, 1, 1024, 1024, 0, 1024, (bf16*)(ws + WS_WOUT), 0, 0, 128);
    conv_matrix(F, in_ptr(I_WR), 0, 1, 1024, 256, 0, 256, (bf16*)(ws + WS_WRS), 0, 0, 128);
    conv_matrix(F, in_ptr(I_WSG), 0, 1, 1024, 256, 0, 256, (bf16*)(ws + WS_WRS), 256, 0, 256);
    conv_matrix(F, in_ptr(I_WSU), 0, 1, 1024, 256, 0, 256, (bf16*)(ws + WS_WRS), 384, 0, 256);
    conv_matrix(F, in_ptr(I_WSD), 0, 1, 256, 1024, 0, 1024, (bf16*)(ws + WS_WSD), 0, 0, 128);
    {
        LAS float* ct = (LAS float*)(F.lds + LDSX_OFF);
        if (F.tid < 128) { float sn, cs; __sincosf(6.283185307179586f * (float)F.tid / 128.f, &sn, &cs); ct[F.tid] = cs; ct[128 + F.tid] = sn; }
        __syncthreads();
        const float* win = in_ptr(I_WIN); bf16* wt = (bf16*)(ws + WS_WIN);
        LAS float* wscr = (LAS float*)(F.lds + RING_OFF + F.wave * 16384);
        for (int it = gw; it < 1024 * 4; it += NGW) {
            const int k = it >> 2, g = it & 3;
            const f32x2 w2 = *(const f32x2*)(win + (size_t)k * 6656 + g * 128 + 2 * F.lane);
            wscr[2 * F.lane] = w2[0]; wscr[2 * F.lane + 1] = w2[1];
            LDS_WAIT(); asm volatile("" ::: "memory");
            float ac0 = 0.f, as0 = 0.f, ac1 = 0.f, as1 = 0.f;
#pragma unroll 8
            for (int c = 0; c < 128; ++c) { const float wv = wscr[c]; const int a0 = (F.lane * c) & 127, a1 = ((F.lane + 64) * c) & 127;
                ac0 += wv * ct[a0]; as0 += wv * ct[128 + a0]; ac1 += wv * ct[a1]; as1 += wv * ct[128 + a1]; }
            wt[(size_t)(g * 128 + F.lane) * 1024 + k] = f2bf(ac0); wt[(size_t)(512 + g * 128 + F.lane) * 1024 + k] = f2bf(as0);
            wt[(size_t)(g * 128 + 64 + F.lane) * 1024 + k] = f2bf(ac1); wt[(size_t)(512 + g * 128 + 64 + F.lane) * 1024 + k] = f2bf(as1);
            LDS_WAIT(); asm volatile("" ::: "memory");
        }
        bf16* a1 = (bf16*)(ws + WS_A1);
        for (int i = F.bid * NTHR + F.tid; i < 128 * 128; i += F.G * NTHR) {
            const int m = i >> 7, kk = i & 127, po = m >> 6, k1 = m & 63, pi = kk >> 6, s1 = kk & 63;
            float sn, cs; __sincosf(6.283185307179586f * (float)((s1 * k1) & 63) / 64.f, &sn, &cs);
            const float v = (po == pi) ? cs : (po == 0 ? -sn : sn);
            a1[i] = f2bf(v * 0.125f);
        }
        bf16* a3 = (bf16*)(ws + WS_A3);
        for (int i = F.bid * NTHR + F.tid; i < 64 * 128 * 256; i += F.G * NTHR) {
            const int k1 = i >> 15, k2 = (i >> 8) & 127, kk = i & 255, s2 = kk >> 1, part = kk & 1, k = k1 + 64 * k2;
            float sn, cs; __sincosf(6.283185307179586f * (float)((s2 * k) & 8191) / 8192.f, &sn, &cs);
            a3[i] = f2bf((part == 0 ? cs : -sn) * (1.f / 128.f));
        }
    }
    for (int m = gw; m < T; m += NGW) ln_row_bf16(in_ptr(I_X) + (size_t)m * D, in_ptr(I_LNIG), in_ptr(I_LNIB), (bf16*)(ws + WS_H0) + (size_t)m * D, F.lane);
    for (int m = gw; m < NB * MEM; m += NGW) ln_row_bf16(in_ptr(I_MEM) + (size_t)m * D, in_ptr(I_LNMG), in_ptr(I_LNMB), (bf16*)(ws + WS_MEMN) + (size_t)m * D, F.lane);
}
__device__ __forceinline__ void p_convert_experts(Frame& F) {
    unsigned char* ws = F.ws;
    conv_matrix(F, in_ptr(I_WEG), (size_t)1024 * 256, NE, 1024, 256, 0, 256, (bf16*)(ws + WS_EXPGU), 0, 512, 256);
    conv_matrix(F, in_ptr(I_WEU), (size_t)1024 * 256, NE, 1024, 256, 0, 256, (bf16*)(ws + WS_EXPGU), 128, 512, 256);
    conv_matrix(F, in_ptr(I_WED), (size_t)256 * 1024, NE, 256, 1024, 0, 1024, (bf16*)(ws + WS_EXPD), 0, 1024, 128);
}
__device__ __forceinline__ void p_ln1(Frame& F) {
    const int gw = F.bid * NWAVES + F.wave, NGW = F.G * NWAVES;
    for (int m = gw; m < T; m += NGW) ln_rowb_bf16((const bf16*)(F.ws + WS_S1) + (size_t)m * D, in_ptr(I_LN1G), in_ptr(I_LN1B), (bf16*)(F.ws + WS_H1) + (size_t)m * D, F.lane);
}
template <bool ROUTED>
__device__ __forceinline__ void p_final(Frame& F) {
    const int gw = F.bid * NWAVES + F.wave, NGW = F.G * NWAVES, lane = F.lane;
    const float* g = in_ptr(I_LN2G); const float* b = in_ptr(I_LN2B);
    for (int m = gw; m < T; m += NGW) {
        const v2u* xr = (const v2u*)((const bf16*)(F.ws + WS_S2) + (size_t)m * D) + lane;
        f32x4 v[4];
#pragma unroll
        for (int j = 0; j < 4; ++j) { const v2u w = xr[64 * j]; v[j][0] = bflo(w.x); v[j][1] = bfhi(w.x); v[j][2] = bflo(w.y); v[j][3] = bfhi(w.y); }
        if (ROUTED) {
            const bf16* yb = (const bf16*)(F.ws + WS_YR) + (size_t)m * 8 * 1024;
#pragma unroll
            for (int k = 0; k < 8; ++k)
#pragma unroll
                for (int j = 0; j < 4; ++j) { const v2u w = ((const v2u*)(yb + (size_t)k * 1024))[lane + 64 * j];
                    v[j][0] += bflo(w.x); v[j][1] += bfhi(w.x); v[j][2] += bflo(w.y); v[j][3] += bfhi(w.y); }
        }
        float s = 0.f;
#pragma unroll
        for (int j = 0; j < 4; ++j) s += (v[j][0] + v[j][1]) + (v[j][2] + v[j][3]);
        const float mean = wave_sum(s) * (1.f / 1024.f); float s2 = 0.f;
#pragma unroll
        for (int j = 0; j < 4; ++j) { v[j] = v[j] - mean; s2 += (v[j][0] * v[j][0] + v[j][1] * v[j][1]) + (v[j][2] * v[j][2] + v[j][3] * v[j][3]); }
        const float rstd = 1.f / sqrtf(wave_sum(s2) * (1.f / 1024.f) + LN_EPS);
        f32x4* o = (f32x4*)(F.out + (size_t)m * D) + lane;
#pragma unroll
        for (int j = 0; j < 4; ++j) { const f32x4 gg = ((const f32x4*)g)[lane + 64 * j], bb = ((const f32x4*)b)[lane + 64 * j]; o[64 * j] = v[j] * rstd * gg + bb; }
    }
}
__device__ __forceinline__ void p_scale_copy(Frame& F, const bf16* src, float* dst) {
    for (size_t i = (size_t)F.bid * NTHR + F.tid; i < (size_t)T * D / 4; i += (size_t)F.G * NTHR) {
        const v2u w = ((const v2u*)src)[i]; f32x4 o; o[0] = ALPHA * bflo(w.x); o[1] = ALPHA * bfhi(w.x); o[2] = ALPHA * bflo(w.y); o[3] = ALPHA * bfhi(w.y); ((f32x4*)dst)[i] = o; }
}


__device__ __forceinline__ void p_proj(Frame& F) {
    pg8::Gemm g{(const bf16*)(F.ws + WS_H0), (const bf16*)(F.ws + WS_WIN), 1024};
    pg8::StaticOrder S; S.init(T, NPROJ, F.G, F.bid);
    EpiProj E{(bf16*)(F.ws + WS_F), (bf16*)(F.ws + WS_Q), (bf16*)(F.ws + WS_GATES), in_ptr(I_BGATE)};
    pg8::gemm_phase<EpiProj, pg8::StaticOrder, false>(F.lds + RING_OFF, g, S, E, nullptr);
}
__device__ __forceinline__ void p_kv(Frame& F) {
    pg8::Gemm g{(const bf16*)(F.ws + WS_MEMN), (const bf16*)(F.ws + WS_WKV), 1024};
    pg8::StaticOrder S; S.init(NB * MEM, 1024, F.G, F.bid);
    EpiPlain E{(bf16*)(F.ws + WS_KV), 1024};
    pg8::gemm_phase<EpiPlain, pg8::StaticOrder, false>(F.lds + RING_OFF, g, S, E, nullptr);
}
__device__ __forceinline__ void p_branch(Frame& F) {
    pg8::Gemm g{(const bf16*)(F.ws + WS_MIX), (const bf16*)(F.ws + WS_WBR), 512};
    ChainOrder S; S.S.init(T, 1024, F.G, F.bid);
    EpiMix E{(bf16*)(F.ws + WS_MERGED), (const bf16*)(F.ws + WS_GATES), in_ptr(I_BFO)};
    pg8::gemm_phase<EpiMix, ChainOrder, false>(F.lds + RING_OFF, g, S, E, nullptr);
}
__device__ __forceinline__ void p_wout(Frame& F) {
    pg8::Gemm g{(const bf16*)(F.ws + WS_MERGED), (const bf16*)(F.ws + WS_WOUT), 1024};
    pg8::StaticOrder S; S.init(T, 1024, F.G, F.bid);
    EpiResid E{(bf16*)(F.ws + WS_S1), (const bf16*)(F.ws + WS_H0)};
    pg8::gemm_phase<EpiResid, pg8::StaticOrder, false>(F.lds + RING_OFF, g, S, E, nullptr);
}
__device__ __forceinline__ void p_router_shared(Frame& F) {
    pg8::Gemm g{(const bf16*)(F.ws + WS_H1), (const bf16*)(F.ws + WS_WRS), 1024};
    pg8::StaticOrder S; S.init(T, 768, F.G, F.bid);
    EpiRouterShared E{(float*)(F.ws + WS_LOGIT), (bf16*)(F.ws + WS_HS)};
    pg8::gemm_phase<EpiRouterShared, pg8::StaticOrder, false>(F.lds + RING_OFF, g, S, E, nullptr);
}
__device__ __forceinline__ void p_shared_down(Frame& F) {
    pg8::Gemm g{(const bf16*)(F.ws + WS_HS), (const bf16*)(F.ws + WS_WSD), 256};
    pg8::StaticOrder S; S.init(T, 1024, F.G, F.bid);
    EpiResid E{(bf16*)(F.ws + WS_S2), (const bf16*)(F.ws + WS_H1)};
    pg8::gemm_phase<EpiResid, pg8::StaticOrder, false>(F.lds + RING_OFF, g, S, E, nullptr);
}

constexpr int XA_PITCH = 136;
__device__ __forceinline__ void p_xattn(Frame& F) {
    LAS bf16* Ks = (LAS bf16*)(F.lds); LAS bf16* Vs = Ks + 256 * XA_PITCH;
    const bf16* KV = (const bf16*)(F.ws + WS_KV); const bf16* XQ = (const bf16*)(F.ws + WS_Q + 5 * SEC_STRIDE); bf16* XO = (bf16*)(F.ws + WS_MIX) + (size_t)2 * T * 512;
    const int lane = F.lane, r = lane & 15, q = lane >> 4, qp = (lane & 15) >> 2, pp = lane & 3;
    int cur_bh = -1;
    for (int u = F.bid; u < 512; u += F.G) {
        const int bh = u & 15, tile = u >> 4, b = bh >> 2, h = bh & 3;
        if (bh != cur_bh) {
            __syncthreads();
            for (int c = F.tid; c < 256 * 16; c += NTHR) { const int key = c >> 4, ch = c & 15;
                const v4u kv = *(const v4u*)(KV + (size_t)(b * 256 + key) * 1024 + h * 128 + ch * 8);
                const v4u vv = *(const v4u*)(KV + (size_t)(b * 256 + key) * 1024 + 512 + h * 128 + ch * 8);
                *(LAS v4u*)(Ks + key * XA_PITCH + ch * 8) = kv; *(LAS v4u*)(Vs + key * XA_PITCH + ch * 8) = vv; }
            __syncthreads();
            cur_bh = bh;
        }
        const int t0 = b * SEQ + tile * 256 + F.wave * 32;
#pragma unroll 1
        for (int mq = 0; mq < 2; ++mq) {
            const bf16* qrow = XQ + (size_t)(t0 + 16 * mq + r) * 512 + h * 128 + 8 * q;
            bf16x8 qf[4];
#pragma unroll
            for (int ks = 0; ks < 4; ++ks) qf[ks] = *(const bf16x8*)(qrow + 32 * ks);
            f32x4 sc[16];
#pragma unroll
            for (int nk = 0; nk < 16; ++nk) { sc[nk] = (f32x4){0.f, 0.f, 0.f, 0.f};
#pragma unroll
                for (int ks = 0; ks < 4; ++ks) { const bf16x8 kf = *(const LAS bf16x8*)(Ks + (16 * nk + r) * XA_PITCH + 32 * ks + 8 * q);
                    sc[nk] = __builtin_amdgcn_mfma_f32_16x16x32_bf16(kf, qf[ks], sc[nk], 0, 0, 0); } }
            float mx = -3.0e38f;
#pragma unroll
            for (int nk = 0; nk < 16; ++nk) mx = fmaxf(mx, fmaxf(fmaxf(sc[nk][0], sc[nk][1]), fmaxf(sc[nk][2], sc[nk][3])));
            mx = fmaxf(mx, __shfl_xor(mx, 16)); mx = fmaxf(mx, __shfl_xor(mx, 32));
            float l = 0.f;
#pragma unroll
            for (int nk = 0; nk < 16; ++nk) {
#pragma unroll
                for (int j = 0; j < 4; ++j) { sc[nk][j] = __builtin_amdgcn_exp2f(sc[nk][j] - mx); l += sc[nk][j]; } }
            l += __shfl_xor(l, 16); l += __shfl_xor(l, 32);
            const float inv = 1.0f / l;
            bf16x8 pf[8];
#pragma unroll
            for (int s = 0; s < 8; ++s) { v4u w; w.x = cvt_pk_bf16(sc[2 * s][0], sc[2 * s][1]); w.y = cvt_pk_bf16(sc[2 * s][2], sc[2 * s][3]);
                w.z = cvt_pk_bf16(sc[2 * s + 1][0], sc[2 * s + 1][1]); w.w = cvt_pk_bf16(sc[2 * s + 1][2], sc[2 * s + 1][3]); pf[s] = __builtin_bit_cast(bf16x8, w); }
            bf16* orow = XO + (size_t)(t0 + 16 * mq + r) * 512 + h * 128 + 4 * q;
#pragma unroll
            for (int nd = 0; nd < 8; ++nd) { f32x4 o = (f32x4){0.f, 0.f, 0.f, 0.f};
#pragma unroll
                for (int s = 0; s < 8; ++s) {
                    const s16x4 v0 = __builtin_amdgcn_ds_read_tr16_b64_v4i16((LAS s16x4*)(Vs + (32 * s + 4 * q + qp) * XA_PITCH + 16 * nd + 4 * pp));
                    const s16x4 v1 = __builtin_amdgcn_ds_read_tr16_b64_v4i16((LAS s16x4*)(Vs + (32 * s + 16 + 4 * q + qp) * XA_PITCH + 16 * nd + 4 * pp));
                    const bf16x8 vf = {v0[0], v0[1], v0[2], v0[3], v1[0], v1[1], v1[2], v1[3]};
                    o = __builtin_amdgcn_mfma_f32_16x16x32_bf16(vf, pf[s], o, 0, 0, 0); }
                o = o * inv;
                v2u w; w.x = cvt_pk_bf16(o[0], o[1]); w.y = cvt_pk_bf16(o[2], o[3]); *(v2u*)(orow + 16 * nd) = w; }
        }
    }
    __syncthreads();
}

__device__ __forceinline__ void p_routing(Frame& F) {
    const int gw = F.bid * NWAVES + F.wave, NGW = F.G * NWAVES, lane = F.lane;
    const float* L = (const float*)(F.ws + WS_LOGIT);
    int* eidx = (int*)(F.ws + WS_ROUTE + RT_EIDX); float* wgt = (float*)(F.ws + WS_ROUTE + RT_WGT); int* pos = (int*)(F.ws + WS_ROUTE + RT_POS);
    unsigned* cnt = F.ctl + CW_CNT;
    const f32x4 rb = ((const f32x4*)in_ptr(I_RB))[lane];
    const float NEG = -__builtin_inff();
    for (int t = gw; t < T; t += NGW) {
        const f32x4 lg = ((const f32x4*)(L + (size_t)t * 256))[lane];
        float a0 = sigmoidf_(lg[0]), a1 = sigmoidf_(lg[1]), a2 = sigmoidf_(lg[2]), a3 = sigmoidf_(lg[3]);
        float s0 = a0 + rb[0], s1 = a1 + rb[1], s2 = a2 + rb[2], s3 = a3 + rb[3];
        float m1 = fmaxf(s0, s1), m2 = fminf(s0, s1);
        { const float n1 = fmaxf(m1, s2), n2 = fmaxf(fminf(m1, s2), m2); m1 = n1; m2 = n2; }
        { const float n1 = fmaxf(m1, s3), n2 = fmaxf(fminf(m1, s3), m2); m1 = n1; m2 = n2; }
#pragma unroll
        for (int o = 1; o < 8; o <<= 1) { const float p1 = __shfl_xor(m1, o), p2 = __shfl_xor(m2, o); const float n1 = fmaxf(m1, p1), n2 = fmaxf(fminf(m1, p1), fmaxf(m2, p2)); m1 = n1; m2 = n2; }
        const float gs = m1 + m2; const int grp = lane >> 3; int rank = 0;
#pragma unroll
        for (int g2 = 0; g2 < 8; ++g2) { const float o = __shfl(gs, g2 * 8); rank += (o > gs || (o == gs && g2 < grp)) ? 1 : 0; }
        if (rank >= 4) { s0 = NEG; s1 = NEG; s2 = NEG; s3 = NEG; }
        int my_e = 0; float my_a = 0.f, asum = 0.f;
#pragma unroll 1
        for (int k = 0; k < 8; ++k) {
            float bv = s0; int bi = 4 * lane; float ba = a0;
            if (s1 > bv) { bv = s1; bi = 4 * lane + 1; ba = a1; }
            if (s2 > bv) { bv = s2; bi = 4 * lane + 2; ba = a2; }
            if (s3 > bv) { bv = s3; bi = 4 * lane + 3; ba = a3; }
#pragma unroll
            for (int o = 1; o < 64; o <<= 1) { const float pv = __shfl_xor(bv, o); const int pi = __shfl_xor(bi, o); const float pa = __shfl_xor(ba, o);
                if (pv > bv || (pv == bv && pi < bi)) { bv = pv; bi = pi; ba = pa; } }
            if ((bi >> 2) == lane) { const int j = bi & 3; if (j == 0) s0 = NEG; else if (j == 1) s1 = NEG; else if (j == 2) s2 = NEG; else s3 = NEG; }
            if (lane == k) { my_e = bi; my_a = ba; }
            asum += ba;
        }
        if (lane < 8) {
            const unsigned p = __hip_atomic_fetch_add(cnt + my_e, 1u, __ATOMIC_RELAXED, __HIP_MEMORY_SCOPE_AGENT);
            eidx[(size_t)t * 8 + lane] = my_e; wgt[(size_t)t * 8 + lane] = my_a / asum * 2.5f; pos[(size_t)t * 8 + lane] = (int)p;
        }
    }
}
__device__ __forceinline__ int build_expert_tables(Frame& F, LAS unsigned short* te, LAS int* roff) {
    LAS int* tmp = (LAS int*)(F.lds + LDSX_OFF + 6656);
    const unsigned* cnt = F.ctl + CW_CNT;
    __syncthreads();
    if (F.tid < 256) tmp[F.tid] = (int)((__hip_atomic_load(cnt + F.tid, __ATOMIC_RELAXED, __HIP_MEMORY_SCOPE_AGENT) + 255u) >> 8);
    __syncthreads();
    if (F.tid < 256) { int s = 0; for (int j = 0; j < F.tid; ++j) s += tmp[j]; const int nt = tmp[F.tid];
        for (int i = 0; i < nt; ++i) te[s + i] = (unsigned short)F.tid;
        if (roff) roff[F.tid] = s * 256;
        if (F.tid == 255) tmp[256] = s + nt; }
    __syncthreads();
    return tmp[256];
}
__device__ __forceinline__ void p_fill(Frame& F) {
    LAS unsigned short* te = (LAS unsigned short*)(F.lds + LDSX_OFF); LAS int* roff = (LAS int*)(F.lds + LDSX_OFF + 8192);
    (void)build_expert_tables(F, te, roff);
    const int* eidx = (const int*)(F.ws + WS_ROUTE + RT_EIDX); const float* wgt = (const float*)(F.ws + WS_ROUTE + RT_WGT); const int* pos = (const int*)(F.ws + WS_ROUTE + RT_POS);
    int* rowtok = (int*)(F.ws + WS_ROUTE + RT_ROWTOK); v2u* rowinfo = (v2u*)(F.ws + WS_ROUTE + RT_ROWSLOT);
    for (int i = F.bid * NTHR + F.tid; i < T * TOPK; i += F.G * NTHR) { const int e = eidx[i]; const int r = roff[e] + pos[i]; rowtok[r] = i >> 3; rowinfo[r] = (v2u){(unsigned)i, __float_as_uint(wgt[i])}; }
    const unsigned* cnt = F.ctl + CW_CNT;
    for (int e = F.bid; e < NE; e += F.G) { const int c = (int)__hip_atomic_load(cnt + e, __ATOMIC_RELAXED, __HIP_MEMORY_SCOPE_AGENT), r0 = roff[e] + c, r1 = roff[e] + ((c + 255) & ~255);
        for (int r = r0 + F.tid; r < r1; r += NTHR) { rowtok[r] = 0; rowinfo[r] = (v2u){0xffffffffu, 0u}; } }
    __syncthreads();
}
__device__ __forceinline__ void p_exp_gu(Frame& F) {
    LAS unsigned short* te = (LAS unsigned short*)(F.lds + LDSX_OFF);
    const int ntiles = build_expert_tables(F, te, nullptr);
    pg8::Gemm g{(const bf16*)(F.ws + WS_H1), (const bf16*)(F.ws + WS_EXPGU), 1024};
    pg8::ExpertOrder<2> S{ntiles * 2, F.G, F.bid, te};
    EpiExpGU E{(bf16*)(F.ws + WS_HACT)};
    pg8::gemm_phase<EpiExpGU, pg8::ExpertOrder<2>, true>(F.lds + RING_OFF, g, S, E, (const int*)(F.ws + WS_ROUTE + RT_ROWTOK));
}
__device__ __forceinline__ void p_exp_down(Frame& F) {
    LAS unsigned short* te = (LAS unsigned short*)(F.lds + LDSX_OFF);
    const int ntiles = build_expert_tables(F, te, nullptr);
    pg8::Gemm g{(const bf16*)(F.ws + WS_HACT), (const bf16*)(F.ws + WS_EXPD), 256};
    pg8::ExpertOrder<4> S{ntiles * 4, F.G, F.bid, te};
    EpiExpDown E{(bf16*)(F.ws + WS_YR), (const v2u*)(F.ws + WS_ROUTE + RT_ROWSLOT), (bf16*)(F.ws + WS_ROUTE + RT_TRASH)};
    pg8::gemm_phase<EpiExpDown, pg8::ExpertOrder<4>, false>(F.lds + RING_OFF, g, S, E, nullptr);
}

template <int STEP>
__device__ __forceinline__ void p_dft(Frame& F) {
    constexpr int K = STEP == 1 ? 128 : 256, NBC = STEP == 1 ? 256 : 128, WM = STEP == 1 ? 1 : 2, WN = 8 / WM;
    constexpr int MT = 128 / WM / 16, NT = NBC / WN / 16, PITCH = NBC + 8, CPR = NBC / 8;
    LAS bf16* Bs = (LAS bf16*)F.lds;
    const bf16* Fb = (const bf16*)(F.ws + WS_F); bf16* Yb = (bf16*)(F.ws + WS_Y); bf16* FM = (bf16*)(F.ws + WS_MIX);
    const int lane = F.lane, r = lane & 15, q = lane >> 4, qp = (lane & 15) >> 2, pp = lane & 3;
    const int wm = F.wave / WN, wn = F.wave % WN;
    for (int u = F.bid; u < 1024; u += F.G) {
        const int b = u >> 8, mid = STEP == 1 ? (u >> 1) & 127 : (u >> 2) & 63, n0 = STEP == 1 ? (u & 1) * 256 : (u & 3) * 128;
        __syncthreads();
        for (int c = F.tid; c < K * CPR; c += NTHR) { const int kk = c / CPR, ch = c % CPR;
            const bf16* src = STEP == 1 ? Fb + (size_t)(b * SEQ + 128 * (kk & 63) + mid) * 1024 + (kk >> 6) * 512 + n0 + ch * 8
                                        : Yb + ((size_t)(b * 64 + mid) * 256 + kk) * 512 + n0 + ch * 8;
            *(LAS v4u*)(Bs + kk * PITCH + ch * 8) = *(const v4u*)src; }
        __syncthreads();
        const bf16* A = STEP == 1 ? (const bf16*)(F.ws + WS_A1) : (const bf16*)(F.ws + WS_A3) + (size_t)mid * 128 * 256;
        f32x4 acc[MT][NT];
#pragma unroll
        for (int mi = 0; mi < MT; ++mi)
#pragma unroll
            for (int ni = 0; ni < NT; ++ni) acc[mi][ni] = (f32x4){0.f, 0.f, 0.f, 0.f};
#pragma unroll 2
        for (int ks = 0; ks < K / 32; ++ks) {
            bf16x8 af[MT];
#pragma unroll
            for (int mi = 0; mi < MT; ++mi) af[mi] = *(const bf16x8*)(A + (size_t)(wm * (128 / WM) + 16 * mi + r) * K + 32 * ks + 8 * q);
#pragma unroll
            for (int ni = 0; ni < NT; ++ni) { const int n = wn * (NBC / WN) + 16 * ni;
                const s16x4 v0 = __builtin_amdgcn_ds_read_tr16_b64_v4i16((LAS s16x4*)(Bs + (32 * ks + 8 * q + qp) * PITCH + n + 4 * pp));
                const s16x4 v1 = __builtin_amdgcn_ds_read_tr16_b64_v4i16((LAS s16x4*)(Bs + (32 * ks + 8 * q + 4 + qp) * PITCH + n + 4 * pp));
                const bf16x8 xf = {v0[0], v0[1], v0[2], v0[3], v1[0], v1[1], v1[2], v1[3]};
#pragma unroll
                for (int mi = 0; mi < MT; ++mi) acc[mi][ni] = __builtin_amdgcn_mfma_f32_16x16x32_bf16(xf, af[mi], acc[mi][ni], 0, 0, 0); }
        }
#pragma unroll
        for (int mi = 0; mi < MT; ++mi) { const int m = wm * (128 / WM) + 16 * mi + r;
            bf16* drow = STEP == 1 ? Yb + ((((size_t)(b * 64 + (m & 63)) * 128 + mid) * 2 + (m >> 6)) * 512)
                                   : FM + (size_t)(b * SEQ + mid + 64 * m) * 512;
#pragma unroll
            for (int ni = 0; ni < NT; ++ni) { const int n = n0 + wn * (NBC / WN) + 16 * ni + 4 * q; const f32x4 o = acc[mi][ni];
                v2u w; w.x = cvt_pk_bf16_c(o[0], o[1]); w.y = cvt_pk_bf16_c(o[2], o[3]); *(v2u*)(drow + n) = w; } }
    }
    __syncthreads();
}

__device__ __forceinline__ v2u pack4c(const f32x4 o) { v2u w; w.x = cvt_pk_bf16_c(o[0], o[1]); w.y = cvt_pk_bf16_c(o[2], o[3]); return w; }
__device__ __forceinline__ bf16x8 tr8(const LAS bf16* p0, const LAS bf16* p1) {
    const s16x4 a = __builtin_amdgcn_ds_read_tr16_b64_v4i16((LAS s16x4*)p0), b = __builtin_amdgcn_ds_read_tr16_b64_v4i16((LAS s16x4*)p1);
    return (bf16x8){a[0], a[1], a[2], a[3], b[0], b[1], b[2], b[3]};
}
constexpr int HP = 136;
__device__ __forceinline__ void p_hgrn1(Frame& F) {
    LAS bf16* Qd = (LAS bf16*)F.lds; LAS bf16* Ki = Qd + 64 * HP; LAS bf16* Ke = Ki + 64 * HP; LAS bf16* Vs = Ke + 64 * HP; LAS bf16* Sb = Vs + 64 * HP;
    LAS float* tot = (LAS float*)(Sb + 128 * HP); LAS float* dec = tot + 512;
    const int tid = F.tid, lane = F.lane, r = lane & 15, q = lane >> 4, qp = (lane & 15) >> 2, pp = lane & 3, w = F.wave, tb = w & 3, dh = w >> 2, d = tid & 127, qt = tid >> 7;
    for (int u = F.bid; u < 512; u += F.G) {
        const int sg = u & 15, dir = (u >> 4) & 1, h = (u >> 5) & 3, b = u >> 7;
        const bf16* Qg = (const bf16*)(F.ws + WS_Q) + h * 128; const bf16* Vg = (const bf16*)(F.ws + WS_Q + SEC_STRIDE) + h * 128;
        const bf16* Zg = (const bf16*)(F.ws + WS_Q + (dir ? 3 : 2) * SEC_STRIDE) + h * 128;
        bf16* OL = (bf16*)(F.ws + (dir ? WS_OLB : WS_OLF)) + h * 128; bf16* QS = (bf16*)(F.ws + (dir ? WS_QSB : WS_QSF)) + h * 128;
        const float* lbp = in_ptr(dir ? I_LBB : I_LBF);
        const float lb = 1.0f / (1.0f + __expf(lbp[512 + h * 128 + d] - lbp[h * 128 + d]));
        float G = 0.f;
        f32x4 sS[8];
#pragma unroll
        for (int nd = 0; nd < 8; ++nd) sS[nd] = (f32x4){0.f, 0.f, 0.f, 0.f};
        __syncthreads();
        for (int i = tid; i < 128 * HP / 8; i += NTHR) ((LAS v4u*)Sb)[i] = (v4u){0u, 0u, 0u, 0u};
#pragma unroll 1
        for (int c = 0; c < 8; ++c) {
            __syncthreads();
            const int tbase = sg * SEG + 64 * c;
            float qv[16], kv[16], cs[16]; float run = 0.f;
#pragma unroll
            for (int i = 0; i < 16; ++i) { const int pos = tbase + 16 * qt + i; const size_t tok = (size_t)(b * SEQ + (dir ? SEQ - 1 - pos : pos));
                const float zf = bf2f(Zg[tok * 512 + d]); qv[i] = bf2f(Qg[tok * 512 + d]);
                const float f = lb + (1.0f - lb) * sigmoidf_(zf); kv[i] = 1.0f - f; run += __logf(f); cs[i] = run; }
            tot[qt * 128 + d] = run;
            for (int cc = tid; cc < 1024; cc += NTHR) { const int tp = cc >> 4, ch = cc & 15, pos = tbase + tp; const size_t tok = (size_t)(b * SEQ + (dir ? SEQ - 1 - pos : pos));
                *(LAS v4u*)(Vs + tp * HP + ch * 8) = *(const v4u*)(Vg + tok * 512 + ch * 8); }
            __syncthreads();
            float pre = 0.f, aend = 0.f;
#pragma unroll
            for (int j = 0; j < 4; ++j) { const float x = tot[j * 128 + d]; aend += x; pre += (j < qt) ? x : 0.f; }
            const float eG = __expf(G);
#pragma unroll
            for (int i = 0; i < 16; ++i) { const int tp = 16 * qt + i, pos = tbase + tp; const size_t tok = (size_t)(b * SEQ + (dir ? SEQ - 1 - pos : pos));
                const float a = pre + cs[i], qd = qv[i] * __expf(a);
                Qd[tp * HP + d] = f2bf(qd); Ki[tp * HP + d] = f2bf(kv[i] * __expf(-a)); Ke[tp * HP + d] = f2bf(kv[i] * __expf(aend - a));
                QS[tok * 512 + d] = f2bf(qd * eG); }
            if (qt == 0) dec[d] = __expf(aend);
            G += aend;
            __syncthreads();
            bf16x8 qf[4];
#pragma unroll
            for (int ks = 0; ks < 4; ++ks) qf[ks] = *(const LAS bf16x8*)(Qd + (16 * tb + r) * HP + 32 * ks + 8 * q);
            f32x4 sc[4];
#pragma unroll
            for (int sb = 0; sb < 4; ++sb) { sc[sb] = (f32x4){0.f, 0.f, 0.f, 0.f};
#pragma unroll
                for (int ks = 0; ks < 4; ++ks) { const bf16x8 kf = *(const LAS bf16x8*)(Ki + (16 * sb + r) * HP + 32 * ks + 8 * q); sc[sb] = __builtin_amdgcn_mfma_f32_16x16x32_bf16(kf, qf[ks], sc[sb], 0, 0, 0); }
#pragma unroll
                for (int j = 0; j < 4; ++j) sc[sb][j] = (16 * sb + 4 * q + j > 16 * tb + r) ? 0.f : sc[sb][j]; }
            bf16x8 pf[2];
#pragma unroll
            for (int k2 = 0; k2 < 2; ++k2) { v4u wv; wv.x = cvt_pk_bf16(sc[2 * k2][0], sc[2 * k2][1]); wv.y = cvt_pk_bf16(sc[2 * k2][2], sc[2 * k2][3]);
                wv.z = cvt_pk_bf16(sc[2 * k2 + 1][0], sc[2 * k2 + 1][1]); wv.w = cvt_pk_bf16(sc[2 * k2 + 1][2], sc[2 * k2 + 1][3]); pf[k2] = __builtin_bit_cast(bf16x8, wv); }
            { const int pos = tbase + 16 * tb + r; const size_t tok = (size_t)(b * SEQ + (dir ? SEQ - 1 - pos : pos));
#pragma unroll
            for (int nd = 0; nd < 4; ++nd) { f32x4 o = (f32x4){0.f, 0.f, 0.f, 0.f}; const int cb = 64 * dh + 16 * nd + 4 * pp;
#pragma unroll
                for (int k2 = 0; k2 < 2; ++k2) o = __builtin_amdgcn_mfma_f32_16x16x32_bf16(tr8(Vs + (32 * k2 + 4 * q + qp) * HP + cb, Vs + (32 * k2 + 16 + 4 * q + qp) * HP + cb), pf[k2], o, 0, 0, 0);
#pragma unroll
                for (int ks = 0; ks < 4; ++ks) o = __builtin_amdgcn_mfma_f32_16x16x32_bf16(tr8(Sb + (32 * ks + 8 * q + qp) * HP + cb, Sb + (32 * ks + 8 * q + 4 + qp) * HP + cb), qf[ks], o, 0, 0, 0);
                *(v2u*)(OL + tok * 512 + 64 * dh + 16 * nd + 4 * q) = pack4c(o); } }
            { const float dc = dec[16 * w + r];
#pragma unroll
            for (int nd = 0; nd < 8; ++nd) { sS[nd] = sS[nd] * dc;
#pragma unroll
                for (int k2 = 0; k2 < 2; ++k2) sS[nd] = __builtin_amdgcn_mfma_f32_16x16x32_bf16(tr8(Vs + (32 * k2 + 8 * q + qp) * HP + 16 * nd + 4 * pp, Vs + (32 * k2 + 8 * q + 4 + qp) * HP + 16 * nd + 4 * pp),
                                                                                              tr8(Ke + (32 * k2 + 8 * q + qp) * HP + 16 * w + 4 * pp, Ke + (32 * k2 + 8 * q + 4 + qp) * HP + 16 * w + 4 * pp), sS[nd], 0, 0, 0); } }
            __syncthreads();
#pragma unroll
            for (int nd = 0; nd < 8; ++nd) *(LAS v2u*)(Sb + (16 * w + r) * HP + 16 * nd + 4 * q) = pack4c(sS[nd]);
        }
        float* U = (float*)(F.ws + WS_U) + (size_t)u * 16384;
#pragma unroll
        for (int nd = 0; nd < 8; ++nd) *(f32x4*)(U + (16 * w + r) * 128 + 16 * nd + 4 * q) = sS[nd];
        if (qt == 0) ((float*)(F.ws + WS_DEC))[u * 128 + d] = __expf(G);
    }
    __syncthreads();
}
__device__ __forceinline__ void p_hgrn_scan(Frame& F) {
    const float* U = (const float*)(F.ws + WS_U); const float* DEC = (const float*)(F.ws + WS_DEC); bf16* SST = (bf16*)(F.ws + WS_SST);
    for (int it = F.bid * NTHR + F.tid; it < 32 * 128 * 32; it += F.G * NTHR) {
        const int cmb = it >> 12, dk = (it >> 5) & 127, dv4 = it & 31;
        f32x4 st = (f32x4){0.f, 0.f, 0.f, 0.f};
#pragma unroll 4
        for (int sg = 0; sg < NSEG; ++sg) { const size_t un = (size_t)(cmb * 16 + sg);
            v2u wv; wv.x = cvt_pk_bf16(st[0], st[1]); wv.y = cvt_pk_bf16(st[2], st[3]); *(v2u*)(SST + un * 16384 + dk * 128 + dv4 * 4) = wv;
            const float dcy = DEC[un * 128 + dk]; const f32x4 uu = *(const f32x4*)(U + un * 16384 + dk * 128 + dv4 * 4); st = st * dcy + uu; }
    }
}
__device__ __forceinline__ void p_hgrn2(Frame& F) {
    LAS bf16* Sf = (LAS bf16*)F.lds; LAS bf16* Sw = Sf + 128 * HP;
    const int lane = F.lane, r = lane & 15, q = lane >> 4, qp = (lane & 15) >> 2, pp = lane & 3;
    const bf16* SST = (const bf16*)(F.ws + WS_SST);
    for (int u = F.bid; u < 512; u += F.G) {
        const int tile = u & 31, h = (u >> 5) & 3, b = u >> 7;
        const int unf = ((b * 4 + h) * 2 + 0) * 16 + (tile >> 1), unb = ((b * 4 + h) * 2 + 1) * 16 + ((31 - tile) >> 1);
        __syncthreads();
        for (int c = F.tid; c < 128 * 16; c += NTHR) { const int dk = c >> 4, ch = c & 15;
            *(LAS v4u*)(Sf + dk * HP + ch * 8) = *(const v4u*)(SST + (size_t)unf * 16384 + dk * 128 + ch * 8);
            *(LAS v4u*)(Sw + dk * HP + ch * 8) = *(const v4u*)(SST + (size_t)unb * 16384 + dk * 128 + ch * 8); }
        __syncthreads();
        const float* ng = in_ptr(I_HNG) + h * 128;
#pragma unroll 1
        for (int mq = 0; mq < 2; ++mq) {
            const size_t tok = (size_t)(b * SEQ + tile * 256 + F.wave * 32 + 16 * mq + r);
            const bf16* qsf = (const bf16*)(F.ws + WS_QSF) + tok * 512 + h * 128 + 8 * q; const bf16* qsb = (const bf16*)(F.ws + WS_QSB) + tok * 512 + h * 128 + 8 * q;
            bf16x8 ff[4], fb[4];
#pragma unroll
            for (int ks = 0; ks < 4; ++ks) { ff[ks] = *(const bf16x8*)(qsf + 32 * ks); fb[ks] = *(const bf16x8*)(qsb + 32 * ks); }
            f32x4 o[8]; float ss = 0.f;
            const size_t rb = tok * 512 + h * 128 + 4 * q;
#pragma unroll
            for (int nd = 0; nd < 8; ++nd) { f32x4 a = (f32x4){0.f, 0.f, 0.f, 0.f}; const int cb = 16 * nd + 4 * pp;
#pragma unroll
                for (int ks = 0; ks < 4; ++ks) { a = __builtin_amdgcn_mfma_f32_16x16x32_bf16(tr8(Sf + (32 * ks + 8 * q + qp) * HP + cb, Sf + (32 * ks + 8 * q + 4 + qp) * HP + cb), ff[ks], a, 0, 0, 0);
                    a = __builtin_amdgcn_mfma_f32_16x16x32_bf16(tr8(Sw + (32 * ks + 8 * q + qp) * HP + cb, Sw + (32 * ks + 8 * q + 4 + qp) * HP + cb), fb[ks], a, 0, 0, 0); }
                const v2u lf = *(const v2u*)((const bf16*)(F.ws + WS_OLF) + rb + 16 * nd), lw = *(const v2u*)((const bf16*)(F.ws + WS_OLB) + rb + 16 * nd);
                a[0] += bflo(lf.x) + bflo(lw.x); a[1] += bfhi(lf.x) + bfhi(lw.x); a[2] += bflo(lf.y) + bflo(lw.y); a[3] += bfhi(lf.y) + bfhi(lw.y);
                ss += (a[0] * a[0] + a[1] * a[1]) + (a[2] * a[2] + a[3] * a[3]); o[nd] = a; }
            ss += __shfl_xor(ss, 16); ss += __shfl_xor(ss, 32);
            const float rs = 1.0f / sqrtf(ss * (1.0f / 128.0f) + LN_EPS);
#pragma unroll
            for (int nd = 0; nd < 8; ++nd) { const f32x4 gn = *(const f32x4*)(ng + 16 * nd + 4 * q); const v2u gw = *(const v2u*)((const bf16*)(F.ws + WS_Q + 4 * SEC_STRIDE) + rb + 16 * nd);
                f32x4 y; y[0] = o[nd][0] * rs * gn[0] * bflo(gw.x); y[1] = o[nd][1] * rs * gn[1] * bfhi(gw.x); y[2] = o[nd][2] * rs * gn[2] * bflo(gw.y); y[3] = o[nd][3] * rs * gn[3] * bfhi(gw.y);
                v2u wv; wv.x = cvt_pk_bf16(y[0], y[1]); wv.y = cvt_pk_bf16(y[2], y[3]); *(v2u*)((bf16*)(F.ws + WS_MIX) + (size_t)T * 512 + rb + 16 * nd) = wv; }
        }
    }
    __syncthreads();
}
struct Args { const float* in[29]; float* out; unsigned char* ws; };
__global__ void __launch_bounds__(NTHR, 2) fwd(Args args) {
    extern __shared__ __attribute__((aligned(16))) unsigned char lds[];
    Frame F;
    F.lds = (LAS unsigned char*)lds;
    F.tid = threadIdx.x; F.lane = F.tid & 63; F.wave = __builtin_amdgcn_readfirstlane(F.tid >> 6);
    F.G = gridDim.x; F.bid = blockIdx.x;
    F.ws = args.ws; F.ctl = (unsigned*)(args.ws + WS_CTL); F.out = args.out;
    if (F.tid < 64) ((LAS unsigned*)(F.lds + LDSCTL_OFF))[F.tid] = 0u;
    __syncthreads();
    XcdBarrier bar = xcd_barrier_post(F.ctl + CW_BAR, (volatile LAS unsigned*)(F.lds + LDSCTL_OFF + 32));
#define GRID_BAR() xcd_barrier(bar)

#ifndef DUP
#define DUP 0
#endif
#define PH(id, call) do { call; if (DUP == (id)) { __syncthreads(); call; } } while (0)
    PH(1, p0_prologue(F));
    GRID_BAR();
    PH(2, p_proj(F));
    PH(3, p_kv(F));
    GRID_BAR();
    PH(4, p_xattn(F));
    PH(5, p_dft<1>(F));
    PH(6, p_hgrn1(F));
    GRID_BAR();
    PH(7, p_dft<3>(F));
    PH(8, p_hgrn_scan(F));
    GRID_BAR();
    PH(9, p_hgrn2(F));
    GRID_BAR();
    PH(10, p_branch(F));
    GRID_BAR();
    PH(11, p_wout(F));
    GRID_BAR();
    PH(12, p_ln1(F));
    PH(13, p_convert_experts(F));
    GRID_BAR();
    PH(14, p_router_shared(F));
    GRID_BAR();
    p_routing(F);
    GRID_BAR();
    PH(16, p_fill(F));
    PH(17, p_shared_down(F));
    GRID_BAR();
    PH(18, p_exp_gu(F));
    GRID_BAR();
    PH(19, p_exp_down(F));
    GRID_BAR();
    PH(20, p_final<true>(F));
}

extern "C" void kernel_launch(void* const* d_in, const int* in_sizes, int n_in, void* d_out, int out_size, void* d_ws, size_t ws_size, hipStream_t stream) {
    static int grid = 0;
    if (grid == 0) {
        int dev = 0, cus = 0, per_cu = 0;
        if (n_in != 29 || ws_size < WS_END) { fprintf(stderr, "kernel_launch: unexpected n_in %d / ws_size %zu\n", n_in, ws_size); }
        if (hipGetDevice(&dev) != hipSuccess || hipDeviceGetAttribute(&cus, hipDeviceAttributeMultiprocessorCount, dev) != hipSuccess) { grid = -1; return; }
        if (hipFuncSetAttribute((const void*)fwd, hipFuncAttributeMaxDynamicSharedMemorySize, LDS_BYTES) != hipSuccess) { grid = -1; return; }
        if (hipOccupancyMaxActiveBlocksPerMultiprocessor(&per_cu, (const void*)fwd, NTHR, LDS_BYTES) != hipSuccess || per_cu < 1) fprintf(stderr, "kernel_launch: occupancy query says %d\n", per_cu);
        (void)hipGetLastError();
        grid = cus;
    }
    if (grid < 0) return;
    (void)hipMemsetAsync((char*)d_ws + WS_CTL, 0, CTL_ZERO_BYTES, stream);
    Args a{};
    for (int i = 0; i < 29; ++i) a.in[i] = (const float*)d_in[i];
    a.out = (float*)d_out; a.ws = (unsigned char*)d_ws;
    hipLaunchKernelGGL(fwd, dim3(grid), dim3(NTHR), LDS_BYTES, stream, a);
}
```

```cpp
#define DUP 0
#include <hip/hip_runtime.h>
#include <cstdio>
#include <cstdint>

#define GAS __attribute__((address_space(1)))
#define LAS __attribute__((address_space(3)))
typedef unsigned short bf16;
typedef unsigned v4u __attribute__((ext_vector_type(4)));
typedef unsigned v2u __attribute__((ext_vector_type(2)));
typedef float f32x4 __attribute__((ext_vector_type(4)));
typedef float f32x2 __attribute__((ext_vector_type(2)));
typedef short bf16x8 __attribute__((ext_vector_type(8)));
typedef short s16x4 __attribute__((ext_vector_type(4)));

constexpr int NB = 4, SEQ = 8192, D = 1024, T = NB * SEQ, MEM = 256;
constexpr int NPROJ = 7168;
constexpr int NE = 256, TOPK = 8, FF = 256;
constexpr float LN_EPS = 1e-5f;
constexpr float YSCALE = 128.f;
constexpr float ALPHA = 1.189207115002721f;
constexpr int NWAVES = 8, NTHR = 512;
constexpr int SEG = 512, NSEG = SEQ / SEG, CH = 64;

constexpr size_t MiB = 1u << 20;
constexpr size_t WS_CTL = 0, CTL_ZERO_BYTES = 1 * MiB;
constexpr size_t WS_WIN = 1 * MiB;
constexpr size_t WS_WKV = 15 * MiB;
constexpr size_t WS_WFO = 17 * MiB;
constexpr size_t WS_WHO = 18 * MiB;
constexpr size_t WS_WXO = 19 * MiB;
constexpr size_t WS_WOUT = 20 * MiB;
constexpr size_t WS_WRS = 22 * MiB;
constexpr size_t WS_WSD = 24 * MiB;
constexpr size_t WS_A1 = 25 * MiB;
constexpr size_t WS_A3 = 26 * MiB;
constexpr size_t WS_MEMN = 30 * MiB;
constexpr size_t WS_EXPD = 32 * MiB;
constexpr size_t WS_H0 = 32 * MiB;
constexpr size_t WS_F = 96 * MiB;
constexpr size_t WS_MIX = 883 * MiB;
constexpr size_t WS_WBR = 17 * MiB;
constexpr size_t WS_Q = 160 * MiB;
constexpr size_t SEC_STRIDE = 32 * MiB;
constexpr size_t WS_S1 = 160 * MiB;
constexpr size_t WS_HACT = 160 * MiB;
constexpr size_t WS_GATES = 352 * MiB;
constexpr size_t WS_S2 = 320 * MiB;
constexpr size_t WS_ROUTE = 448 * MiB;
constexpr size_t WS_KV = 544 * MiB;
constexpr size_t WS_Y = 546 * MiB;
constexpr size_t WS_FM = 610 * MiB;
constexpr size_t WS_OLF = 642 * MiB, WS_OLB = 674 * MiB;
constexpr size_t WS_QSF = 706 * MiB, WS_QSB = 738 * MiB;
constexpr size_t WS_U = 770 * MiB;
constexpr size_t WS_DEC = 802 * MiB;
constexpr size_t WS_SST = 803 * MiB;
constexpr size_t WS_HO = 819 * MiB;
constexpr size_t WS_XO = 851 * MiB;
constexpr size_t WS_MERGED = 96 * MiB;
constexpr size_t WS_EXPGU = 512 * MiB;
constexpr size_t WS_H1 = 768 * MiB;
constexpr size_t WS_LOGIT = 832 * MiB;
constexpr size_t WS_HS = 864 * MiB;
constexpr size_t WS_YR = 512 * MiB;
constexpr size_t WS_END = 1024 * MiB;
constexpr size_t RT_EIDX = 0, RT_WGT = 1 * MiB, RT_POS = 2 * MiB, RT_ROWTOK = 3 * MiB, RT_ROWSLOT = 5 * MiB, RT_ROWGATE = 6 * MiB + 512 * 1024, RT_TRASH = 7 * MiB + 768 * 1024;
constexpr int RPAD_MAX = T * TOPK + NE * 255;
constexpr int CW_BAR = 4096;
constexpr int CW_CNT = 16384;

#define LDS_WAIT() asm volatile("s_waitcnt lgkmcnt(0)" ::: "memory")
#define VM_WAIT() asm volatile("s_waitcnt vmcnt(0)" ::: "memory")
typedef __bf16 bf16x2v __attribute__((ext_vector_type(2)));
__device__ __forceinline__ unsigned cvt_pk_bf16_c(float lo, float hi) { const f32x2 v = {lo, hi}; const bf16x2v b = __builtin_convertvector(v, bf16x2v); return __builtin_bit_cast(unsigned, b); }
__device__ __forceinline__ unsigned cvt_pk_bf16(float lo, float hi) { unsigned r; asm volatile("v_cvt_pk_bf16_f32 %0, %1, %2" : "=v"(r) : "v"(lo), "v"(hi)); return r; }
__device__ __forceinline__ float bflo(unsigned w) { return __uint_as_float(w << 16); }
__device__ __forceinline__ float bfhi(unsigned w) { return __uint_as_float(w & 0xffff0000u); }
__device__ __forceinline__ float bf2f(bf16 h) { return __uint_as_float(((unsigned)h) << 16); }
__device__ __forceinline__ bf16 f2bf(float f) { return (bf16)(cvt_pk_bf16(f, 0.f) & 0xffffu); }
__device__ __forceinline__ float sigmoidf_(float x) { return __builtin_amdgcn_rcpf(1.0f + __builtin_amdgcn_exp2f(-1.4426950408889634f * x)); }
__device__ __forceinline__ float siluf_(float x) { return x * __builtin_amdgcn_rcpf(1.0f + __builtin_amdgcn_exp2f(-1.4426950408889634f * x)); }
__device__ __forceinline__ float wave_sum(float v) {
#pragma unroll
    for (int o = 1; o < 64; o <<= 1) v += __shfl_xor(v, o);
    return v;
}

#define XB_TMO      128
#define XB_XCNT(j)  (256  + 64 * (j))
#define XB_XSUB(j)  (1280 + 64 * (j))
#define XB_XGEN(j)  (2304 + 64 * (j))
#define XB_TOP      3328
#define XB_TOPGEN   3392
#define XCD_BAR_WORDS 3456
#define XB_SPIN_CAP (1u << 22)
__device__ __forceinline__ unsigned xb_ld(unsigned* p)              { return __hip_atomic_load(p, __ATOMIC_RELAXED, __HIP_MEMORY_SCOPE_AGENT); }
__device__ __forceinline__ unsigned xb_add(unsigned* p, unsigned v) { return __hip_atomic_fetch_add(p, v, __ATOMIC_RELAXED, __HIP_MEMORY_SCOPE_AGENT); }
__device__ __forceinline__ unsigned xb_xcc_id() { return (unsigned)__builtin_amdgcn_s_getreg((3 << 11) | 20) & 0xFu; }
#define XB_SPIN(cond, bar) do { unsigned _sp = 0; while (cond) { __builtin_amdgcn_s_sleep(1); \
    if ((++_sp & 255u) == 0u) { if (xb_ld(&(bar)[XB_TMO])) break; if (_sp > XB_SPIN_CAP) { atomicAdd(&(bar)[XB_TMO], 1u); break; } } } } while (0)
struct XcdBarrier { unsigned* bar; unsigned x; volatile LAS unsigned* st; };
__device__ __forceinline__ XcdBarrier xcd_barrier_post(unsigned* bar, volatile LAS unsigned* st) {
    XcdBarrier b; b.bar = bar; b.x = xb_xcc_id(); b.st = st;
    if (threadIdx.x == 0) (void)xb_add(&bar[XB_XCNT(b.x)], 1u);
    return b;
}
__device__ __forceinline__ void xcd_barrier_complete(unsigned* bar, unsigned x, unsigned& nloc, unsigned& nx) {
    const unsigned G = gridDim.x * gridDim.y * gridDim.z;
    unsigned sum, cnt, mine, sp = 0u;
    for (;;) {
        sum = 0u; cnt = 0u; mine = 0u;
#pragma unroll
        for (unsigned j = 0; j < 16; ++j) { const unsigned c = xb_ld(&bar[XB_XCNT(j)]); sum += c; cnt += (c > 0u) ? 1u : 0u; mine = (j == x) ? c : mine; }
        if (sum == G) break;
        __builtin_amdgcn_s_sleep(1);
        if ((++sp & 255u) == 0u) { if (xb_ld(&bar[XB_TMO])) break; if (sp > XB_SPIN_CAP) { atomicAdd(&bar[XB_TMO], 1u); break; } }
    }
    nloc = mine > 0u ? mine : 1u; nx = cnt > 0u ? cnt : 1u;
}
__device__ __forceinline__ void xcd_barrier(const XcdBarrier& b) {
    asm volatile("s_waitcnt vmcnt(0)" ::: "memory");
    __syncthreads();
    if (threadIdx.x == 0) {
        unsigned* bar = b.bar;
        __builtin_amdgcn_s_waitcnt(0);
        unsigned nloc = b.st[0], nx = b.st[1];
        if (nloc == 0u) { xcd_barrier_complete(bar, b.x, nloc, nx); b.st[0] = nloc; b.st[1] = nx; }
        const unsigned old = xb_add(&bar[XB_XSUB(b.x)], 1u);
        const unsigned gen = old / nloc;
        if (old + 1u == (gen + 1u) * nloc) {
            __builtin_amdgcn_fence(__ATOMIC_RELEASE, "agent");
            asm volatile("s_waitcnt vmcnt(0)" ::: "memory");
            const unsigned og = xb_add(&bar[XB_TOP], 1u);
            const unsigned tg = og / nx;
            if (og + 1u == (tg + 1u) * nx) xb_add(&bar[XB_TOPGEN], 1u);
            else XB_SPIN(xb_ld(&bar[XB_TOPGEN]) == tg, bar);
            __builtin_amdgcn_fence(__ATOMIC_ACQUIRE, "agent");
            xb_add(&bar[XB_XGEN(b.x)], 1u);
            asm volatile("s_waitcnt vmcnt(0)" ::: "memory");
        } else {
            XB_SPIN(xb_ld(&bar[XB_XGEN(b.x)]) == gen, bar);
            __builtin_amdgcn_fence(__ATOMIC_ACQUIRE, "agent");
            asm volatile("s_waitcnt vmcnt(0)" ::: "memory");
        }
    }
    __syncthreads();
}

namespace pg8 {
constexpr int BM = 256, BK = 64, HALF = 128, HTB = HALF * BK * 2, STAGE_BYTES = 8 * HTB, NXCD = 8, WGM = 8;
__host__ __device__ __forceinline__ int lds_byte(int r, int c) { const int st = (r >> 4) * 2 + (c >> 5), rr = r & 15, cc = c & 31, ob = rr * 64 + cc * 2; return st * 1024 + (ob ^ (((ob >> 9) & 1) << 5)); }
__host__ __device__ __forceinline__ void stage_rc(int b, int& R, int& C) { const int st = b / 1024, sb = b % 1024, swz = sb ^ (((sb >> 9) & 1) << 5); R = (st >> 1) * 16 + swz / 64; C = (st & 1) * 32 + (swz % 64) / 2; }
__host__ __device__ __forceinline__ int perm32(int rho) { const int n = rho >> 4, i = rho & 15; return 8 * (i >> 2) + 4 * n + (i & 3); }
struct Unit { int pm, pn; };
struct Gemm { const bf16* A; const bf16* Bt; int K; };
struct StaticOrder {
    int nM, nN, nwg, G, c;
    __device__ void init(int M, int N, int G_, int c_) { nM = M / BM; nN = N / BM; nwg = nM * nN; G = G_; c = c_; }
    __device__ bool next(int i, Unit& u) const {
        const long L = (long)i * G + c; if (L >= nwg) return false;
        int wgid = (int)L; { const int q = nwg / NXCD, r = nwg % NXCD, xcd = wgid % NXCD, off = wgid / NXCD; wgid = (xcd < r ? xcd * (q + 1) : r * (q + 1) + (xcd - r) * q) + off; }
        const int nig = WGM * nN, gid = wgid / nig, fm = gid * WGM, gsz = (nM - fm) < WGM ? (nM - fm) : WGM;
        u.pm = fm + ((wgid % nig) % gsz); u.pn = (wgid % nig) / gsz; return true;
    }
};
template <int J> struct ExpertOrder {
    int nunits, G, c; const LAS unsigned short* te;
    __device__ bool next(int i, Unit& u) const {
        const int nb = G >> 3, tpx = nb / J, x = c & 7, k = c >> 3;
        int tau, j;
        if ((G & 7) == 0 && tpx * J == nb) { tau = (i * 8 + x) * tpx + k / J; j = k % J; }
        else { const int L = i * G + c; tau = L / J; j = L - tau * J; }
        if (tau * J + j >= nunits) return false;
        u.pm = tau; u.pn = (int)te[tau] * J + j; return true;
    }
};
template <class Epi, class Sched, bool GATHER>
__device__ __forceinline__ void gemm_phase(LAS unsigned char* lds, const Gemm g, const Sched& S, const Epi& E, const int* rowidx) {
    int tid_ = threadIdx.x; asm volatile("" : "+v"(tid_));
    const int tid = tid_, wid = __builtin_amdgcn_readfirstlane(tid >> 6), lane = tid & 63, wr = wid >> 2, wc = wid & 3, fr = lane & 15, fq = lane >> 4;
    const int K = g.K, nt = K / BK;
    unsigned voffB[2], voffC[2][2];
    LAS v4u* gsl = (LAS v4u*)(lds + STAGE_BYTES + 8192) + tid;
    const size_t kstep = (size_t)(BK * 2);
    const size_t hstep = (size_t)HALF * K * 2;
    const size_t tstep = 2 * hstep;
#pragma unroll
    for (int i = 0; i < 2; ++i) { int R, C; stage_rc(tid * 16 + i * 8192, R, C); const int Rb = Epi::PERM ? ((R & ~31) + perm32(R & 31)) : R;
        voffB[i] = (unsigned)(Rb * K + C) * 2u; voffC[0][i] = (unsigned)(R * K + C) * 2u; voffC[1][i] = voffC[0][i] + (unsigned)hstep; }
    const unsigned ldsw = (unsigned)wid * 1024u;
    const int aoff = lds_byte(wr * 64 + fr, fq * 8), boff = lds_byte(wc * 32 + fr, fq * 8);
#define PG8_SA(b, h) (((b) * 2 + (h)) * HTB)
#define PG8_SB(b, h) ((4 + (b) * 2 + (h)) * HTB)
#define PG8_STAGE(bufoff, gbase, voff) do { const char* _gb = (const char*)(gbase); _Pragma("unroll") for (int _i = 0; _i < 2; ++_i) { unsigned _keep; \
        asm volatile("s_mov_b32 %0, m0\n\ts_mov_b32 m0, %3\n\ts_nop 0\n\tglobal_load_lds_dwordx4 %1, %2\n\ts_mov_b32 m0, %0" : "=&s"(_keep) : "v"((voff)[_i]), "s"(_gb), "s"((unsigned)(size_t)(lds + (bufoff) + ldsw + _i * 8192)) : "memory"); } } while (0)
#define PG8_LDA(dst, b, h) do { _Pragma("unroll") for (int m = 0; m < 4; ++m) _Pragma("unroll") for (int k = 0; k < 2; ++k) dst[m][k] = *(const LAS bf16x8*)(lds + PG8_SA(b, h) + aoff + m * 2048 + k * 1024); } while (0)
#define PG8_LDB(dst, b, h) do { _Pragma("unroll") for (int n = 0; n < 2; ++n) _Pragma("unroll") for (int k = 0; k < 2; ++k) dst[n][k] = *(const LAS bf16x8*)(lds + PG8_SB(b, h) + boff + n * 2048 + k * 1024); } while (0)
#define PG8_MMA(ai, bj, At, Bt) do { __builtin_amdgcn_s_setprio(1); _Pragma("unroll") for (int m = 0; m < 4; ++m) _Pragma("unroll") for (int n = 0; n < 2; ++n) _Pragma("unroll") for (int k = 0; k < 2; ++k) \
        acc[ai][bj][m][n] = __builtin_amdgcn_mfma_f32_16x16x32_bf16(Bt[n][k], At[m][k], acc[ai][bj][m][n], 0, 0, 0); __builtin_amdgcn_s_setprio(0); } while (0)
#define PG8_WAIT_V(n) asm volatile("s_waitcnt vmcnt(" #n ")" ::: "memory")
#define PG8_WAIT_L(n) asm volatile("s_waitcnt lgkmcnt(" #n ")" ::: "memory")
#define PG8_BAR __builtin_amdgcn_s_barrier()
#define PG8_SCHED __builtin_amdgcn_sched_barrier(0)
#define PG8_GSTORE(set, u) do { unsigned _v[2][2]; _Pragma("unroll") for (int _i = 0; _i < 2; ++_i) { int _R, _C; stage_rc(tid * 16 + _i * 8192, _R, _C); \
        _Pragma("unroll") for (int _h = 0; _h < 2; ++_h) _v[_h][_i] = ((unsigned)rowidx[(u).pm * BM + _h * HALF + _R] * (unsigned)K + (unsigned)_C) * 2u; } \
        gsl[(set) * 512] = (v4u){_v[0][0], _v[0][1], _v[1][0], _v[1][1]}; } while (0)
#define PG8_GRD(dst, h, set) unsigned dst[2]; do { if constexpr (GATHER) { const v2u _o = ((const LAS v2u*)(gsl + (set) * 512))[h]; dst[0] = _o.x; dst[1] = _o.y; } else { dst[0] = voffC[h][0]; dst[1] = voffC[h][1]; } } while (0)
    Unit cur, nxt; int ui = 0;
    if (!S.next(0, cur)) return;
    f32x4 acc[2][2][4][2];
#pragma unroll
    for (int a = 0; a < 2; ++a)
#pragma unroll
        for (int b = 0; b < 2; ++b)
#pragma unroll
            for (int m = 0; m < 4; ++m)
#pragma unroll
                for (int n = 0; n < 2; ++n) acc[a][b][m][n] = (f32x4){0.f, 0.f, 0.f, 0.f};
    bf16x8 At[4][2], B0[2][2], B1[2][2];
    const char* cA = GATHER ? (const char*)g.A : (const char*)g.A + (size_t)cur.pm * tstep; const char* cB = (const char*)g.Bt + (size_t)cur.pn * tstep;
    int par = 0;
    LAS v2u* const rib = (LAS v2u*)(lds + STAGE_BYTES + 2560);
    if constexpr (GATHER) { PG8_GSTORE(0, cur); }
    if constexpr (Epi::PRE) E.pre(cur, rib, tid);
    { PG8_GRD(p0, 0, 0); PG8_GRD(p1, 1, 0);
    PG8_STAGE(PG8_SB(0, 0), cB, voffB); PG8_STAGE(PG8_SB(0, 1), cB + hstep, voffB); PG8_STAGE(PG8_SA(0, 0), cA, p0); PG8_STAGE(PG8_SA(0, 1), cA, p1);
    if (wr == 1) PG8_BAR;
    PG8_WAIT_V(2); PG8_BAR;
    PG8_STAGE(PG8_SB(1, 0), cB + kstep, voffB); PG8_STAGE(PG8_SA(1, 0), cA + kstep, p0); PG8_STAGE(PG8_SB(1, 1), cB + hstep + kstep, voffB); }
    PG8_WAIT_V(6); PG8_BAR;
    for (;;) {
        const bool has_next = S.next(ui + 1, nxt);
        const char* nA = GATHER ? (const char*)g.A : (has_next ? (const char*)g.A + (size_t)nxt.pm * tstep : cA); const char* nB = has_next ? (const char*)g.Bt + (size_t)nxt.pn * tstep : cB;
        if constexpr (GATHER) { if (has_next) { PG8_GSTORE(par ^ 1, nxt); } else { gsl[(par ^ 1) * 512] = gsl[par * 512]; } }
        for (int t = 0; t < nt; t += 2) {
            const bool last = (t == nt - 2);
            const char* a1 = cA + (size_t)(t + 1) * kstep;
            const char* a2 = last ? nA : cA + (size_t)(t + 2) * kstep; const char* b2 = last ? nB : cB + (size_t)(t + 2) * kstep;
            const char* a3 = a2 + kstep; const char* b3 = b2 + kstep;
            const int s2 = (GATHER && last) ? (par ^ 1) : par;
            { PG8_GRD(o, 1, par); PG8_LDB(B0, 0, 0); PG8_LDB(B1, 0, 1); PG8_SCHED; PG8_LDA(At, 0, 0); PG8_STAGE(PG8_SA(1, 1), a1, o); }
            PG8_WAIT_V(8); PG8_WAIT_L(0); PG8_BAR; PG8_MMA(0, 0, At, B0); PG8_MMA(0, 1, At, B1); PG8_BAR; PG8_SCHED;
            { PG8_GRD(o, 0, s2); PG8_LDA(At, 0, 1); PG8_STAGE(PG8_SB(0, 0), b2, voffB); PG8_STAGE(PG8_SB(0, 1), b2 + hstep, voffB); PG8_STAGE(PG8_SA(0, 0), a2, o); }
            PG8_WAIT_V(8); PG8_WAIT_L(0); PG8_BAR; PG8_MMA(1, 0, At, B0); PG8_MMA(1, 1, At, B1); PG8_BAR; PG8_SCHED;
            { PG8_GRD(o, 1, s2); PG8_LDB(B0, 1, 0); PG8_LDB(B1, 1, 1); PG8_SCHED; PG8_LDA(At, 1, 0); PG8_STAGE(PG8_SA(0, 1), a2, o); }
            PG8_WAIT_V(8); PG8_WAIT_L(0); PG8_BAR; PG8_MMA(0, 0, At, B0); PG8_MMA(0, 1, At, B1); PG8_BAR; PG8_SCHED;
            { PG8_GRD(o, 0, s2); PG8_LDA(At, 1, 1); PG8_STAGE(PG8_SB(1, 0), b3, voffB); PG8_STAGE(PG8_SB(1, 1), b3 + hstep, voffB); PG8_STAGE(PG8_SA(1, 0), a3, o); }
            PG8_WAIT_V(8); PG8_WAIT_L(0); PG8_BAR; PG8_MMA(1, 0, At, B0); PG8_MMA(1, 1, At, B1); PG8_BAR; PG8_SCHED;
        }
        if (wr == 0) PG8_BAR;
        asm volatile("s_nop 15\n\ts_nop 15" ::: "memory");
        if constexpr (Epi::PRE) E(acc, cur, wr, wc, fr, fq, rib + par * 256); else E(acc, cur, wr, wc, fr, fq);
        if (!has_next) break;
        bool zero = true;
        if constexpr (Epi::CHAIN) zero = !E.keep(cur);
        if (zero) {
#pragma unroll
        for (int a = 0; a < 2; ++a)
#pragma unroll
            for (int b = 0; b < 2; ++b)
#pragma unroll
                for (int m = 0; m < 4; ++m)
#pragma unroll
                    for (int n = 0; n < 2; ++n) acc[a][b][m][n] = (f32x4){0.f, 0.f, 0.f, 0.f};
        }
        cur = nxt; cA = nA; cB = nB; ++ui; par ^= 1;
        if constexpr (Epi::PRE) E.pre(cur, rib + par * 256, tid);
        if (wr == 1) PG8_BAR;
    }
    PG8_WAIT_V(0);
    PG8_BAR;
#undef PG8_SA
#undef PG8_SB
#undef PG8_STAGE
#undef PG8_LDA
#undef PG8_LDB
#undef PG8_MMA
#undef PG8_WAIT_V
#undef PG8_WAIT_L
#undef PG8_BAR
#undef PG8_SCHED
#undef PG8_GSTORE
#undef PG8_GRD
}
}
using pg8::Unit;

typedef f32x4 AccT[2][2][4][2];
__device__ __forceinline__ v4u pack8(const f32x4 a, const f32x4 b) { v4u w; w.x = cvt_pk_bf16(a[0], a[1]); w.y = cvt_pk_bf16(a[2], a[3]); w.z = cvt_pk_bf16(b[0], b[1]); w.w = cvt_pk_bf16(b[2], b[3]); return w; }

struct EpiProj {
    static constexpr bool PERM = true, PRE = false, CHAIN = false;
    bf16* F; bf16* SEC; bf16* GATES; const float* bgate;
    __device__ __forceinline__ void operator()(const AccT& acc, const Unit& u, int wr, int wc, int fr, int fq) const {
        const int pn = u.pn; bf16* base; int ldc, colt, mode;
        if (pn < 4) { base = F; ldc = 1024; colt = pn * 256; mode = 0; }
        else if (pn < 16) { const int s = (pn - 4) >> 1; base = SEC + (size_t)s * (SEC_STRIDE / 2); ldc = 512; colt = ((pn - 4) & 1) * 256; mode = (s == 0 || s == 4) ? 1 : (s == 5 ? 3 : 0); }
        else { base = GATES; ldc = 3072; colt = (pn - 16) * 256; mode = 2; }
        const int row0 = u.pm * 256 + wr * 64 + fr, col0 = colt + wc * 32 + 8 * fq;
        f32x4 bv[2][2];
#pragma unroll
        for (int bj = 0; bj < 2; ++bj)
#pragma unroll
            for (int n = 0; n < 2; ++n) bv[bj][n] = (mode == 2) ? *(const f32x4*)(bgate + col0 + bj * 128 + 4 * n) : (f32x4){0.f, 0.f, 0.f, 0.f};
#pragma unroll
        for (int ai = 0; ai < 2; ++ai)
#pragma unroll
            for (int m = 0; m < 4; ++m) { bf16* rowp = base + (size_t)(row0 + ai * 128 + m * 16) * ldc + col0;
#pragma unroll
                for (int bj = 0; bj < 2; ++bj) { f32x4 v0 = acc[ai][bj][m][0] + bv[bj][0], v1 = acc[ai][bj][m][1] + bv[bj][1];
                    if (mode == 1) {
#pragma unroll
                        for (int j = 0; j < 4; ++j) { v0[j] = siluf_(v0[j]); v1[j] = siluf_(v1[j]); } }
                    else if (mode == 2) {
#pragma unroll
                        for (int j = 0; j < 4; ++j) { v0[j] = sigmoidf_(v0[j]); v1[j] = sigmoidf_(v1[j]); } }
                    else if (mode == 3) { v0 = v0 * 0.12751743f; v1 = v1 * 0.12751743f; }
                    *(v4u*)(rowp + bj * 128) = pack8(v0, v1); } }
    }
};
struct EpiPlain {
    static constexpr bool PERM = true, PRE = false, CHAIN = false;
    bf16* O; int ldc;
    __device__ __forceinline__ void operator()(const AccT& acc, const Unit& u, int wr, int wc, int fr, int fq) const {
        const int row0 = u.pm * 256 + wr * 64 + fr, col0 = u.pn * 256 + wc * 32 + 8 * fq;
#pragma unroll
        for (int ai = 0; ai < 2; ++ai)
#pragma unroll
            for (int m = 0; m < 4; ++m) { bf16* rowp = O + (size_t)(row0 + ai * 128 + m * 16) * ldc + col0;
#pragma unroll
                for (int bj = 0; bj < 2; ++bj) *(v4u*)(rowp + bj * 128) = pack8(acc[ai][bj][m][0], acc[ai][bj][m][1]); }
    }
};
struct EpiMix {
    static constexpr bool PERM = true, PRE = false, CHAIN = true;
    bf16* M; const bf16* gates; const float* bias;
    static __device__ __forceinline__ float rt(float n, float d) { return fmaxf(n, 1e-7f) * __builtin_amdgcn_rcpf(fmaxf(d, 1e-7f)); }
    __device__ __forceinline__ bool keep(const Unit& u) const { return (u.pn >> 2) < 2; }
    __device__ __forceinline__ void operator()(AccT& acc, const Unit& u, int wr, int wc, int fr, int fq) const {
        const int s = u.pn >> 2, row0 = (u.pm & 127) * 256 + wr * 64 + fr, col0 = (u.pn & 3) * 256 + wc * 32 + 8 * fq;
        if (s < 2) {
#pragma unroll
            for (int bj = 0; bj < 2; ++bj) {
                f32x4 b0 = (f32x4){0.f, 0.f, 0.f, 0.f}, b1 = b0;
                if (s == 0) { b0 = *(const f32x4*)(bias + col0 + bj * 128); b1 = *(const f32x4*)(bias + col0 + bj * 128 + 4); }
#pragma unroll
                for (int ai = 0; ai < 2; ++ai)
#pragma unroll
                    for (int m = 0; m < 4; ++m) { const bf16* gp = gates + (size_t)(row0 + ai * 128 + m * 16) * 3072 + s * 1024 + col0 + bj * 128;
                        const v4u gn = *(const v4u*)gp, gd = *(const v4u*)(gp + 1024);
                        f32x4 r0, r1;
                        r0[0] = rt(bflo(gn.x), bflo(gd.x)); r0[1] = rt(bfhi(gn.x), bfhi(gd.x)); r0[2] = rt(bflo(gn.y), bflo(gd.y)); r0[3] = rt(bfhi(gn.y), bfhi(gd.y));
                        r1[0] = rt(bflo(gn.z), bflo(gd.z)); r1[1] = rt(bfhi(gn.z), bfhi(gd.z)); r1[2] = rt(bflo(gn.w), bflo(gd.w)); r1[3] = rt(bfhi(gn.w), bfhi(gd.w));
                        acc[ai][bj][m][0] = (acc[ai][bj][m][0] + b0) * r0; acc[ai][bj][m][1] = (acc[ai][bj][m][1] + b1) * r1;
                        asm volatile("" ::: "memory"); }
            }
        } else {
#pragma unroll
            for (int ai = 0; ai < 2; ++ai)
#pragma unroll
                for (int m = 0; m < 4; ++m) { const size_t row = (size_t)(row0 + ai * 128 + m * 16);
#pragma unroll
                    for (int bj = 0; bj < 2; ++bj) { const v4u gw = *(const v4u*)(gates + row * 3072 + 2048 + col0 + bj * 128);
                        const f32x4 v0 = acc[ai][bj][m][0], v1 = acc[ai][bj][m][1]; f32x4 o0, o1;
                        o0[0] = fmaxf(bflo(gw.x), 1e-7f) * v0[0]; o0[1] = fmaxf(bfhi(gw.x), 1e-7f) * v0[1]; o0[2] = fmaxf(bflo(gw.y), 1e-7f) * v0[2]; o0[3] = fmaxf(bfhi(gw.y), 1e-7f) * v0[3];
                        o1[0] = fmaxf(bflo(gw.z), 1e-7f) * v1[0]; o1[1] = fmaxf(bfhi(gw.z), 1e-7f) * v1[1]; o1[2] = fmaxf(bflo(gw.w), 1e-7f) * v1[2]; o1[3] = fmaxf(bfhi(gw.w), 1e-7f) * v1[3];
                        *(v4u*)(M + row * 1024 + col0 + bj * 128) = pack8(o0, o1); } }
        }
    }
};
struct ChainOrder {
    pg8::StaticOrder S;
    __device__ bool next(int i, Unit& u) const { const int ti = i / 3, s = i - 3 * ti; if (!S.next(ti, u)) return false; u.pm += 128 * s; u.pn += 4 * s; return true; }
};
struct EpiResid {
    static constexpr bool PERM = true, PRE = false, CHAIN = false;
    bf16* O; const bf16* R;
    __device__ __forceinline__ void operator()(const AccT& acc, const Unit& u, int wr, int wc, int fr, int fq) const {
        const int row0 = u.pm * 256 + wr * 64 + fr, col0 = u.pn * 256 + wc * 32 + 8 * fq;
#pragma unroll
        for (int ai = 0; ai < 2; ++ai)
#pragma unroll
            for (int m = 0; m < 4; ++m) { const size_t off = (size_t)(row0 + ai * 128 + m * 16) * 1024 + col0;
#pragma unroll
                for (int bj = 0; bj < 2; ++bj) { const v4u rw = *(const v4u*)(R + off + bj * 128);
                    f32x4 o0 = acc[ai][bj][m][0], o1 = acc[ai][bj][m][1];
                    o0[0] += ALPHA * bflo(rw.x); o0[1] += ALPHA * bfhi(rw.x); o0[2] += ALPHA * bflo(rw.y); o0[3] += ALPHA * bfhi(rw.y);
                    o1[0] += ALPHA * bflo(rw.z); o1[1] += ALPHA * bfhi(rw.z); o1[2] += ALPHA * bflo(rw.w); o1[3] += ALPHA * bfhi(rw.w);
                    *(v4u*)(O + off + bj * 128) = pack8(o0, o1); } }
    }
};
struct EpiRouterShared {
    static constexpr bool PERM = true, PRE = false, CHAIN = false;
    float* L; bf16* HS;
    __device__ __forceinline__ void operator()(const AccT& acc, const Unit& u, int wr, int wc, int fr, int fq) const {
        const int row0 = u.pm * 256 + wr * 64 + fr, cl = wc * 32 + 8 * fq;
        if (u.pn == 0) {
#pragma unroll
            for (int ai = 0; ai < 2; ++ai)
#pragma unroll
                for (int m = 0; m < 4; ++m) { float* rowp = L + (size_t)(row0 + ai * 128 + m * 16) * 256 + cl;
#pragma unroll
                    for (int bj = 0; bj < 2; ++bj)
#pragma unroll
                        for (int n = 0; n < 2; ++n) *(f32x4*)(rowp + bj * 128 + 4 * n) = acc[ai][bj][m][n]; }
        } else {
            const int colt = (u.pn - 1) * 128;
#pragma unroll
            for (int ai = 0; ai < 2; ++ai)
#pragma unroll
                for (int m = 0; m < 4; ++m) { bf16* rowp = HS + (size_t)(row0 + ai * 128 + m * 16) * 256 + colt + cl;
                    f32x4 h0, h1;
#pragma unroll
                    for (int j = 0; j < 4; ++j) { h0[j] = siluf_(acc[ai][0][m][0][j]) * acc[ai][1][m][0][j]; h1[j] = siluf_(acc[ai][0][m][1][j]) * acc[ai][1][m][1][j]; }
                    *(v4u*)rowp = pack8(h0, h1); }
        }
    }
};
struct EpiExpGU {
    static constexpr bool PERM = true, PRE = false, CHAIN = false;
    bf16* H;
    __device__ __forceinline__ void operator()(const AccT& acc, const Unit& u, int wr, int wc, int fr, int fq) const {
        const int row0 = u.pm * 256 + wr * 64 + fr, col0 = (u.pn & 1) * 128 + wc * 32 + 8 * fq;
#pragma unroll
        for (int ai = 0; ai < 2; ++ai)
#pragma unroll
            for (int m = 0; m < 4; ++m) { bf16* rowp = H + (size_t)(row0 + ai * 128 + m * 16) * 256 + col0;
                f32x4 h0, h1;
#pragma unroll
                for (int j = 0; j < 4; ++j) { h0[j] = siluf_(acc[ai][0][m][0][j]) * acc[ai][1][m][0][j]; h1[j] = siluf_(acc[ai][0][m][1][j]) * acc[ai][1][m][1][j]; }
                *(v4u*)rowp = pack8(h0, h1); }
    }
};
struct EpiExpDown {
    static constexpr bool PERM = true, PRE = true, CHAIN = false;
    unsigned char* Y; const v2u* rowinfo; unsigned char* trash;
    __device__ __forceinline__ void pre(const Unit& u, LAS v2u* ri, int tid) const { if (tid < 256) ri[tid] = rowinfo[(size_t)u.pm * 256 + tid]; }
    __device__ __forceinline__ void operator()(const AccT& acc, const Unit& u, int wr, int wc, int fr, int fq, const LAS v2u* ri) const {
        const int rl0 = wr * 64 + fr, col0 = (u.pn & 3) * 256 + wc * 32 + 8 * fq;
#pragma unroll
        for (int ai = 0; ai < 2; ++ai)
#pragma unroll
            for (int m = 0; m < 4; ++m) { const v2u info = ri[rl0 + ai * 128 + m * 16]; const int slot = (int)info.x; const float gt = __uint_as_float(info.y) * YSCALE;
                unsigned char* rowp = (slot >= 0 ? Y + (size_t)slot * 1024 : trash) + col0;
#pragma unroll
                for (int bj = 0; bj < 2; ++bj) { const f32x4 a = acc[ai][bj][m][0] * gt, b = acc[ai][bj][m][1] * gt; v2u w;
                    int p = __builtin_amdgcn_cvt_pk_fp8_f32(fminf(fmaxf(a[0], -448.f), 448.f), fminf(fmaxf(a[1], -448.f), 448.f), 0, false);
                    p = __builtin_amdgcn_cvt_pk_fp8_f32(fminf(fmaxf(a[2], -448.f), 448.f), fminf(fmaxf(a[3], -448.f), 448.f), p, true); w.x = (unsigned)p;
                    p = __builtin_amdgcn_cvt_pk_fp8_f32(fminf(fmaxf(b[0], -448.f), 448.f), fminf(fmaxf(b[1], -448.f), 448.f), 0, false);
                    p = __builtin_amdgcn_cvt_pk_fp8_f32(fminf(fmaxf(b[2], -448.f), 448.f), fminf(fmaxf(b[3], -448.f), 448.f), p, true); w.y = (unsigned)p;
                    *(v2u*)(rowp + bj * 128) = w; } }
    }
};

constexpr int RING_OFF = 0, RING_BYTES = 131072;
constexpr int LDSX_OFF = RING_BYTES;
constexpr int LDS_BYTES = 163840;
constexpr int LDSCTL_OFF = LDS_BYTES - 256;

struct Frame {
    LAS unsigned char* lds;
    unsigned* ctl;
    unsigned char* ws;
    int tid, lane, wave, G, bid;
    float* out;
};
__device__ __forceinline__ const float* in_ptr(int i) { const float* const* ka = (const float* const*)__builtin_amdgcn_kernarg_segment_ptr(); asm volatile("" : "+s"(ka)); return ka[i]; }
enum { I_X = 0, I_MEM, I_LNIG, I_LNIB, I_LNMG, I_LNMB, I_LBF, I_LBB, I_WIN, I_BGATE, I_HNG, I_WKV, I_WFO, I_BFO, I_WHO, I_WXO, I_WOUT, I_LN1G, I_LN1B, I_WR, I_RB, I_WEG, I_WEU, I_WED, I_WSG, I_WSU, I_WSD, I_LN2G, I_LN2B };

__device__ __forceinline__ void tr_item(const float* src0, int lds_, bf16* dst0, int ldd, LAS float* scr, int lane) {
    f32x4 v[8];
#pragma unroll
    for (int i = 0; i < 8; ++i) v[i] = *(const f32x4*)(src0 + (size_t)((lane >> 3) + 8 * i) * lds_ + 4 * (lane & 7));
#pragma unroll
    for (int i = 0; i < 8; ++i) { LAS float* d = scr + ((lane >> 3) + 8 * i) * 33 + 4 * (lane & 7); d[0] = v[i][0]; d[1] = v[i][1]; d[2] = v[i][2]; d[3] = v[i][3]; }
    LDS_WAIT(); asm volatile("" ::: "memory");
    const int c = lane & 7;
#pragma unroll
    for (int j = 0; j < 4; ++j) { const int n = (lane >> 3) + 8 * j; const LAS float* s = scr + (8 * c) * 33 + n;
        v4u o; o.x = cvt_pk_bf16(s[0 * 33], s[1 * 33]); o.y = cvt_pk_bf16(s[2 * 33], s[3 * 33]); o.z = cvt_pk_bf16(s[4 * 33], s[5 * 33]); o.w = cvt_pk_bf16(s[6 * 33], s[7 * 33]);
        *(v4u*)(dst0 + (size_t)n * ldd + 8 * c) = o; }
    LDS_WAIT(); asm volatile("" ::: "memory");
}
__device__ __forceinline__ void conv_matrix(Frame& F, const float* src, size_t mat_stride, int nmat, int K, int ldsrc, int n_lo, int ncols, bf16* dst, int rbase, int rstride, int rmul, int dld = 0, int dko = 0) {
    if (dld == 0) dld = K;
    LAS float* scr = (LAS float*)(F.lds + RING_OFF + F.wave * 16384);
    const int gw = F.bid * NWAVES + F.wave, NGW = F.G * NWAVES;
    const int nkb = K / 64, nnb = ncols / 32, per = nkb * nnb, total = per * nmat;
    for (int it = gw; it < total; it += NGW) {
        const int e = it / per, r = it - e * per, kb = r / nnb, nb = r - kb * nnb, n = nb * 32;
        const int drow = rbase + e * rstride + (n >> 7) * rmul + (n & 127);
        tr_item(src + (size_t)e * mat_stride + (size_t)(kb * 64) * ldsrc + n_lo + n, ldsrc, dst + (size_t)drow * dld + dko + kb * 64, dld, scr, F.lane);
    }
}
__device__ __forceinline__ void ln_row_bf16(const float* xrow, const float* g, const float* b, bf16* orow, int lane) {
    const f32x4* xr = (const f32x4*)xrow + lane;
    f32x4 v[4]; float s = 0.f;
#pragma unroll
    for (int j = 0; j < 4; ++j) { v[j] = xr[64 * j]; s += (v[j][0] + v[j][1]) + (v[j][2] + v[j][3]); }
    const float mean = wave_sum(s) * (1.f / 1024.f); float s2 = 0.f;
#pragma unroll
    for (int j = 0; j < 4; ++j) { v[j] = v[j] - mean; s2 += (v[j][0] * v[j][0] + v[j][1] * v[j][1]) + (v[j][2] * v[j][2] + v[j][3] * v[j][3]); }
    const float rstd = 1.f / sqrtf(wave_sum(s2) * (1.f / 1024.f) + LN_EPS);
    v2u* o8 = (v2u*)orow + lane;
#pragma unroll
    for (int j = 0; j < 4; ++j) { const f32x4 gg = ((const f32x4*)g)[lane + 64 * j], bb = ((const f32x4*)b)[lane + 64 * j]; const f32x4 y = v[j] * rstd * gg + bb;
        v2u w; w.x = cvt_pk_bf16(y[0], y[1]); w.y = cvt_pk_bf16(y[2], y[3]); o8[64 * j] = w; }
}

__device__ __forceinline__ void ln_rowb_bf16(const bf16* xrow, const float* g, const float* b, bf16* orow, int lane) {
    const v2u* xr = (const v2u*)xrow + lane;
    f32x4 v[4]; float s = 0.f;
#pragma unroll
    for (int j = 0; j < 4; ++j) { const v2u w = xr[64 * j]; v[j][0] = bflo(w.x); v[j][1] = bfhi(w.x); v[j][2] = bflo(w.y); v[j][3] = bfhi(w.y); s += (v[j][0] + v[j][1]) + (v[j][2] + v[j][3]); }
    const float mean = wave_sum(s) * (1.f / 1024.f); float s2 = 0.f;
#pragma unroll
    for (int j = 0; j < 4; ++j) { v[j] = v[j] - mean; s2 += (v[j][0] * v[j][0] + v[j][1] * v[j][1]) + (v[j][2] * v[j][2] + v[j][3] * v[j][3]); }
    const float rstd = 1.f / sqrtf(wave_sum(s2) * (1.f / 1024.f) + LN_EPS);
    v2u* o8 = (v2u*)orow + lane;
#pragma unroll
    for (int j = 0; j < 4; ++j) { const f32x4 gg = ((const f32x4*)g)[lane + 64 * j], bb = ((const f32x4*)b)[lane + 64 * j]; const f32x4 y = v[j] * rstd * gg + bb;
        v2u w; w.x = cvt_pk_bf16(y[0], y[1]); w.y = cvt_pk_bf16(y[2], y[3]); o8[64 * j] = w; }
}
__device__ __forceinline__ void p0_prologue(Frame& F) {
    const int gw = F.bid * NWAVES + F.wave, NGW = F.G * NWAVES;
    unsigned char* ws = F.ws;
    {
        LAS float* scr = (LAS float*)(F.lds + RING_OFF + F.wave * 16384);
        for (int it = gw; it < 5376; it += NGW) {
            int r = it, mi, K, ld, nlo, ncols, rbase, rmul; size_t doff;
            if (r < 3072) { mi = I_WIN; K = 1024; ld = 6656; nlo = 512; ncols = 6144; doff = WS_WIN; rbase = 1024; rmul = 128; }
            else if ((r -= 3072) < 512) { mi = I_WKV; K = 1024; ld = 1024; nlo = 0; ncols = 1024; doff = WS_WKV; rbase = 0; rmul = 128; }
            else if ((r -= 512) < 256) { mi = I_WFO; K = 512; ld = 1024; nlo = 0; ncols = 1024; doff = WS_WBR; rbase = 0; rmul = 128; }
            else if ((r -= 256) < 256) { mi = I_WHO; K = 512; ld = 1024; nlo = 0; ncols = 1024; doff = WS_WBR; rbase = 1024; rmul = 128; }
            else if ((r -= 256) < 256) { mi = I_WXO; K = 512; ld = 1024; nlo = 0; ncols = 1024; doff = WS_WBR; rbase = 2048; rmul = 128; }
            else if ((r -= 256) < 512) { mi = I_WOUT; K = 1024; ld = 1024; nlo = 0; ncols = 1024; doff = WS_WOUT; rbase = 0; rmul = 128; }
            else if ((r -= 512) < 128) { mi = I_WR; K = 1024; ld = 256; nlo = 0; ncols = 256; doff = WS_WRS; rbase = 0; rmul = 128; }
            else if ((r -= 128) < 128) { mi = I_WSG; K = 1024; ld = 256; nlo = 0; ncols = 256; doff = WS_WRS; rbase = 256; rmul = 256; }
            else if ((r -= 128) < 128) { mi = I_WSU; K = 1024; ld = 256; nlo = 0; ncols = 256; doff = WS_WRS; rbase = 384; rmul = 256; }
            else { r -= 128; mi = I_WSD; K = 256; ld = 1024; nlo = 0; ncols = 1024; doff = WS_WSD; rbase = 0; rmul = 128; }
            const int nnb = ncols / 32, kb = r / nnb, nb = r - kb * nnb, n = nb * 32, drow = rbase + (n >> 7) * rmul + (n & 127);
            tr_item(in_ptr(mi) + (size_t)(kb * 64) * ld + nlo + n, ld, (bf16*)(ws + doff) + (size_t)drow * K + kb * 64, K, scr, F.lane);
        }
    }
    {
        LAS float* ct = (LAS float*)(F.lds + LDSX_OFF);
        if (F.tid < 128) { float sn, cs; __sincosf(6.283185307179586f * (float)F.tid / 128.f, &sn, &cs); ct[F.tid] = cs; ct[128 + F.tid] = sn; }
        __syncthreads();
        const float* win = in_ptr(I_WIN); bf16* wt = (bf16*)(ws + WS_WIN);
        LAS float* wscr = (LAS float*)(F.lds + RING_OFF + F.wave * 16384);
        for (int it = gw; it < 1024 * 4; it += NGW) {
            const int k = it >> 2, g = it & 3;
            const f32x2 w2 = *(const f32x2*)(win + (size_t)k * 6656 + g * 128 + 2 * F.lane);
            wscr[2 * F.lane] = w2[0]; wscr[2 * F.lane + 1] = w2[1];
            LDS_WAIT(); asm volatile("" ::: "memory");
            float ac0 = 0.f, as0 = 0.f, ac1 = 0.f, as1 = 0.f;
#pragma unroll 8
            for (int c = 0; c < 128; ++c) { const float wv = wscr[c]; const int a0 = (F.lane * c) & 127, a1 = ((F.lane + 64) * c) & 127;
                ac0 += wv * ct[a0]; as0 += wv * ct[128 + a0]; ac1 += wv * ct[a1]; as1 += wv * ct[128 + a1]; }
            wt[(size_t)(g * 128 + F.lane) * 1024 + k] = f2bf(ac0); wt[(size_t)(512 + g * 128 + F.lane) * 1024 + k] = f2bf(as0);
            wt[(size_t)(g * 128 + 64 + F.lane) * 1024 + k] = f2bf(ac1); wt[(size_t)(512 + g * 128 + 64 + F.lane) * 1024 + k] = f2bf(as1);
            LDS_WAIT(); asm volatile("" ::: "memory");
        }
        bf16* a1 = (bf16*)(ws + WS_A1);
        for (int i = F.bid * NTHR + F.tid; i < 128 * 128; i += F.G * NTHR) {
            const int m = i >> 7, kk = i & 127, po = m >> 6, k1 = m & 63, pi = kk >> 6, s1 = kk & 63;
            float sn, cs; __sincosf(6.283185307179586f * (float)((s1 * k1) & 63) / 64.f, &sn, &cs);
            const float v = (po == pi) ? cs : (po == 0 ? -sn : sn);
            a1[i] = f2bf(v * 0.125f);
        }
        bf16* a3 = (bf16*)(ws + WS_A3);
        for (int i = F.bid * NTHR + F.tid; i < 64 * 128 * 256; i += F.G * NTHR) {
            const int k1 = i >> 15, k2 = (i >> 8) & 127, kk = i & 255, s2 = kk >> 1, part = kk & 1, k = k1 + 64 * k2;
            float sn, cs; __sincosf(6.283185307179586f * (float)((s2 * k) & 8191) / 8192.f, &sn, &cs);
            a3[i] = f2bf((part == 0 ? cs : -sn) * (1.f / 128.f));
        }
    }
    for (int m = gw; m < T; m += NGW) ln_row_bf16(in_ptr(I_X) + (size_t)m * D, in_ptr(I_LNIG), in_ptr(I_LNIB), (bf16*)(ws + WS_H0) + (size_t)m * D, F.lane);
    for (int m = gw; m < NB * MEM; m += NGW) ln_row_bf16(in_ptr(I_MEM) + (size_t)m * D, in_ptr(I_LNMG), in_ptr(I_LNMB), (bf16*)(ws + WS_MEMN) + (size_t)m * D, F.lane);
}
__device__ __forceinline__ void p_convert_experts(Frame& F) {
    unsigned char* ws = F.ws;
    conv_matrix(F, in_ptr(I_WEG), (size_t)1024 * 256, NE, 1024, 256, 0, 256, (bf16*)(ws + WS_EXPGU), 0, 512, 256);
    conv_matrix(F, in_ptr(I_WEU), (size_t)1024 * 256, NE, 1024, 256, 0, 256, (bf16*)(ws + WS_EXPGU), 128, 512, 256);
    conv_matrix(F, in_ptr(I_WED), (size_t)256 * 1024, NE, 256, 1024, 0, 1024, (bf16*)(ws + WS_EXPD), 0, 1024, 128);
}
__device__ __forceinline__ void p_ln1(Frame& F) {
    const int gw = F.bid * NWAVES + F.wave, NGW = F.G * NWAVES;
    for (int m = gw; m < T; m += NGW) ln_rowb_bf16((const bf16*)(F.ws + WS_S1) + (size_t)m * D, in_ptr(I_LN1G), in_ptr(I_LN1B), (bf16*)(F.ws + WS_H1) + (size_t)m * D, F.lane);
}
template <bool ROUTED>
__device__ __forceinline__ void p_final(Frame& F) {
    const int gw = F.bid * NWAVES + F.wave, NGW = F.G * NWAVES, lane = F.lane;
    const float* g = in_ptr(I_LN2G); const float* b = in_ptr(I_LN2B);
    for (int m = gw; m < T; m += NGW) {
        const v2u* xr = (const v2u*)((const bf16*)(F.ws + WS_S2) + (size_t)m * D) + lane;
        f32x4 v[4];
#pragma unroll
        for (int j = 0; j < 4; ++j) { const v2u w = xr[64 * j]; v[j][0] = bflo(w.x); v[j][1] = bfhi(w.x); v[j][2] = bflo(w.y); v[j][3] = bfhi(w.y); }
        if (ROUTED) {
            const unsigned* yb = (const unsigned*)(F.ws + WS_YR) + (size_t)m * 8 * 256;
            f32x4 ya[4];
#pragma unroll
            for (int j = 0; j < 4; ++j) ya[j] = (f32x4){0.f, 0.f, 0.f, 0.f};
#pragma unroll
            for (int k = 0; k < 8; ++k)
#pragma unroll
                for (int j = 0; j < 4; ++j) { const int w = (int)yb[(size_t)k * 256 + lane + 64 * j];
                    ya[j][0] += __builtin_amdgcn_cvt_f32_fp8(w, 0); ya[j][1] += __builtin_amdgcn_cvt_f32_fp8(w, 1); ya[j][2] += __builtin_amdgcn_cvt_f32_fp8(w, 2); ya[j][3] += __builtin_amdgcn_cvt_f32_fp8(w, 3); }
#pragma unroll
            for (int j = 0; j < 4; ++j) v[j] = v[j] + ya[j] * (1.0f / YSCALE);
        }
        float s = 0.f;
#pragma unroll
        for (int j = 0; j < 4; ++j) s += (v[j][0] + v[j][1]) + (v[j][2] + v[j][3]);
        const float mean = wave_sum(s) * (1.f / 1024.f); float s2 = 0.f;
#pragma unroll
        for (int j = 0; j < 4; ++j) { v[j] = v[j] - mean; s2 += (v[j][0] * v[j][0] + v[j][1] * v[j][1]) + (v[j][2] * v[j][2] + v[j][3] * v[j][3]); }
        const float rstd = 1.f / sqrtf(wave_sum(s2) * (1.f / 1024.f) + LN_EPS);
        f32x4* o = (f32x4*)(F.out + (size_t)m * D) + lane;
#pragma unroll
        for (int j = 0; j < 4; ++j) { const f32x4 gg = ((const f32x4*)g)[lane + 64 * j], bb = ((const f32x4*)b)[lane + 64 * j]; o[64 * j] = v[j] * rstd * gg + bb; }
    }
}
__device__ __forceinline__ void p_scale_copy(Frame& F, const bf16* src, float* dst) {
    for (size_t i = (size_t)F.bid * NTHR + F.tid; i < (size_t)T * D / 4; i += (size_t)F.G * NTHR) {
        const v2u w = ((const v2u*)src)[i]; f32x4 o; o[0] = ALPHA * bflo(w.x); o[1] = ALPHA * bfhi(w.x); o[2] = ALPHA * bflo(w.y); o[3] = ALPHA * bfhi(w.y); ((f32x4*)dst)[i] = o; }
}


__device__ __forceinline__ void p_proj(Frame& F) {
    pg8::Gemm g{(const bf16*)(F.ws + WS_H0), (const bf16*)(F.ws + WS_WIN), 1024};
    pg8::StaticOrder S; S.init(T, NPROJ, F.G, F.bid);
    EpiProj E{(bf16*)(F.ws + WS_F), (bf16*)(F.ws + WS_Q), (bf16*)(F.ws + WS_GATES), in_ptr(I_BGATE)};
    pg8::gemm_phase<EpiProj, pg8::StaticOrder, false>(F.lds + RING_OFF, g, S, E, nullptr);
}
__device__ __forceinline__ void p_kv(Frame& F) {
    pg8::Gemm g{(const bf16*)(F.ws + WS_MEMN), (const bf16*)(F.ws + WS_WKV), 1024};
    pg8::StaticOrder S; S.init(NB * MEM, 1024, F.G, F.bid);
    EpiPlain E{(bf16*)(F.ws + WS_KV), 1024};
    pg8::gemm_phase<EpiPlain, pg8::StaticOrder, false>(F.lds + RING_OFF, g, S, E, nullptr);
}
__device__ __forceinline__ void p_branch(Frame& F) {
    pg8::Gemm g{(const bf16*)(F.ws + WS_MIX), (const bf16*)(F.ws + WS_WBR), 512};
    ChainOrder S; S.S.init(T, 1024, F.G, F.bid);
    EpiMix E{(bf16*)(F.ws + WS_MERGED), (const bf16*)(F.ws + WS_GATES), in_ptr(I_BFO)};
    pg8::gemm_phase<EpiMix, ChainOrder, false>(F.lds + RING_OFF, g, S, E, nullptr);
}
__device__ __forceinline__ void p_wout(Frame& F) {
    pg8::Gemm g{(const bf16*)(F.ws + WS_MERGED), (const bf16*)(F.ws + WS_WOUT), 1024};
    pg8::StaticOrder S; S.init(T, 1024, F.G, F.bid);
    EpiResid E{(bf16*)(F.ws + WS_S1), (const bf16*)(F.ws + WS_H0)};
    pg8::gemm_phase<EpiResid, pg8::StaticOrder, false>(F.lds + RING_OFF, g, S, E, nullptr);
}
__device__ __forceinline__ void p_router_shared(Frame& F) {
    pg8::Gemm g{(const bf16*)(F.ws + WS_H1), (const bf16*)(F.ws + WS_WRS), 1024};
    pg8::StaticOrder S; S.init(T, 768, F.G, F.bid);
    EpiRouterShared E{(float*)(F.ws + WS_LOGIT), (bf16*)(F.ws + WS_HS)};
    pg8::gemm_phase<EpiRouterShared, pg8::StaticOrder, false>(F.lds + RING_OFF, g, S, E, nullptr);
}
__device__ __forceinline__ void p_shared_down(Frame& F) {
    pg8::Gemm g{(const bf16*)(F.ws + WS_HS), (const bf16*)(F.ws + WS_WSD), 256};
    pg8::StaticOrder S; S.init(T, 1024, F.G, F.bid);
    EpiResid E{(bf16*)(F.ws + WS_S2), (const bf16*)(F.ws + WS_H1)};
    pg8::gemm_phase<EpiResid, pg8::StaticOrder, false>(F.lds + RING_OFF, g, S, E, nullptr);
}

constexpr int XA_PITCH = 136;
__device__ __forceinline__ void p_xattn(Frame& F) {
    LAS bf16* Ks = (LAS bf16*)(F.lds); LAS bf16* Vs = Ks + 256 * XA_PITCH;
    const bf16* KV = (const bf16*)(F.ws + WS_KV); const bf16* XQ = (const bf16*)(F.ws + WS_Q + 5 * SEC_STRIDE); bf16* XO = (bf16*)(F.ws + WS_MIX) + (size_t)2 * T * 512;
    const int lane = F.lane, r = lane & 15, q = lane >> 4, qp = (lane & 15) >> 2, pp = lane & 3;
    int cur_bh = -1;
    for (int u = F.bid; u < 512; u += F.G) {
        const int bh = u & 15, tile = u >> 4, b = bh >> 2, h = bh & 3;
        if (bh != cur_bh) {
            __syncthreads();
            for (int c = F.tid; c < 256 * 16; c += NTHR) { const int key = c >> 4, ch = c & 15;
                const v4u kv = *(const v4u*)(KV + (size_t)(b * 256 + key) * 1024 + h * 128 + ch * 8);
                const v4u vv = *(const v4u*)(KV + (size_t)(b * 256 + key) * 1024 + 512 + h * 128 + ch * 8);
                *(LAS v4u*)(Ks + key * XA_PITCH + ch * 8) = kv; *(LAS v4u*)(Vs + key * XA_PITCH + ch * 8) = vv; }
            __syncthreads();
            cur_bh = bh;
        }
        const int t0 = b * SEQ + tile * 256 + F.wave * 32;
#pragma unroll 1
        for (int mq = 0; mq < 2; ++mq) {
            const bf16* qrow = XQ + (size_t)(t0 + 16 * mq + r) * 512 + h * 128 + 8 * q;
            bf16x8 qf[4];
#pragma unroll
            for (int ks = 0; ks < 4; ++ks) qf[ks] = *(const bf16x8*)(qrow + 32 * ks);
            f32x4 sc[16];
#pragma unroll
            for (int nk = 0; nk < 16; ++nk) { sc[nk] = (f32x4){0.f, 0.f, 0.f, 0.f};
#pragma unroll
                for (int ks = 0; ks < 4; ++ks) { const bf16x8 kf = *(const LAS bf16x8*)(Ks + (16 * nk + r) * XA_PITCH + 32 * ks + 8 * q);
                    sc[nk] = __builtin_amdgcn_mfma_f32_16x16x32_bf16(kf, qf[ks], sc[nk], 0, 0, 0); } }
            float mx = -3.0e38f;
#pragma unroll
            for (int nk = 0; nk < 16; ++nk) mx = fmaxf(mx, fmaxf(fmaxf(sc[nk][0], sc[nk][1]), fmaxf(sc[nk][2], sc[nk][3])));
            mx = fmaxf(mx, __shfl_xor(mx, 16)); mx = fmaxf(mx, __shfl_xor(mx, 32));
            float l = 0.f;
#pragma unroll
            for (int nk = 0; nk < 16; ++nk) {
#pragma unroll
                for (int j = 0; j < 4; ++j) { sc[nk][j] = __builtin_amdgcn_exp2f(sc[nk][j] - mx); l += sc[nk][j]; } }
            l += __shfl_xor(l, 16); l += __shfl_xor(l, 32);
            const float inv = 1.0f / l;
            bf16x8 pf[8];
#pragma unroll
            for (int s = 0; s < 8; ++s) { v4u w; w.x = cvt_pk_bf16(sc[2 * s][0], sc[2 * s][1]); w.y = cvt_pk_bf16(sc[2 * s][2], sc[2 * s][3]);
                w.z = cvt_pk_bf16(sc[2 * s + 1][0], sc[2 * s + 1][1]); w.w = cvt_pk_bf16(sc[2 * s + 1][2], sc[2 * s + 1][3]); pf[s] = __builtin_bit_cast(bf16x8, w); }
            bf16* orow = XO + (size_t)(t0 + 16 * mq + r) * 512 + h * 128 + 4 * q;
#pragma unroll
            for (int nd = 0; nd < 8; ++nd) { f32x4 o = (f32x4){0.f, 0.f, 0.f, 0.f};
#pragma unroll
                for (int s = 0; s < 8; ++s) {
                    const s16x4 v0 = __builtin_amdgcn_ds_read_tr16_b64_v4i16((LAS s16x4*)(Vs + (32 * s + 4 * q + qp) * XA_PITCH + 16 * nd + 4 * pp));
                    const s16x4 v1 = __builtin_amdgcn_ds_read_tr16_b64_v4i16((LAS s16x4*)(Vs + (32 * s + 16 + 4 * q + qp) * XA_PITCH + 16 * nd + 4 * pp));
                    const bf16x8 vf = {v0[0], v0[1], v0[2], v0[3], v1[0], v1[1], v1[2], v1[3]};
                    o = __builtin_amdgcn_mfma_f32_16x16x32_bf16(vf, pf[s], o, 0, 0, 0); }
                o = o * inv;
                v2u w; w.x = cvt_pk_bf16(o[0], o[1]); w.y = cvt_pk_bf16(o[2], o[3]); *(v2u*)(orow + 16 * nd) = w; }
        }
    }
    __syncthreads();
}

__device__ __forceinline__ unsigned fkey(float x) { const unsigned b = __float_as_uint(x); return (b & 0x80000000u) ? ~b : (b | 0x80000000u); }
__device__ __forceinline__ int popc64(unsigned long long m) { return __builtin_popcountll(m); }
__device__ __forceinline__ void p_routing(Frame& F) {
    const int gw = F.bid * NWAVES + F.wave, NGW = F.G * NWAVES, lane = F.lane;
    const float* L = (const float*)(F.ws + WS_LOGIT);
    int* eidx = (int*)(F.ws + WS_ROUTE + RT_EIDX); float* wgt = (float*)(F.ws + WS_ROUTE + RT_WGT); int* pos = (int*)(F.ws + WS_ROUTE + RT_POS);
    unsigned* cnt = F.ctl + CW_CNT;
    const f32x4 rb = ((const f32x4*)in_ptr(I_RB))[lane];
    const float NEG = -__builtin_inff();
    const unsigned long long below = (lane == 0) ? 0ull : (~0ull >> (64 - lane));
    LAS int* le = (LAS int*)(F.lds + F.wave * 1024); LAS float* lw = (LAS float*)(F.lds + F.wave * 1024 + 256);
    f32x4 lgn = ((const f32x4*)(L + (size_t)gw * 256))[lane];
    for (int base = gw; base < T; base += 8 * NGW) {
#pragma unroll 1
      for (int jt = 0; jt < 8; ++jt) {
        const int t = base + jt * NGW; if (t >= T) break;
        const f32x4 lg = lgn;
        if (t + NGW < T) lgn = ((const f32x4*)(L + (size_t)(t + NGW) * 256))[lane];
        const float a0 = sigmoidf_(lg[0]), a1 = sigmoidf_(lg[1]), a2 = sigmoidf_(lg[2]), a3 = sigmoidf_(lg[3]);
        float s0 = a0 + rb[0], s1 = a1 + rb[1], s2 = a2 + rb[2], s3 = a3 + rb[3];
        float m1 = fmaxf(s0, s1), m2 = fminf(s0, s1);
        { const float n1 = fmaxf(m1, s2), n2 = fmaxf(fminf(m1, s2), m2); m1 = n1; m2 = n2; }
        { const float n1 = fmaxf(m1, s3), n2 = fmaxf(fminf(m1, s3), m2); m1 = n1; m2 = n2; }
#pragma unroll
        for (int o = 1; o < 8; o <<= 1) { const float p1 = __shfl_xor(m1, o), p2 = __shfl_xor(m2, o); const float n1 = fmaxf(m1, p1), n2 = fmaxf(fminf(m1, p1), fmaxf(m2, p2)); m1 = n1; m2 = n2; }
        const float gs = m1 + m2; const int grp = lane >> 3; int rank = 0;
#pragma unroll
        for (int g2 = 0; g2 < 8; ++g2) { const float o = __uint_as_float((unsigned)__builtin_amdgcn_readlane((int)__float_as_uint(gs), g2 * 8)); rank += (o > gs || (o == gs && g2 < grp)) ? 1 : 0; }
        if (rank >= 4) { s0 = NEG; s1 = NEG; s2 = NEG; s3 = NEG; }
        const unsigned k0 = fkey(s0), k1 = fkey(s1), k2 = fkey(s2), k3 = fkey(s3);
        unsigned Tk = 0u;
#pragma unroll 1
        for (int bit = 31; bit >= 0; --bit) { const unsigned cand = Tk | (1u << bit);
            const int c = popc64(__ballot(k0 >= cand)) + popc64(__ballot(k1 >= cand)) + popc64(__ballot(k2 >= cand)) + popc64(__ballot(k3 >= cand));
            if (c >= 8) Tk = cand; }
        const unsigned long long g0 = __ballot(k0 > Tk), g1 = __ballot(k1 > Tk), g2b = __ballot(k2 > Tk), g3 = __ballot(k3 > Tk);
        const unsigned long long e0 = __ballot(k0 == Tk), e1 = __ballot(k1 == Tk), e2 = __ballot(k2 == Tk), e3 = __ballot(k3 == Tk);
        const int need = 8 - (popc64(g0) + popc64(g1) + popc64(g2b) + popc64(g3));
        const int r0 = popc64(e0 & below), r1 = popc64(e0) + popc64(e1 & below), r2 = popc64(e0) + popc64(e1) + popc64(e2 & below), r3 = popc64(e0) + popc64(e1) + popc64(e2) + popc64(e3 & below);
        const bool c0 = (k0 > Tk) || (k0 == Tk && r0 < need), c1 = (k1 > Tk) || (k1 == Tk && r1 < need), c2 = (k2 > Tk) || (k2 == Tk && r2 < need), c3 = (k3 > Tk) || (k3 == Tk && r3 < need);
        const unsigned long long b0 = __ballot(c0), b1 = __ballot(c1), b2 = __ballot(c2), b3 = __ballot(c3);
        float asum = (c0 ? a0 : 0.f) + (c1 ? a1 : 0.f) + (c2 ? a2 : 0.f) + (c3 ? a3 : 0.f);
        asum = wave_sum(asum);
        const float sc = 2.5f / asum;
        const int p0 = popc64(b0 & below), p1 = popc64(b0) + popc64(b1 & below), p2 = popc64(b0) + popc64(b1) + popc64(b2 & below), p3 = popc64(b0) + popc64(b1) + popc64(b2) + popc64(b3 & below);
        if (c0) { le[jt * 8 + p0] = 4 * lane; lw[jt * 8 + p0] = a0 * sc; }
        if (c1) { le[jt * 8 + p1] = 4 * lane + 1; lw[jt * 8 + p1] = a1 * sc; }
        if (c2) { le[jt * 8 + p2] = 4 * lane + 2; lw[jt * 8 + p2] = a2 * sc; }
        if (c3) { le[jt * 8 + p3] = 4 * lane + 3; lw[jt * 8 + p3] = a3 * sc; }
      }
      { const int t = base + (lane >> 3) * NGW;
        if (t < T) { const int e = le[lane]; const float wv = lw[lane];
            const unsigned p = __hip_atomic_fetch_add(cnt + e, 1u, __ATOMIC_RELAXED, __HIP_MEMORY_SCOPE_AGENT);
            const size_t o = (size_t)t * 8 + (lane & 7); eidx[o] = e; wgt[o] = wv; pos[o] = (int)p; } }
    }
}
__device__ __forceinline__ int build_expert_tables(Frame& F, LAS unsigned short* te, LAS int* roff) {
    LAS int* tmp = (LAS int*)(F.lds + LDSX_OFF + 6656);
    const unsigned* cnt = F.ctl + CW_CNT;
    __syncthreads();
    if (F.tid < 256) tmp[F.tid] = (int)((__hip_atomic_load(cnt + F.tid, __ATOMIC_RELAXED, __HIP_MEMORY_SCOPE_AGENT) + 255u) >> 8);
    __syncthreads();
    if (F.tid < 256) { int s = 0; for (int j = 0; j < F.tid; ++j) s += tmp[j]; const int nt = tmp[F.tid];
        for (int i = 0; i < nt; ++i) te[s + i] = (unsigned short)F.tid;
        if (roff) roff[F.tid] = s * 256;
        if (F.tid == 255) tmp[256] = s + nt; }
    __syncthreads();
    return tmp[256];
}
__device__ __forceinline__ void p_fill(Frame& F) {
    LAS unsigned short* te = (LAS unsigned short*)(F.lds + LDSX_OFF); LAS int* roff = (LAS int*)(F.lds + LDSX_OFF + 8192);
    (void)build_expert_tables(F, te, roff);
    const int* eidx = (const int*)(F.ws + WS_ROUTE + RT_EIDX); const float* wgt = (const float*)(F.ws + WS_ROUTE + RT_WGT); const int* pos = (const int*)(F.ws + WS_ROUTE + RT_POS);
    int* rowtok = (int*)(F.ws + WS_ROUTE + RT_ROWTOK); v2u* rowinfo = (v2u*)(F.ws + WS_ROUTE + RT_ROWSLOT);
    for (int i = F.bid * NTHR + F.tid; i < T * TOPK; i += F.G * NTHR) { const int e = eidx[i]; const int r = roff[e] + pos[i]; rowtok[r] = i >> 3; rowinfo[r] = (v2u){(unsigned)i, __float_as_uint(wgt[i])}; }
    const unsigned* cnt = F.ctl + CW_CNT;
    for (int e = F.bid; e < NE; e += F.G) { const int c = (int)__hip_atomic_load(cnt + e, __ATOMIC_RELAXED, __HIP_MEMORY_SCOPE_AGENT), r0 = roff[e] + c, r1 = roff[e] + ((c + 255) & ~255);
        for (int r = r0 + F.tid; r < r1; r += NTHR) { rowtok[r] = 0; rowinfo[r] = (v2u){0xffffffffu, 0u}; } }
    __syncthreads();
}
__device__ __forceinline__ void p_exp_gu(Frame& F) {
    LAS unsigned short* te = (LAS unsigned short*)(F.lds + LDSX_OFF);
    const int ntiles = build_expert_tables(F, te, nullptr);
    pg8::Gemm g{(const bf16*)(F.ws + WS_H1), (const bf16*)(F.ws + WS_EXPGU), 1024};
    pg8::ExpertOrder<2> S{ntiles * 2, F.G, F.bid, te};
    EpiExpGU E{(bf16*)(F.ws + WS_HACT)};
    pg8::gemm_phase<EpiExpGU, pg8::ExpertOrder<2>, true>(F.lds + RING_OFF, g, S, E, (const int*)(F.ws + WS_ROUTE + RT_ROWTOK));
}
__device__ __forceinline__ void p_exp_down(Frame& F) {
    LAS unsigned short* te = (LAS unsigned short*)(F.lds + LDSX_OFF);
    const int ntiles = build_expert_tables(F, te, nullptr);
    pg8::Gemm g{(const bf16*)(F.ws + WS_HACT), (const bf16*)(F.ws + WS_EXPD), 256};
    pg8::ExpertOrder<4> S{ntiles * 4, F.G, F.bid, te};
    EpiExpDown E{(unsigned char*)(F.ws + WS_YR), (const v2u*)(F.ws + WS_ROUTE + RT_ROWSLOT), (unsigned char*)(F.ws + WS_ROUTE + RT_TRASH)};
    pg8::gemm_phase<EpiExpDown, pg8::ExpertOrder<4>, false>(F.lds + RING_OFF, g, S, E, nullptr);
}

template <int STEP>
__device__ __forceinline__ void p_dft(Frame& F) {
    constexpr int K = STEP == 1 ? 128 : 256, NBC = STEP == 1 ? 256 : 128, WM = STEP == 1 ? 1 : 2, WN = 8 / WM;
    constexpr int MT = 128 / WM / 16, NT = NBC / WN / 16, PITCH = NBC + 8, CPR = NBC / 8;
    LAS bf16* Bs = (LAS bf16*)F.lds;
    const bf16* Fb = (const bf16*)(F.ws + WS_F); bf16* Yb = (bf16*)(F.ws + WS_Y); bf16* FM = (bf16*)(F.ws + WS_MIX);
    const int lane = F.lane, r = lane & 15, q = lane >> 4, qp = (lane & 15) >> 2, pp = lane & 3;
    const int wm = F.wave / WN, wn = F.wave % WN;
    for (int u = F.bid; u < 1024; u += F.G) {
        const int b = u >> 8, mid = STEP == 1 ? (u >> 1) & 127 : (u >> 2) & 63, n0 = STEP == 1 ? (u & 1) * 256 : (u & 3) * 128;
        __syncthreads();
        for (int c = F.tid; c < K * CPR; c += NTHR) { const int kk = c / CPR, ch = c % CPR;
            const bf16* src = STEP == 1 ? Fb + (size_t)(b * SEQ + 128 * (kk & 63) + mid) * 1024 + (kk >> 6) * 512 + n0 + ch * 8
                                        : Yb + ((size_t)(b * 64 + mid) * 256 + kk) * 512 + n0 + ch * 8;
            *(LAS v4u*)(Bs + kk * PITCH + ch * 8) = *(const v4u*)src; }
        __syncthreads();
        const bf16* A = STEP == 1 ? (const bf16*)(F.ws + WS_A1) : (const bf16*)(F.ws + WS_A3) + (size_t)mid * 128 * 256;
        f32x4 acc[MT][NT];
#pragma unroll
        for (int mi = 0; mi < MT; ++mi)
#pragma unroll
            for (int ni = 0; ni < NT; ++ni) acc[mi][ni] = (f32x4){0.f, 0.f, 0.f, 0.f};
#pragma unroll 2
        for (int ks = 0; ks < K / 32; ++ks) {
            bf16x8 af[MT];
#pragma unroll
            for (int mi = 0; mi < MT; ++mi) af[mi] = *(const bf16x8*)(A + (size_t)(wm * (128 / WM) + 16 * mi + r) * K + 32 * ks + 8 * q);
#pragma unroll
            for (int ni = 0; ni < NT; ++ni) { const int n = wn * (NBC / WN) + 16 * ni;
                const s16x4 v0 = __builtin_amdgcn_ds_read_tr16_b64_v4i16((LAS s16x4*)(Bs + (32 * ks + 8 * q + qp) * PITCH + n + 4 * pp));
                const s16x4 v1 = __builtin_amdgcn_ds_read_tr16_b64_v4i16((LAS s16x4*)(Bs + (32 * ks + 8 * q + 4 + qp) * PITCH + n + 4 * pp));
                const bf16x8 xf = {v0[0], v0[1], v0[2], v0[3], v1[0], v1[1], v1[2], v1[3]};
#pragma unroll
                for (int mi = 0; mi < MT; ++mi) acc[mi][ni] = __builtin_amdgcn_mfma_f32_16x16x32_bf16(xf, af[mi], acc[mi][ni], 0, 0, 0); }
        }
#pragma unroll
        for (int mi = 0; mi < MT; ++mi) { const int m = wm * (128 / WM) + 16 * mi + r;
            bf16* drow = STEP == 1 ? Yb + ((((size_t)(b * 64 + (m & 63)) * 128 + mid) * 2 + (m >> 6)) * 512)
                                   : FM + (size_t)(b * SEQ + mid + 64 * m) * 512;
#pragma unroll
            for (int ni = 0; ni < NT; ++ni) { const int n = n0 + wn * (NBC / WN) + 16 * ni + 4 * q; const f32x4 o = acc[mi][ni];
                v2u w; w.x = cvt_pk_bf16_c(o[0], o[1]); w.y = cvt_pk_bf16_c(o[2], o[3]); *(v2u*)(drow + n) = w; } }
    }
    __syncthreads();
}

__device__ __forceinline__ v2u pack4c(const f32x4 o) { v2u w; w.x = cvt_pk_bf16_c(o[0], o[1]); w.y = cvt_pk_bf16_c(o[2], o[3]); return w; }
__device__ __forceinline__ bf16x8 tr8(const LAS bf16* p0, const LAS bf16* p1) {
    const s16x4 a = __builtin_amdgcn_ds_read_tr16_b64_v4i16((LAS s16x4*)p0), b = __builtin_amdgcn_ds_read_tr16_b64_v4i16((LAS s16x4*)p1);
    return (bf16x8){a[0], a[1], a[2], a[3], b[0], b[1], b[2], b[3]};
}
constexpr int HP = 136;
__device__ __forceinline__ void p_hgrn1(Frame& F) {
    LAS bf16* Qd = (LAS bf16*)F.lds; LAS bf16* Ki = Qd + 64 * HP; LAS bf16* Ke = Ki + 64 * HP; LAS bf16* Vs = Ke + 64 * HP; LAS bf16* Sb = Vs + 64 * HP;
    LAS float* tot = (LAS float*)(Sb + 128 * HP); LAS float* dec = tot + 16 * 128;
    const int tid = F.tid, lane = F.lane, r = lane & 15, q = lane >> 4, qp = (lane & 15) >> 2, pp = lane & 3, w = F.wave, tb = w & 3, dh = w >> 2;
    const int d4 = tid & 31, tg = tid >> 5;
    for (int u = F.bid; u < 512; u += F.G) {
        const int sg = u & 15, dir = (u >> 4) & 1, h = (u >> 5) & 3, b = u >> 7;
        const bf16* Qg = (const bf16*)(F.ws + WS_Q) + h * 128; const bf16* Vg = (const bf16*)(F.ws + WS_Q + SEC_STRIDE) + h * 128;
        const bf16* Zg = (const bf16*)(F.ws + WS_Q + (dir ? 3 : 2) * SEC_STRIDE) + h * 128;
        bf16* OL = (bf16*)(F.ws + (dir ? WS_OLB : WS_OLF)) + h * 128; bf16* QS = (bf16*)(F.ws + (dir ? WS_QSB : WS_QSF)) + h * 128;
        const float* lbp = in_ptr(dir ? I_LBB : I_LBF);
        f32x4 lb, G2 = (f32x4){0.f, 0.f, 0.f, 0.f};
        { const f32x4 p0 = *(const f32x4*)(lbp + h * 128 + 4 * d4), p1 = *(const f32x4*)(lbp + 512 + h * 128 + 4 * d4);
#pragma unroll
          for (int c = 0; c < 4; ++c) lb[c] = sigmoidf_(p0[c] - p1[c]); }
        f32x4 sS[8];
#pragma unroll
        for (int nd = 0; nd < 8; ++nd) sS[nd] = (f32x4){0.f, 0.f, 0.f, 0.f};
        __syncthreads();
        for (int i = tid; i < 128 * HP / 8; i += NTHR) ((LAS v4u*)Sb)[i] = (v4u){0u, 0u, 0u, 0u};
#pragma unroll 1
        for (int c = 0; c < 8; ++c) {
            __syncthreads();
            const int tbase = sg * SEG + 64 * c;
            f32x4 qv[4], kv[4], cs[4], run = (f32x4){0.f, 0.f, 0.f, 0.f};
            v2u zr[4], qr[4];
#pragma unroll
            for (int i = 0; i < 4; ++i) { const int pos = tbase + 4 * tg + i; const size_t tok = (size_t)(b * SEQ + (dir ? SEQ - 1 - pos : pos));
                zr[i] = *(const v2u*)(Zg + tok * 512 + 4 * d4); qr[i] = *(const v2u*)(Qg + tok * 512 + 4 * d4); }
#pragma unroll
            for (int i = 0; i < 4; ++i) { const f32x4 z = (f32x4){bflo(zr[i].x), bfhi(zr[i].x), bflo(zr[i].y), bfhi(zr[i].y)};
                qv[i] = (f32x4){bflo(qr[i].x), bfhi(qr[i].x), bflo(qr[i].y), bfhi(qr[i].y)};
#pragma unroll
                for (int e = 0; e < 4; ++e) { const float f = lb[e] + (1.0f - lb[e]) * sigmoidf_(z[e]); kv[i][e] = 1.0f - f; run[e] += __builtin_amdgcn_logf(f); }
                cs[i] = run; }
            *(LAS f32x4*)(tot + tg * 128 + 4 * d4) = run;
            for (int cc = tid; cc < 1024; cc += NTHR) { const int tp = cc >> 4, ch = cc & 15, pos = tbase + tp; const size_t tok = (size_t)(b * SEQ + (dir ? SEQ - 1 - pos : pos));
                *(LAS v4u*)(Vs + tp * HP + ch * 8) = *(const v4u*)(Vg + tok * 512 + ch * 8); }
            __syncthreads();
            f32x4 pre = (f32x4){0.f, 0.f, 0.f, 0.f}, aend = pre;
#pragma unroll
            for (int j = 0; j < 16; ++j) { const f32x4 x = *(const LAS f32x4*)(tot + j * 128 + 4 * d4); aend = aend + x; if (j < tg) pre = pre + x; }
            f32x4 eend, eG;
#pragma unroll
            for (int e = 0; e < 4; ++e) { eend[e] = __builtin_amdgcn_exp2f(aend[e]); eG[e] = __builtin_amdgcn_exp2f(G2[e]); }
#pragma unroll
            for (int i = 0; i < 4; ++i) { const int tp = 4 * tg + i, pos = tbase + tp; const size_t tok = (size_t)(b * SEQ + (dir ? SEQ - 1 - pos : pos));
                f32x4 qd, ki, ke, qs;
#pragma unroll
                for (int e = 0; e < 4; ++e) { const float ea = __builtin_amdgcn_exp2f(pre[e] + cs[i][e]), ei = __builtin_amdgcn_rcpf(ea);
                    qd[e] = qv[i][e] * ea; ki[e] = kv[i][e] * ei; ke[e] = ki[e] * eend[e]; qs[e] = qd[e] * eG[e]; }
                v2u wq, wk, we, ws2; wq.x = cvt_pk_bf16(qd[0], qd[1]); wq.y = cvt_pk_bf16(qd[2], qd[3]); wk.x = cvt_pk_bf16(ki[0], ki[1]); wk.y = cvt_pk_bf16(ki[2], ki[3]);
                we.x = cvt_pk_bf16(ke[0], ke[1]); we.y = cvt_pk_bf16(ke[2], ke[3]); ws2.x = cvt_pk_bf16(qs[0], qs[1]); ws2.y = cvt_pk_bf16(qs[2], qs[3]);
                *(LAS v2u*)(Qd + tp * HP + 4 * d4) = wq; *(LAS v2u*)(Ki + tp * HP + 4 * d4) = wk; *(LAS v2u*)(Ke + tp * HP + 4 * d4) = we;
                *(v2u*)(QS + tok * 512 + 4 * d4) = ws2; }
            if (tg == 0) *(LAS f32x4*)(dec + 4 * d4) = eend;
            G2 = G2 + aend;
            __syncthreads();
            bf16x8 qf[4];
#pragma unroll
            for (int ks = 0; ks < 4; ++ks) qf[ks] = *(const LAS bf16x8*)(Qd + (16 * tb + r) * HP + 32 * ks + 8 * q);
            f32x4 sc[4];
#pragma unroll
            for (int sb = 0; sb < 4; ++sb) { sc[sb] = (f32x4){0.f, 0.f, 0.f, 0.f};
#pragma unroll
                for (int ks = 0; ks < 4; ++ks) { const bf16x8 kf = *(const LAS bf16x8*)(Ki + (16 * sb + r) * HP + 32 * ks + 8 * q); sc[sb] = __builtin_amdgcn_mfma_f32_16x16x32_bf16(kf, qf[ks], sc[sb], 0, 0, 0); }
#pragma unroll
                for (int j = 0; j < 4; ++j) sc[sb][j] = (16 * sb + 4 * q + j > 16 * tb + r) ? 0.f : sc[sb][j]; }
            bf16x8 pf[2];
#pragma unroll
            for (int k2 = 0; k2 < 2; ++k2) { v4u wv; wv.x = cvt_pk_bf16(sc[2 * k2][0], sc[2 * k2][1]); wv.y = cvt_pk_bf16(sc[2 * k2][2], sc[2 * k2][3]);
                wv.z = cvt_pk_bf16(sc[2 * k2 + 1][0], sc[2 * k2 + 1][1]); wv.w = cvt_pk_bf16(sc[2 * k2 + 1][2], sc[2 * k2 + 1][3]); pf[k2] = __builtin_bit_cast(bf16x8, wv); }
            { const int pos = tbase + 16 * tb + r; const size_t tok = (size_t)(b * SEQ + (dir ? SEQ - 1 - pos : pos));
#pragma unroll
            for (int nd = 0; nd < 4; ++nd) { f32x4 o = (f32x4){0.f, 0.f, 0.f, 0.f}; const int cb = 64 * dh + 16 * nd + 4 * pp;
#pragma unroll
                for (int k2 = 0; k2 < 2; ++k2) o = __builtin_amdgcn_mfma_f32_16x16x32_bf16(tr8(Vs + (32 * k2 + 4 * q + qp) * HP + cb, Vs + (32 * k2 + 16 + 4 * q + qp) * HP + cb), pf[k2], o, 0, 0, 0);
#pragma unroll
                for (int ks = 0; ks < 4; ++ks) o = __builtin_amdgcn_mfma_f32_16x16x32_bf16(tr8(Sb + (32 * ks + 8 * q + qp) * HP + cb, Sb + (32 * ks + 8 * q + 4 + qp) * HP + cb), qf[ks], o, 0, 0, 0);
                *(v2u*)(OL + tok * 512 + 64 * dh + 16 * nd + 4 * q) = pack4c(o); } }
            { const float dc = dec[16 * w + r];
#pragma unroll
            for (int nd = 0; nd < 8; ++nd) { sS[nd] = sS[nd] * dc;
#pragma unroll
                for (int k2 = 0; k2 < 2; ++k2) sS[nd] = __builtin_amdgcn_mfma_f32_16x16x32_bf16(tr8(Vs + (32 * k2 + 8 * q + qp) * HP + 16 * nd + 4 * pp, Vs + (32 * k2 + 8 * q + 4 + qp) * HP + 16 * nd + 4 * pp),
                                                                                              tr8(Ke + (32 * k2 + 8 * q + qp) * HP + 16 * w + 4 * pp, Ke + (32 * k2 + 8 * q + 4 + qp) * HP + 16 * w + 4 * pp), sS[nd], 0, 0, 0); } }
            __syncthreads();
#pragma unroll
            for (int nd = 0; nd < 8; ++nd) *(LAS v2u*)(Sb + (16 * w + r) * HP + 16 * nd + 4 * q) = pack4c(sS[nd]);
        }
        float* U = (float*)(F.ws + WS_U) + (size_t)u * 16384;
#pragma unroll
        for (int nd = 0; nd < 8; ++nd) *(f32x4*)(U + (16 * w + r) * 128 + 16 * nd + 4 * q) = sS[nd];
        if (tg == 0) { f32x4 dg; dg[0] = __builtin_amdgcn_exp2f(G2[0]); dg[1] = __builtin_amdgcn_exp2f(G2[1]); dg[2] = __builtin_amdgcn_exp2f(G2[2]); dg[3] = __builtin_amdgcn_exp2f(G2[3]); *(f32x4*)((float*)(F.ws + WS_DEC) + u * 128 + 4 * d4) = dg; }
    }
    __syncthreads();
}
__device__ __forceinline__ void p_hgrn_scan(Frame& F) {
    const float* U = (const float*)(F.ws + WS_U); const float* DEC = (const float*)(F.ws + WS_DEC); bf16* SST = (bf16*)(F.ws + WS_SST);
    for (int it = F.bid * NTHR + F.tid; it < 32 * 128 * 32; it += F.G * NTHR) {
        const int cmb = it >> 12, dk = (it >> 5) & 127, dv4 = it & 31;
        f32x4 st = (f32x4){0.f, 0.f, 0.f, 0.f};
#pragma unroll 4
        for (int sg = 0; sg < NSEG; ++sg) { const size_t un = (size_t)(cmb * 16 + sg);
            v2u wv; wv.x = cvt_pk_bf16(st[0], st[1]); wv.y = cvt_pk_bf16(st[2], st[3]); *(v2u*)(SST + un * 16384 + dk * 128 + dv4 * 4) = wv;
            const float dcy = DEC[un * 128 + dk]; const f32x4 uu = *(const f32x4*)(U + un * 16384 + dk * 128 + dv4 * 4); st = st * dcy + uu; }
    }
}
__device__ __forceinline__ void p_hgrn2(Frame& F) {
    LAS bf16* Sf = (LAS bf16*)F.lds; LAS bf16* Sw = Sf + 128 * HP;
    const int lane = F.lane, r = lane & 15, q = lane >> 4, qp = (lane & 15) >> 2, pp = lane & 3;
    const bf16* SST = (const bf16*)(F.ws + WS_SST);
    for (int u = F.bid; u < 512; u += F.G) {
        const int tile = u & 31, h = (u >> 5) & 3, b = u >> 7;
        const int unf = ((b * 4 + h) * 2 + 0) * 16 + (tile >> 1), unb = ((b * 4 + h) * 2 + 1) * 16 + ((31 - tile) >> 1);
        __syncthreads();
        for (int c = F.tid; c < 128 * 16; c += NTHR) { const int dk = c >> 4, ch = c & 15;
            *(LAS v4u*)(Sf + dk * HP + ch * 8) = *(const v4u*)(SST + (size_t)unf * 16384 + dk * 128 + ch * 8);
            *(LAS v4u*)(Sw + dk * HP + ch * 8) = *(const v4u*)(SST + (size_t)unb * 16384 + dk * 128 + ch * 8); }
        __syncthreads();
        const float* ng = in_ptr(I_HNG) + h * 128;
#pragma unroll 1
        for (int mq = 0; mq < 2; ++mq) {
            const size_t tok = (size_t)(b * SEQ + tile * 256 + F.wave * 32 + 16 * mq + r);
            const bf16* qsf = (const bf16*)(F.ws + WS_QSF) + tok * 512 + h * 128 + 8 * q; const bf16* qsb = (const bf16*)(F.ws + WS_QSB) + tok * 512 + h * 128 + 8 * q;
            bf16x8 ff[4], fb[4];
#pragma unroll
            for (int ks = 0; ks < 4; ++ks) { ff[ks] = *(const bf16x8*)(qsf + 32 * ks); fb[ks] = *(const bf16x8*)(qsb + 32 * ks); }
            f32x4 o[8]; float ss = 0.f;
            const size_t rb = tok * 512 + h * 128 + 4 * q;
#pragma unroll
            for (int nd = 0; nd < 8; ++nd) { f32x4 a = (f32x4){0.f, 0.f, 0.f, 0.f}; const int cb = 16 * nd + 4 * pp;
#pragma unroll
                for (int ks = 0; ks < 4; ++ks) { a = __builtin_amdgcn_mfma_f32_16x16x32_bf16(tr8(Sf + (32 * ks + 8 * q + qp) * HP + cb, Sf + (32 * ks + 8 * q + 4 + qp) * HP + cb), ff[ks], a, 0, 0, 0);
                    a = __builtin_amdgcn_mfma_f32_16x16x32_bf16(tr8(Sw + (32 * ks + 8 * q + qp) * HP + cb, Sw + (32 * ks + 8 * q + 4 + qp) * HP + cb), fb[ks], a, 0, 0, 0); }
                const v2u lf = *(const v2u*)((const bf16*)(F.ws + WS_OLF) + rb + 16 * nd), lw = *(const v2u*)((const bf16*)(F.ws + WS_OLB) + rb + 16 * nd);
                a[0] += bflo(lf.x) + bflo(lw.x); a[1] += bfhi(lf.x) + bfhi(lw.x); a[2] += bflo(lf.y) + bflo(lw.y); a[3] += bfhi(lf.y) + bfhi(lw.y);
                ss += (a[0] * a[0] + a[1] * a[1]) + (a[2] * a[2] + a[3] * a[3]); o[nd] = a; }
            ss += __shfl_xor(ss, 16); ss += __shfl_xor(ss, 32);
            const float rs = 1.0f / sqrtf(ss * (1.0f / 128.0f) + LN_EPS);
#pragma unroll
            for (int nd = 0; nd < 8; ++nd) { const f32x4 gn = *(const f32x4*)(ng + 16 * nd + 4 * q); const v2u gw = *(const v2u*)((const bf16*)(F.ws + WS_Q + 4 * SEC_STRIDE) + rb + 16 * nd);
                f32x4 y; y[0] = o[nd][0] * rs * gn[0] * bflo(gw.x); y[1] = o[nd][1] * rs * gn[1] * bfhi(gw.x); y[2] = o[nd][2] * rs * gn[2] * bflo(gw.y); y[3] = o[nd][3] * rs * gn[3] * bfhi(gw.y);
                v2u wv; wv.x = cvt_pk_bf16(y[0], y[1]); wv.y = cvt_pk_bf16(y[2], y[3]); *(v2u*)((bf16*)(F.ws + WS_MIX) + (size_t)T * 512 + rb + 16 * nd) = wv; }
        }
    }
    __syncthreads();
}
struct Args { const float* in[29]; float* out; unsigned char* ws; };
__global__ void __launch_bounds__(NTHR, 2) fwd(Args args) {
    extern __shared__ __attribute__((aligned(16))) unsigned char lds[];
    Frame F;
    F.lds = (LAS unsigned char*)lds;
    F.tid = threadIdx.x; F.lane = F.tid & 63; F.wave = __builtin_amdgcn_readfirstlane(F.tid >> 6);
    F.G = gridDim.x; F.bid = blockIdx.x;
    F.ws = args.ws; F.ctl = (unsigned*)(args.ws + WS_CTL); F.out = args.out;
    if (F.tid < 64) ((LAS unsigned*)(F.lds + LDSCTL_OFF))[F.tid] = 0u;
    __syncthreads();
    XcdBarrier bar = xcd_barrier_post(F.ctl + CW_BAR, (volatile LAS unsigned*)(F.lds + LDSCTL_OFF + 32));
#define GRID_BAR() xcd_barrier(bar)

#ifndef DUP
#define DUP 0
#endif
#define PH(id, call) do { call; if (DUP == (id)) { __syncthreads(); call; } } while (0)
    PH(1, p0_prologue(F));
    GRID_BAR();
    PH(2, p_proj(F));
    PH(3, p_kv(F));
    GRID_BAR();
    PH(4, p_xattn(F));
    PH(5, p_dft<1>(F));
    PH(6, p_hgrn1(F));
    GRID_BAR();
    PH(7, p_dft<3>(F));
    PH(8, p_hgrn_scan(F));
    GRID_BAR();
    PH(9, p_hgrn2(F));
    GRID_BAR();
    PH(10, p_branch(F));
    GRID_BAR();
    PH(11, p_wout(F));
    GRID_BAR();
    PH(12, p_ln1(F));
    PH(13, p_convert_experts(F));
    GRID_BAR();
    PH(14, p_router_shared(F));
    GRID_BAR();
    p_routing(F);
    GRID_BAR();
    PH(16, p_fill(F));
    PH(17, p_shared_down(F));
    GRID_BAR();
    PH(18, p_exp_gu(F));
    GRID_BAR();
    PH(19, p_exp_down(F));
    PH(30, GRID_BAR());
    PH(20, p_final<true>(F));
}

extern "C" void kernel_launch(void* const* d_in, const int* in_sizes, int n_in, void* d_out, int out_size, void* d_ws, size_t ws_size, hipStream_t stream) {
    static int grid = 0;
    if (grid == 0) {
        int dev = 0, cus = 0, per_cu = 0;
        if (n_in != 29 || ws_size < WS_END) { fprintf(stderr, "kernel_launch: unexpected n_in %d / ws_size %zu\n", n_in, ws_size); }
        if (hipGetDevice(&dev) != hipSuccess || hipDeviceGetAttribute(&cus, hipDeviceAttributeMultiprocessorCount, dev) != hipSuccess) { grid = -1; return; }
        if (hipFuncSetAttribute((const void*)fwd, hipFuncAttributeMaxDynamicSharedMemorySize, LDS_BYTES) != hipSuccess) { grid = -1; return; }
        if (hipOccupancyMaxActiveBlocksPerMultiprocessor(&per_cu, (const void*)fwd, NTHR, LDS_BYTES) != hipSuccess || per_cu < 1) fprintf(stderr, "kernel_launch: occupancy query says %d\n", per_cu);
        (void)hipGetLastError();
        grid = cus;
    }
    if (grid < 0) return;
    (void)hipMemsetAsync((char*)d_ws + WS_CTL, 0, CTL_ZERO_BYTES, stream);
    Args a{};
    for (int i = 0; i < 29; ++i) a.in[i] = (const float*)d_in[i];
    a.out = (float*)d_out; a.ws = (unsigned char*)d_ws;
    hipLaunchKernelGGL(fwd, dim3(grid), dim3(NTHR), LDS_BYTES, stream, a);
}
```

```cpp
#define DUP 0
#include <hip/hip_runtime.h>
#include <cstdio>
#include <cstdint>

#define GAS __attribute__((address_space(1)))
#define LAS __attribute__((address_space(3)))
typedef unsigned short bf16;
typedef unsigned v4u __attribute__((ext_vector_type(4)));
typedef unsigned v2u __attribute__((ext_vector_type(2)));
typedef float f32x4 __attribute__((ext_vector_type(4)));
typedef float f32x2 __attribute__((ext_vector_type(2)));
typedef short bf16x8 __attribute__((ext_vector_type(8)));
typedef short s16x4 __attribute__((ext_vector_type(4)));

constexpr int NB = 4, SEQ = 8192, D = 1024, T = NB * SEQ, MEM = 256;
constexpr int NPROJ = 7168;
constexpr int NE = 256, TOPK = 8, FF = 256;
constexpr float LN_EPS = 1e-5f;
constexpr float YSCALE = 128.f;
constexpr float ALPHA = 1.189207115002721f;
constexpr int NWAVES = 8, NTHR = 512;
constexpr int SEG = 512, NSEG = SEQ / SEG, CH = 64;

constexpr size_t MiB = 1u << 20;
constexpr size_t WS_CTL = 0, CTL_ZERO_BYTES = 1 * MiB;
constexpr size_t WS_WIN = 1 * MiB;
constexpr size_t WS_WKV = 15 * MiB;
constexpr size_t WS_WFO = 17 * MiB;
constexpr size_t WS_WHO = 18 * MiB;
constexpr size_t WS_WXO = 19 * MiB;
constexpr size_t WS_WOUT = 20 * MiB;
constexpr size_t WS_WRS = 22 * MiB;
constexpr size_t WS_WSD = 24 * MiB;
constexpr size_t WS_A1 = 25 * MiB;
constexpr size_t WS_A3 = 26 * MiB;
constexpr size_t WS_MEMN = 30 * MiB;
constexpr size_t WS_H0 = 32 * MiB;
constexpr size_t WS_F = 96 * MiB;
constexpr size_t WS_MERGED = 96 * MiB;
constexpr size_t WS_WBR = 17 * MiB;
constexpr size_t WS_Q = 160 * MiB;
constexpr size_t SEC_STRIDE = 32 * MiB;
constexpr size_t WS_GATES = 352 * MiB;
constexpr size_t WS_KV = 544 * MiB;
constexpr size_t WS_Y = 546 * MiB;
constexpr size_t WS_MIX = 610 * MiB;
constexpr size_t WS_OLF = 706 * MiB, WS_OLB = 738 * MiB;
constexpr size_t WS_QSF = 770 * MiB, WS_QSB = 802 * MiB;
constexpr size_t WS_U = 834 * MiB;
constexpr size_t WS_DEC = 866 * MiB;
constexpr size_t WS_SST = 867 * MiB;
constexpr size_t WS_EXPD = 883 * MiB;
constexpr size_t WS_LOGIT = 32 * MiB;
constexpr size_t WS_HS = 64 * MiB;
constexpr size_t WS_ROUTE = 80 * MiB;
constexpr size_t WS_S2 = 96 * MiB;
constexpr size_t WS_S1 = 160 * MiB;
constexpr size_t WS_HACT = 160 * MiB;
constexpr size_t WS_EXPGU = 546 * MiB;
constexpr size_t WS_YR = 546 * MiB;
constexpr size_t WS_H1 = 802 * MiB;
constexpr size_t WS_END = 1024 * MiB;
constexpr size_t RT_EIDX = 0, RT_WGT = 1 * MiB, RT_POS = 2 * MiB, RT_ROWTOK = 3 * MiB, RT_ROWSLOT = 5 * MiB, RT_ROWGATE = 6 * MiB + 512 * 1024, RT_TRASH = 7 * MiB + 768 * 1024;
constexpr int RPAD_MAX = T * TOPK + NE * 255;
constexpr int CW_BAR = 4096;
constexpr int CW_CNT = 16384;

#define LDS_WAIT() asm volatile("s_waitcnt lgkmcnt(0)" ::: "memory")
#define VM_WAIT() asm volatile("s_waitcnt vmcnt(0)" ::: "memory")
typedef __bf16 bf16x2v __attribute__((ext_vector_type(2)));
__device__ __forceinline__ unsigned cvt_pk_bf16_c(float lo, float hi) { const f32x2 v = {lo, hi}; const bf16x2v b = __builtin_convertvector(v, bf16x2v); return __builtin_bit_cast(unsigned, b); }
__device__ __forceinline__ unsigned cvt_pk_bf16(float lo, float hi) { unsigned r; asm volatile("v_cvt_pk_bf16_f32 %0, %1, %2" : "=v"(r) : "v"(lo), "v"(hi)); return r; }
__device__ __forceinline__ float bflo(unsigned w) { return __uint_as_float(w << 16); }
__device__ __forceinline__ float bfhi(unsigned w) { return __uint_as_float(w & 0xffff0000u); }
__device__ __forceinline__ float bf2f(bf16 h) { return __uint_as_float(((unsigned)h) << 16); }
__device__ __forceinline__ bf16 f2bf(float f) { return (bf16)(cvt_pk_bf16(f, 0.f) & 0xffffu); }
__device__ __forceinline__ float sigmoidf_(float x) { return __builtin_amdgcn_rcpf(1.0f + __builtin_amdgcn_exp2f(-1.4426950408889634f * x)); }
__device__ __forceinline__ float siluf_(float x) { return x * __builtin_amdgcn_rcpf(1.0f + __builtin_amdgcn_exp2f(-1.4426950408889634f * x)); }
__device__ __forceinline__ float wave_sum(float v) {
#pragma unroll
    for (int o = 1; o < 64; o <<= 1) v += __shfl_xor(v, o);
    return v;
}

#define XB_TMO      128
#define XB_XCNT(j)  (256  + 64 * (j))
#define XB_XSUB(j)  (1280 + 64 * (j))
#define XB_XGEN(j)  (2304 + 64 * (j))
#define XB_TOP      3328
#define XB_TOPGEN   3392
#define XCD_BAR_WORDS 3456
#define XB_SPIN_CAP (1u << 22)
__device__ __forceinline__ unsigned xb_ld(unsigned* p)              { return __hip_atomic_load(p, __ATOMIC_RELAXED, __HIP_MEMORY_SCOPE_AGENT); }
__device__ __forceinline__ unsigned xb_add(unsigned* p, unsigned v) { return __hip_atomic_fetch_add(p, v, __ATOMIC_RELAXED, __HIP_MEMORY_SCOPE_AGENT); }
__device__ __forceinline__ unsigned xb_xcc_id() { return (unsigned)__builtin_amdgcn_s_getreg((3 << 11) | 20) & 0xFu; }
#define XB_SPIN(cond, bar) do { unsigned _sp = 0; while (cond) { __builtin_amdgcn_s_sleep(1); \
    if ((++_sp & 255u) == 0u) { if (xb_ld(&(bar)[XB_TMO])) break; if (_sp > XB_SPIN_CAP) { atomicAdd(&(bar)[XB_TMO], 1u); break; } } } } while (0)
struct XcdBarrier { unsigned* bar; unsigned x; volatile LAS unsigned* st; };
__device__ __forceinline__ XcdBarrier xcd_barrier_post(unsigned* bar, volatile LAS unsigned* st) {
    XcdBarrier b; b.bar = bar; b.x = xb_xcc_id(); b.st = st;
    if (threadIdx.x == 0) (void)xb_add(&bar[XB_XCNT(b.x)], 1u);
    return b;
}
__device__ __forceinline__ void xcd_barrier_complete(unsigned* bar, unsigned x, unsigned& nloc, unsigned& nx) {
    const unsigned G = gridDim.x * gridDim.y * gridDim.z;
    unsigned sum, cnt, mine, sp = 0u;
    for (;;) {
        sum = 0u; cnt = 0u; mine = 0u;
#pragma unroll
        for (unsigned j = 0; j < 16; ++j) { const unsigned c = xb_ld(&bar[XB_XCNT(j)]); sum += c; cnt += (c > 0u) ? 1u : 0u; mine = (j == x) ? c : mine; }
        if (sum == G) break;
        __builtin_amdgcn_s_sleep(1);
        if ((++sp & 255u) == 0u) { if (xb_ld(&bar[XB_TMO])) break; if (sp > XB_SPIN_CAP) { atomicAdd(&bar[XB_TMO], 1u); break; } }
    }
    nloc = mine > 0u ? mine : 1u; nx = cnt > 0u ? cnt : 1u;
}
__device__ __forceinline__ void xcd_barrier(const XcdBarrier& b) {
    asm volatile("s_waitcnt vmcnt(0)" ::: "memory");
    __syncthreads();
    if (threadIdx.x == 0) {
        unsigned* bar = b.bar;
        __builtin_amdgcn_s_waitcnt(0);
        unsigned nloc = b.st[0], nx = b.st[1];
        if (nloc == 0u) { xcd_barrier_complete(bar, b.x, nloc, nx); b.st[0] = nloc; b.st[1] = nx; }
        const unsigned old = xb_add(&bar[XB_XSUB(b.x)], 1u);
        const unsigned gen = old / nloc;
        if (old + 1u == (gen + 1u) * nloc) {
            __builtin_amdgcn_fence(__ATOMIC_RELEASE, "agent");
            asm volatile("s_waitcnt vmcnt(0)" ::: "memory");
            const unsigned og = xb_add(&bar[XB_TOP], 1u);
            const unsigned tg = og / nx;
            if (og + 1u == (tg + 1u) * nx) xb_add(&bar[XB_TOPGEN], 1u);
            else XB_SPIN(xb_ld(&bar[XB_TOPGEN]) == tg, bar);
            __builtin_amdgcn_fence(__ATOMIC_ACQUIRE, "agent");
            xb_add(&bar[XB_XGEN(b.x)], 1u);
            asm volatile("s_waitcnt vmcnt(0)" ::: "memory");
        } else {
            XB_SPIN(xb_ld(&bar[XB_XGEN(b.x)]) == gen, bar);
            __builtin_amdgcn_fence(__ATOMIC_ACQUIRE, "agent");
            asm volatile("s_waitcnt vmcnt(0)" ::: "memory");
        }
    }
    __syncthreads();
}

namespace pg8 {
constexpr int BM = 256, BK = 64, HALF = 128, HTB = HALF * BK * 2, STAGE_BYTES = 8 * HTB, NXCD = 8, WGM = 8;
__host__ __device__ __forceinline__ int lds_byte(int r, int c) { const int st = (r >> 4) * 2 + (c >> 5), rr = r & 15, cc = c & 31, ob = rr * 64 + cc * 2; return st * 1024 + (ob ^ (((ob >> 9) & 1) << 5)); }
__host__ __device__ __forceinline__ void stage_rc(int b, int& R, int& C) { const int st = b / 1024, sb = b % 1024, swz = sb ^ (((sb >> 9) & 1) << 5); R = (st >> 1) * 16 + swz / 64; C = (st & 1) * 32 + (swz % 64) / 2; }
__host__ __device__ __forceinline__ int perm32(int rho) { const int n = rho >> 4, i = rho & 15; return 8 * (i >> 2) + 4 * n + (i & 3); }
struct Unit { int pm, pn; };
struct Gemm { const bf16* A; const bf16* Bt; int K; };
struct StaticOrder {
    int nM, nN, nwg, G, c;
    __device__ void init(int M, int N, int G_, int c_) { nM = M / BM; nN = N / BM; nwg = nM * nN; G = G_; c = c_; }
    __device__ bool next(int i, Unit& u) const {
        const long L = (long)i * G + c; if (L >= nwg) return false;
        int wgid = (int)L; { const int q = nwg / NXCD, r = nwg % NXCD, xcd = wgid % NXCD, off = wgid / NXCD; wgid = (xcd < r ? xcd * (q + 1) : r * (q + 1) + (xcd - r) * q) + off; }
        const int nig = WGM * nN, gid = wgid / nig, fm = gid * WGM, gsz = (nM - fm) < WGM ? (nM - fm) : WGM;
        u.pm = fm + ((wgid % nig) % gsz); u.pn = (wgid % nig) / gsz; return true;
    }
};
template <int J> struct ExpertOrder {
    int nunits, G, c; const LAS unsigned short* te;
    __device__ bool next(int i, Unit& u) const {
        const int nb = G >> 3, tpx = nb / J, x = c & 7, k = c >> 3;
        int tau, j;
        if ((G & 7) == 0 && tpx * J == nb) { tau = (i * 8 + x) * tpx + k / J; j = k % J; }
        else { const int L = i * G + c; tau = L / J; j = L - tau * J; }
        if (tau * J + j >= nunits) return false;
        u.pm = tau; u.pn = (int)te[tau] * J + j; return true;
    }
};
template <class Epi, class Sched, bool GATHER>
__device__ __forceinline__ void gemm_phase(LAS unsigned char* lds, const Gemm g, const Sched& S, const Epi& E, const int* rowidx) {
    int tid_ = threadIdx.x; asm volatile("" : "+v"(tid_));
    const int tid = tid_, wid = __builtin_amdgcn_readfirstlane(tid >> 6), lane = tid & 63, wr = wid >> 2, wc = wid & 3, fr = lane & 15, fq = lane >> 4;
    const int K = g.K, nt = K / BK;
    unsigned voffB[2], voffC[2][2];
    LAS v4u* gsl = (LAS v4u*)(lds + STAGE_BYTES + 8192) + tid;
    const size_t kstep = (size_t)(BK * 2);
    const size_t hstep = (size_t)HALF * K * 2;
    const size_t tstep = 2 * hstep;
#pragma unroll
    for (int i = 0; i < 2; ++i) { int R, C; stage_rc(tid * 16 + i * 8192, R, C); const int Rb = Epi::PERM ? ((R & ~31) + perm32(R & 31)) : R;
        voffB[i] = (unsigned)(Rb * K + C) * 2u; voffC[0][i] = (unsigned)(R * K + C) * 2u; voffC[1][i] = voffC[0][i] + (unsigned)hstep; }
    const unsigned ldsw = (unsigned)wid * 1024u;
    const int aoff = lds_byte(wr * 64 + fr, fq * 8), boff = lds_byte(wc * 32 + fr, fq * 8);
#define PG8_SA(b, h) (((b) * 2 + (h)) * HTB)
#define PG8_SB(b, h) ((4 + (b) * 2 + (h)) * HTB)
#define PG8_STAGE(bufoff, gbase, voff) do { const char* _gb = (const char*)(gbase); _Pragma("unroll") for (int _i = 0; _i < 2; ++_i) { unsigned _keep; \
        asm volatile("s_mov_b32 %0, m0\n\ts_mov_b32 m0, %3\n\ts_nop 0\n\tglobal_load_lds_dwordx4 %1, %2\n\ts_mov_b32 m0, %0" : "=&s"(_keep) : "v"((voff)[_i]), "s"(_gb), "s"((unsigned)(size_t)(lds + (bufoff) + ldsw + _i * 8192)) : "memory"); } } while (0)
#define PG8_LDA(dst, b, h) do { _Pragma("unroll") for (int m = 0; m < 4; ++m) _Pragma("unroll") for (int k = 0; k < 2; ++k) dst[m][k] = *(const LAS bf16x8*)(lds + PG8_SA(b, h) + aoff + m * 2048 + k * 1024); } while (0)
#define PG8_LDB(dst, b, h) do { _Pragma("unroll") for (int n = 0; n < 2; ++n) _Pragma("unroll") for (int k = 0; k < 2; ++k) dst[n][k] = *(const LAS bf16x8*)(lds + PG8_SB(b, h) + boff + n * 2048 + k * 1024); } while (0)
#define PG8_MMA(ai, bj, At, Bt) do { __builtin_amdgcn_s_setprio(1); _Pragma("unroll") for (int m = 0; m < 4; ++m) _Pragma("unroll") for (int n = 0; n < 2; ++n) _Pragma("unroll") for (int k = 0; k < 2; ++k) \
        acc[ai][bj][m][n] = __builtin_amdgcn_mfma_f32_16x16x32_bf16(Bt[n][k], At[m][k], acc[ai][bj][m][n], 0, 0, 0); __builtin_amdgcn_s_setprio(0); } while (0)
#define PG8_WAIT_V(n) asm volatile("s_waitcnt vmcnt(" #n ")" ::: "memory")
#define PG8_WAIT_L(n) asm volatile("s_waitcnt lgkmcnt(" #n ")" ::: "memory")
#define PG8_BAR __builtin_amdgcn_s_barrier()
#define PG8_SCHED __builtin_amdgcn_sched_barrier(0)
#define PG8_GSTORE(set, u) do { unsigned _v[2][2]; _Pragma("unroll") for (int _i = 0; _i < 2; ++_i) { int _R, _C; stage_rc(tid * 16 + _i * 8192, _R, _C); \
        _Pragma("unroll") for (int _h = 0; _h < 2; ++_h) _v[_h][_i] = ((unsigned)rowidx[(u).pm * BM + _h * HALF + _R] * (unsigned)K + (unsigned)_C) * 2u; } \
        gsl[(set) * 512] = (v4u){_v[0][0], _v[0][1], _v[1][0], _v[1][1]}; } while (0)
#define PG8_GRD(dst, h, set) unsigned dst[2]; do { if constexpr (GATHER) { const v2u _o = ((const LAS v2u*)(gsl + (set) * 512))[h]; dst[0] = _o.x; dst[1] = _o.y; } else { dst[0] = voffC[h][0]; dst[1] = voffC[h][1]; } } while (0)
    Unit cur, nxt; int ui = 0;
    if (!S.next(0, cur)) return;
    f32x4 acc[2][2][4][2];
#pragma unroll
    for (int a = 0; a < 2; ++a)
#pragma unroll
        for (int b = 0; b < 2; ++b)
#pragma unroll
            for (int m = 0; m < 4; ++m)
#pragma unroll
                for (int n = 0; n < 2; ++n) acc[a][b][m][n] = (f32x4){0.f, 0.f, 0.f, 0.f};
    bf16x8 At[4][2], B0[2][2], B1[2][2];
    const char* cA = GATHER ? (const char*)g.A : (const char*)g.A + (size_t)cur.pm * tstep; const char* cB = (const char*)g.Bt + (size_t)cur.pn * tstep;
    int par = 0;
    LAS v2u* const rib = (LAS v2u*)(lds + STAGE_BYTES + 2560);
    if constexpr (GATHER) { PG8_GSTORE(0, cur); }
    if constexpr (Epi::PRE) E.pre(cur, rib, tid);
    { PG8_GRD(p0, 0, 0); PG8_GRD(p1, 1, 0);
    PG8_STAGE(PG8_SB(0, 0), cB, voffB); PG8_STAGE(PG8_SB(0, 1), cB + hstep, voffB); PG8_STAGE(PG8_SA(0, 0), cA, p0); PG8_STAGE(PG8_SA(0, 1), cA, p1);
    if (wr == 1) PG8_BAR;
    PG8_WAIT_V(2); PG8_BAR;
    PG8_STAGE(PG8_SB(1, 0), cB + kstep, voffB); PG8_STAGE(PG8_SA(1, 0), cA + kstep, p0); PG8_STAGE(PG8_SB(1, 1), cB + hstep + kstep, voffB); }
    PG8_WAIT_V(6); PG8_BAR;
    for (;;) {
        const bool has_next = S.next(ui + 1, nxt);
        const char* nA = GATHER ? (const char*)g.A : (has_next ? (const char*)g.A + (size_t)nxt.pm * tstep : cA); const char* nB = has_next ? (const char*)g.Bt + (size_t)nxt.pn * tstep : cB;
        if constexpr (GATHER) { if (has_next) { PG8_GSTORE(par ^ 1, nxt); } else { gsl[(par ^ 1) * 512] = gsl[par * 512]; } }
        for (int t = 0; t < nt; t += 2) {
            const bool last = (t == nt - 2);
            const char* a1 = cA + (size_t)(t + 1) * kstep;
            const char* a2 = last ? nA : cA + (size_t)(t + 2) * kstep; const char* b2 = last ? nB : cB + (size_t)(t + 2) * kstep;
            const char* a3 = a2 + kstep; const char* b3 = b2 + kstep;
            const int s2 = (GATHER && last) ? (par ^ 1) : par;
            { PG8_GRD(o, 1, par); PG8_LDB(B0, 0, 0); PG8_LDB(B1, 0, 1); PG8_SCHED; PG8_LDA(At, 0, 0); PG8_STAGE(PG8_SA(1, 1), a1, o); }
            PG8_WAIT_V(8); PG8_WAIT_L(0); PG8_BAR; PG8_MMA(0, 0, At, B0); PG8_MMA(0, 1, At, B1); PG8_BAR; PG8_SCHED;
            { PG8_GRD(o, 0, s2); PG8_LDA(At, 0, 1); PG8_STAGE(PG8_SB(0, 0), b2, voffB); PG8_STAGE(PG8_SB(0, 1), b2 + hstep, voffB); PG8_STAGE(PG8_SA(0, 0), a2, o); }
            PG8_WAIT_V(8); PG8_WAIT_L(0); PG8_BAR; PG8_MMA(1, 0, At, B0); PG8_MMA(1, 1, At, B1); PG8_BAR; PG8_SCHED;
            { PG8_GRD(o, 1, s2); PG8_LDB(B0, 1, 0); PG8_LDB(B1, 1, 1); PG8_SCHED; PG8_LDA(At, 1, 0); PG8_STAGE(PG8_SA(0, 1), a2, o); }
            PG8_WAIT_V(8); PG8_WAIT_L(0); PG8_BAR; PG8_MMA(0, 0, At, B0); PG8_MMA(0, 1, At, B1); PG8_BAR; PG8_SCHED;
            { PG8_GRD(o, 0, s2); PG8_LDA(At, 1, 1); PG8_STAGE(PG8_SB(1, 0), b3, voffB); PG8_STAGE(PG8_SB(1, 1), b3 + hstep, voffB); PG8_STAGE(PG8_SA(1, 0), a3, o); }
            PG8_WAIT_V(8); PG8_WAIT_L(0); PG8_BAR; PG8_MMA(1, 0, At, B0); PG8_MMA(1, 1, At, B1); PG8_BAR; PG8_SCHED;
        }
        if (wr == 0) PG8_BAR;
        asm volatile("s_nop 15\n\ts_nop 15" ::: "memory");
        if constexpr (Epi::PRE) E(acc, cur, wr, wc, fr, fq, rib + par * 256); else E(acc, cur, wr, wc, fr, fq);
        if (!has_next) break;
        bool zero = true;
        if constexpr (Epi::CHAIN) zero = !E.keep(cur);
        if (zero) {
#pragma unroll
        for (int a = 0; a < 2; ++a)
#pragma unroll
            for (int b = 0; b < 2; ++b)
#pragma unroll
                for (int m = 0; m < 4; ++m)
#pragma unroll
                    for (int n = 0; n < 2; ++n) acc[a][b][m][n] = (f32x4){0.f, 0.f, 0.f, 0.f};
        }
        cur = nxt; cA = nA; cB = nB; ++ui; par ^= 1;
        if constexpr (Epi::PRE) E.pre(cur, rib + par * 256, tid);
        if (wr == 1) PG8_BAR;
    }
    PG8_WAIT_V(0);
    PG8_BAR;
#undef PG8_SA
#undef PG8_SB
#undef PG8_STAGE
#undef PG8_LDA
#undef PG8_LDB
#undef PG8_MMA
#undef PG8_WAIT_V
#undef PG8_WAIT_L
#undef PG8_BAR
#undef PG8_SCHED
#undef PG8_GSTORE
#undef PG8_GRD
}
}
using pg8::Unit;

typedef f32x4 AccT[2][2][4][2];
__device__ __forceinline__ v4u pack8(const f32x4 a, const f32x4 b) { v4u w; w.x = cvt_pk_bf16(a[0], a[1]); w.y = cvt_pk_bf16(a[2], a[3]); w.z = cvt_pk_bf16(b[0], b[1]); w.w = cvt_pk_bf16(b[2], b[3]); return w; }

struct EpiProj {
    static constexpr bool PERM = true, PRE = false, CHAIN = false;
    bf16* F; bf16* SEC; bf16* GATES; const float* bgate;
    __device__ __forceinline__ void operator()(const AccT& acc, const Unit& u, int wr, int wc, int fr, int fq) const {
        const int pn = u.pn; bf16* base; int ldc, colt, mode;
        if (pn < 4) { base = F; ldc = 1024; colt = pn * 256; mode = 0; }
        else if (pn < 16) { const int s = (pn - 4) >> 1; base = SEC + (size_t)s * (SEC_STRIDE / 2); ldc = 512; colt = ((pn - 4) & 1) * 256; mode = (s == 0 || s == 4) ? 1 : (s == 5 ? 3 : 0); }
        else { base = GATES; ldc = 3072; colt = (pn - 16) * 256; mode = 2; }
        const int row0 = u.pm * 256 + wr * 64 + fr, col0 = colt + wc * 32 + 8 * fq;
        f32x4 bv[2][2];
#pragma unroll
        for (int bj = 0; bj < 2; ++bj)
#pragma unroll
            for (int n = 0; n < 2; ++n) bv[bj][n] = (mode == 2) ? *(const f32x4*)(bgate + col0 + bj * 128 + 4 * n) : (f32x4){0.f, 0.f, 0.f, 0.f};
#pragma unroll
        for (int ai = 0; ai < 2; ++ai)
#pragma unroll
            for (int m = 0; m < 4; ++m) { bf16* rowp = base + (size_t)(row0 + ai * 128 + m * 16) * ldc + col0;
#pragma unroll
                for (int bj = 0; bj < 2; ++bj) { f32x4 v0 = acc[ai][bj][m][0] + bv[bj][0], v1 = acc[ai][bj][m][1] + bv[bj][1];
                    if (mode == 1) {
#pragma unroll
                        for (int j = 0; j < 4; ++j) { v0[j] = siluf_(v0[j]); v1[j] = siluf_(v1[j]); } }
                    else if (mode == 2) {
#pragma unroll
                        for (int j = 0; j < 4; ++j) { v0[j] = sigmoidf_(v0[j]); v1[j] = sigmoidf_(v1[j]); } }
                    else if (mode == 3) { v0 = v0 * 0.12751743f; v1 = v1 * 0.12751743f; }
                    *(v4u*)(rowp + bj * 128) = pack8(v0, v1); } }
    }
};
struct EpiPlain {
    static constexpr bool PERM = true, PRE = false, CHAIN = false;
    bf16* O; int ldc;
    __device__ __forceinline__ void operator()(const AccT& acc, const Unit& u, int wr, int wc, int fr, int fq) const {
        const int row0 = u.pm * 256 + wr * 64 + fr, col0 = u.pn * 256 + wc * 32 + 8 * fq;
#pragma unroll
        for (int ai = 0; ai < 2; ++ai)
#pragma unroll
            for (int m = 0; m < 4; ++m) { bf16* rowp = O + (size_t)(row0 + ai * 128 + m * 16) * ldc + col0;
#pragma unroll
                for (int bj = 0; bj < 2; ++bj) *(v4u*)(rowp + bj * 128) = pack8(acc[ai][bj][m][0], acc[ai][bj][m][1]); }
    }
};
struct EpiMix {
    static constexpr bool PERM = true, PRE = false, CHAIN = true;
    bf16* M; const bf16* gates; const float* bias;
    static __device__ __forceinline__ float rt(float n, float d) { return fmaxf(n, 1e-7f) * __builtin_amdgcn_rcpf(fmaxf(d, 1e-7f)); }
    __device__ __forceinline__ bool keep(const Unit& u) const { return (u.pn >> 2) < 2; }
    __device__ __forceinline__ void operator()(AccT& acc, const Unit& u, int wr, int wc, int fr, int fq) const {
        const int s = u.pn >> 2, row0 = (u.pm & 127) * 256 + wr * 64 + fr, col0 = (u.pn & 3) * 256 + wc * 32 + 8 * fq;
        if (s < 2) {
#pragma unroll
            for (int bj = 0; bj < 2; ++bj) {
                f32x4 b0 = (f32x4){0.f, 0.f, 0.f, 0.f}, b1 = b0;
                if (s == 0) { b0 = *(const f32x4*)(bias + col0 + bj * 128); b1 = *(const f32x4*)(bias + col0 + bj * 128 + 4); }
#pragma unroll
                for (int ai = 0; ai < 2; ++ai)
#pragma unroll
                    for (int m = 0; m < 4; ++m) { const bf16* gp = gates + (size_t)(row0 + ai * 128 + m * 16) * 3072 + s * 1024 + col0 + bj * 128;
                        const v4u gn = *(const v4u*)gp, gd = *(const v4u*)(gp + 1024);
                        f32x4 r0, r1;
                        r0[0] = rt(bflo(gn.x), bflo(gd.x)); r0[1] = rt(bfhi(gn.x), bfhi(gd.x)); r0[2] = rt(bflo(gn.y), bflo(gd.y)); r0[3] = rt(bfhi(gn.y), bfhi(gd.y));
                        r1[0] = rt(bflo(gn.z), bflo(gd.z)); r1[1] = rt(bfhi(gn.z), bfhi(gd.z)); r1[2] = rt(bflo(gn.w), bflo(gd.w)); r1[3] = rt(bfhi(gn.w), bfhi(gd.w));
                        acc[ai][bj][m][0] = (acc[ai][bj][m][0] + b0) * r0; acc[ai][bj][m][1] = (acc[ai][bj][m][1] + b1) * r1;
                        asm volatile("" ::: "memory"); }
            }
        } else {
#pragma unroll
            for (int ai = 0; ai < 2; ++ai)
#pragma unroll
                for (int m = 0; m < 4; ++m) { const size_t row = (size_t)(row0 + ai * 128 + m * 16);
#pragma unroll
                    for (int bj = 0; bj < 2; ++bj) { const v4u gw = *(const v4u*)(gates + row * 3072 + 2048 + col0 + bj * 128);
                        const f32x4 v0 = acc[ai][bj][m][0], v1 = acc[ai][bj][m][1]; f32x4 o0, o1;
                        o0[0] = fmaxf(bflo(gw.x), 1e-7f) * v0[0]; o0[1] = fmaxf(bfhi(gw.x), 1e-7f) * v0[1]; o0[2] = fmaxf(bflo(gw.y), 1e-7f) * v0[2]; o0[3] = fmaxf(bfhi(gw.y), 1e-7f) * v0[3];
                        o1[0] = fmaxf(bflo(gw.z), 1e-7f) * v1[0]; o1[1] = fmaxf(bfhi(gw.z), 1e-7f) * v1[1]; o1[2] = fmaxf(bflo(gw.w), 1e-7f) * v1[2]; o1[3] = fmaxf(bfhi(gw.w), 1e-7f) * v1[3];
                        *(v4u*)(M + row * 1024 + col0 + bj * 128) = pack8(o0, o1); } }
        }
    }
};
struct ChainOrder {
    pg8::StaticOrder S;
    __device__ bool next(int i, Unit& u) const { const int ti = i / 3, s = i - 3 * ti; if (!S.next(ti, u)) return false; u.pm += 128 * s; u.pn += 4 * s; return true; }
};
struct EpiResid {
    static constexpr bool PERM = true, PRE = false, CHAIN = false;
    bf16* O; const bf16* R;
    __device__ __forceinline__ void operator()(const AccT& acc, const Unit& u, int wr, int wc, int fr, int fq) const {
        const int row0 = u.pm * 256 + wr * 64 + fr, col0 = u.pn * 256 + wc * 32 + 8 * fq;
#pragma unroll
        for (int ai = 0; ai < 2; ++ai)
#pragma unroll
            for (int m = 0; m < 4; ++m) { const size_t off = (size_t)(row0 + ai * 128 + m * 16) * 1024 + col0;
#pragma unroll
                for (int bj = 0; bj < 2; ++bj) { const v4u rw = *(const v4u*)(R + off + bj * 128);
                    f32x4 o0 = acc[ai][bj][m][0], o1 = acc[ai][bj][m][1];
                    o0[0] += ALPHA * bflo(rw.x); o0[1] += ALPHA * bfhi(rw.x); o0[2] += ALPHA * bflo(rw.y); o0[3] += ALPHA * bfhi(rw.y);
                    o1[0] += ALPHA * bflo(rw.z); o1[1] += ALPHA * bfhi(rw.z); o1[2] += ALPHA * bflo(rw.w); o1[3] += ALPHA * bfhi(rw.w);
                    *(v4u*)(O + off + bj * 128) = pack8(o0, o1); } }
    }
};
struct EpiRouterShared {
    static constexpr bool PERM = true, PRE = false, CHAIN = false;
    float* L; bf16* HS;
    __device__ __forceinline__ void operator()(const AccT& acc, const Unit& u, int wr, int wc, int fr, int fq) const {
        const int row0 = u.pm * 256 + wr * 64 + fr, cl = wc * 32 + 8 * fq;
        if (u.pn == 0) {
#pragma unroll
            for (int ai = 0; ai < 2; ++ai)
#pragma unroll
                for (int m = 0; m < 4; ++m) { float* rowp = L + (size_t)(row0 + ai * 128 + m * 16) * 256 + cl;
#pragma unroll
                    for (int bj = 0; bj < 2; ++bj)
#pragma unroll
                        for (int n = 0; n < 2; ++n) *(f32x4*)(rowp + bj * 128 + 4 * n) = acc[ai][bj][m][n]; }
        } else {
            const int colt = (u.pn - 1) * 128;
#pragma unroll
            for (int ai = 0; ai < 2; ++ai)
#pragma unroll
                for (int m = 0; m < 4; ++m) { bf16* rowp = HS + (size_t)(row0 + ai * 128 + m * 16) * 256 + colt + cl;
                    f32x4 h0, h1;
#pragma unroll
                    for (int j = 0; j < 4; ++j) { h0[j] = siluf_(acc[ai][0][m][0][j]) * acc[ai][1][m][0][j]; h1[j] = siluf_(acc[ai][0][m][1][j]) * acc[ai][1][m][1][j]; }
                    *(v4u*)rowp = pack8(h0, h1); }
        }
    }
};
struct EpiExpGU {
    static constexpr bool PERM = true, PRE = false, CHAIN = false;
    bf16* H;
    __device__ __forceinline__ void operator()(const AccT& acc, const Unit& u, int wr, int wc, int fr, int fq) const {
        const int row0 = u.pm * 256 + wr * 64 + fr, col0 = (u.pn & 1) * 128 + wc * 32 + 8 * fq;
#pragma unroll
        for (int ai = 0; ai < 2; ++ai)
#pragma unroll
            for (int m = 0; m < 4; ++m) { bf16* rowp = H + (size_t)(row0 + ai * 128 + m * 16) * 256 + col0;
                f32x4 h0, h1;
#pragma unroll
                for (int j = 0; j < 4; ++j) { h0[j] = siluf_(acc[ai][0][m][0][j]) * acc[ai][1][m][0][j]; h1[j] = siluf_(acc[ai][0][m][1][j]) * acc[ai][1][m][1][j]; }
                *(v4u*)rowp = pack8(h0, h1); }
    }
};
struct EpiExpDown {
    static constexpr bool PERM = true, PRE = true, CHAIN = false;
    unsigned char* Y; const v2u* rowinfo; unsigned char* trash;
    __device__ __forceinline__ void pre(const Unit& u, LAS v2u* ri, int tid) const { if (tid < 256) ri[tid] = rowinfo[(size_t)u.pm * 256 + tid]; }
    __device__ __forceinline__ void operator()(const AccT& acc, const Unit& u, int wr, int wc, int fr, int fq, const LAS v2u* ri) const {
        const int rl0 = wr * 64 + fr, col0 = (u.pn & 3) * 256 + wc * 32 + 8 * fq;
#pragma unroll
        for (int ai = 0; ai < 2; ++ai)
#pragma unroll
            for (int m = 0; m < 4; ++m) { const v2u info = ri[rl0 + ai * 128 + m * 16]; const int slot = (int)info.x; const float gt = __uint_as_float(info.y) * YSCALE;
                unsigned char* rowp = (slot >= 0 ? Y + (size_t)slot * 1024 : trash) + col0;
#pragma unroll
                for (int bj = 0; bj < 2; ++bj) { const f32x4 a = acc[ai][bj][m][0] * gt, b = acc[ai][bj][m][1] * gt; v2u w;
                    int p = __builtin_amdgcn_cvt_pk_fp8_f32(__builtin_amdgcn_fmed3f(a[0], -448.f, 448.f), __builtin_amdgcn_fmed3f(a[1], -448.f, 448.f), 0, false);
                    p = __builtin_amdgcn_cvt_pk_fp8_f32(__builtin_amdgcn_fmed3f(a[2], -448.f, 448.f), __builtin_amdgcn_fmed3f(a[3], -448.f, 448.f), p, true); w.x = (unsigned)p;
                    p = __builtin_amdgcn_cvt_pk_fp8_f32(__builtin_amdgcn_fmed3f(b[0], -448.f, 448.f), __builtin_amdgcn_fmed3f(b[1], -448.f, 448.f), 0, false);
                    p = __builtin_amdgcn_cvt_pk_fp8_f32(__builtin_amdgcn_fmed3f(b[2], -448.f, 448.f), __builtin_amdgcn_fmed3f(b[3], -448.f, 448.f), p, true); w.y = (unsigned)p;
                    *(v2u*)(rowp + bj * 128) = w; } }
    }
};

constexpr int RING_OFF = 0, RING_BYTES = 131072;
constexpr int LDSX_OFF = RING_BYTES;
constexpr int LDS_BYTES = 163840;
constexpr int LDSCTL_OFF = LDS_BYTES - 256;

struct Frame {
    LAS unsigned char* lds;
    unsigned* ctl;
    unsigned char* ws;
    int tid, lane, wave, G, bid;
    float* out;
};
__device__ __forceinline__ const float* in_ptr(int i) { const float* const* ka = (const float* const*)__builtin_amdgcn_kernarg_segment_ptr(); asm volatile("" : "+s"(ka)); return ka[i]; }
enum { I_X = 0, I_MEM, I_LNIG, I_LNIB, I_LNMG, I_LNMB, I_LBF, I_LBB, I_WIN, I_BGATE, I_HNG, I_WKV, I_WFO, I_BFO, I_WHO, I_WXO, I_WOUT, I_LN1G, I_LN1B, I_WR, I_RB, I_WEG, I_WEU, I_WED, I_WSG, I_WSU, I_WSD, I_LN2G, I_LN2B };

__device__ __forceinline__ void tr_item(const float* src0, int lds_, bf16* dst0, int ldd, LAS float* scr, int lane) {
    f32x4 v[8];
#pragma unroll
    for (int i = 0; i < 8; ++i) v[i] = *(const f32x4*)(src0 + (size_t)((lane >> 3) + 8 * i) * lds_ + 4 * (lane & 7));
#pragma unroll
    for (int i = 0; i < 8; ++i) { LAS float* d = scr + ((lane >> 3) + 8 * i) * 33 + 4 * (lane & 7); d[0] = v[i][0]; d[1] = v[i][1]; d[2] = v[i][2]; d[3] = v[i][3]; }
    LDS_WAIT(); asm volatile("" ::: "memory");
    const int c = lane & 7;
#pragma unroll
    for (int j = 0; j < 4; ++j) { const int n = (lane >> 3) + 8 * j; const LAS float* s = scr + (8 * c) * 33 + n;
        v4u o; o.x = cvt_pk_bf16(s[0 * 33], s[1 * 33]); o.y = cvt_pk_bf16(s[2 * 33], s[3 * 33]); o.z = cvt_pk_bf16(s[4 * 33], s[5 * 33]); o.w = cvt_pk_bf16(s[6 * 33], s[7 * 33]);
        *(v4u*)(dst0 + (size_t)n * ldd + 8 * c) = o; }
    LDS_WAIT(); asm volatile("" ::: "memory");
}
__device__ __forceinline__ void conv_matrix(Frame& F, const float* src, size_t mat_stride, int nmat, int K, int ldsrc, int n_lo, int ncols, bf16* dst, int rbase, int rstride, int rmul, int dld = 0, int dko = 0) {
    if (dld == 0) dld = K;
    LAS float* scr = (LAS float*)(F.lds + RING_OFF + F.wave * 16384);
    const int gw = F.bid * NWAVES + F.wave, NGW = F.G * NWAVES;
    const int nkb = K / 64, nnb = ncols / 32, per = nkb * nnb, total = per * nmat;
    for (int it = gw; it < total; it += NGW) {
        const int e = it / per, r = it - e * per, kb = r / nnb, nb = r - kb * nnb, n = nb * 32;
        const int drow = rbase + e * rstride + (n >> 7) * rmul + (n & 127);
        tr_item(src + (size_t)e * mat_stride + (size_t)(kb * 64) * ldsrc + n_lo + n, ldsrc, dst + (size_t)drow * dld + dko + kb * 64, dld, scr, F.lane);
    }
}
__device__ __forceinline__ void conv_item_d(Frame& F, int it, LAS float* scr, int lane) {
    const int e = it >> 7, r = it & 127, kb = r >> 5, n = (r & 31) * 32;
    tr_item(in_ptr(I_WED) + (size_t)e * (256 * 1024) + (size_t)(kb * 64) * 1024 + n, 1024, (bf16*)(F.ws + WS_EXPD) + (size_t)(e * 1024 + n) * 256 + kb * 64, 256, scr, lane);
}
__device__ __forceinline__ void conv_item_gu(Frame& F, int it, LAS float* scr, int lane) {
    const int up = it >> 15, e = (it & 32767) >> 7, r = it & 127, kb = r >> 3, n = (r & 7) * 32, drow = e * 512 + up * 128 + (n >> 7) * 256 + (n & 127);
    tr_item(in_ptr(up ? I_WEU : I_WEG) + (size_t)e * (1024 * 256) + (size_t)(kb * 64) * 256 + n, 256, (bf16*)(F.ws + WS_EXPGU) + (size_t)drow * 1024 + kb * 64, 1024, scr, lane);
}
__device__ __forceinline__ void conv_slice(Frame& F, int d0, int d1, int g0, int g1) {
    int tid_ = threadIdx.x; asm volatile("" : "+v"(tid_));
    const int lane = tid_ & 63, wave = __builtin_amdgcn_readfirstlane(tid_ >> 6), gw = F.bid * NWAVES + wave, NGW = F.G * NWAVES;
    LAS float* scr = (LAS float*)(F.lds + RING_OFF + wave * 16384);
    for (int j = d0; (d1 < 0 || j < d1) && gw + j * NGW < 32768; ++j) conv_item_d(F, gw + j * NGW, scr, lane);
    for (int j = g0; (g1 < 0 || j < g1) && gw + j * NGW < 65536; ++j) conv_item_gu(F, gw + j * NGW, scr, lane);
}
__device__ __forceinline__ void gbar_arrive(const XcdBarrier& b) {
    asm volatile("s_waitcnt vmcnt(0)" ::: "memory");
    __syncthreads();
    if (threadIdx.x == 0) {
        unsigned* bar = b.bar;
        __builtin_amdgcn_s_waitcnt(0);
        unsigned nloc = b.st[0], nx = b.st[1];
        if (nloc == 0u) { xcd_barrier_complete(bar, b.x, nloc, nx); b.st[0] = nloc; b.st[1] = nx; }
        const unsigned old = xb_add(&bar[XB_XSUB(b.x)], 1u);
        const unsigned gen = old / nloc;
        if (old + 1u == (gen + 1u) * nloc) {
            __builtin_amdgcn_fence(__ATOMIC_RELEASE, "agent");
            asm volatile("s_waitcnt vmcnt(0)" ::: "memory");
            const unsigned og = xb_add(&bar[XB_TOP], 1u);
            const unsigned tg = og / nx;
            if (og + 1u == (tg + 1u) * nx) xb_add(&bar[XB_TOPGEN], 1u);
        }
    }
}
__device__ __forceinline__ void gbar_wait(const XcdBarrier& b) {
    if (threadIdx.x == 0) {
        const unsigned k = b.st[2];
        XB_SPIN(xb_ld(&b.bar[XB_TOPGEN]) <= k, b.bar);
        __builtin_amdgcn_fence(__ATOMIC_ACQUIRE, "agent");
        asm volatile("s_waitcnt vmcnt(0)" ::: "memory");
        b.st[2] = k + 1u;
    }
    __syncthreads();
}
__device__ __forceinline__ void ln_regs_bf16(f32x4 (&v)[4], const float* g, const float* b, bf16* orow, int lane) {
    float s = 0.f;
#pragma unroll
    for (int j = 0; j < 4; ++j) s += (v[j][0] + v[j][1]) + (v[j][2] + v[j][3]);
    const float mean = wave_sum(s) * (1.f / 1024.f); float s2 = 0.f;
#pragma unroll
    for (int j = 0; j < 4; ++j) { v[j] = v[j] - mean; s2 += (v[j][0] * v[j][0] + v[j][1] * v[j][1]) + (v[j][2] * v[j][2] + v[j][3] * v[j][3]); }
    const float rstd = 1.f / sqrtf(wave_sum(s2) * (1.f / 1024.f) + LN_EPS);
    v2u* o8 = (v2u*)orow + lane;
#pragma unroll
    for (int j = 0; j < 4; ++j) { const f32x4 gg = ((const f32x4*)g)[lane + 64 * j], bb = ((const f32x4*)b)[lane + 64 * j]; const f32x4 y = v[j] * rstd * gg + bb;
        v2u w; w.x = cvt_pk_bf16(y[0], y[1]); w.y = cvt_pk_bf16(y[2], y[3]); o8[64 * j] = w; }
}
__device__ __forceinline__ void ln_rows_f32(const float* X, int nrows, int m0, int step, const float* g, const float* b, bf16* O, int lane) {
    if (m0 >= nrows) return;
    asm volatile("" : "+v"(lane));
    f32x4 nx[4];
#pragma unroll
    for (int j = 0; j < 4; ++j) nx[j] = ((const f32x4*)(X + (size_t)m0 * D))[lane + 64 * j];
    for (int m = m0; m < nrows; m += step) {
        f32x4 v[4];
#pragma unroll
        for (int j = 0; j < 4; ++j) v[j] = nx[j];
        if (m + step < nrows) {
#pragma unroll
            for (int j = 0; j < 4; ++j) nx[j] = ((const f32x4*)(X + (size_t)(m + step) * D))[lane + 64 * j]; }
        ln_regs_bf16(v, g, b, O + (size_t)m * D, lane);
    }
}
__device__ __forceinline__ void ln_rows_bf16(const bf16* X, int nrows, int m0, int step, const float* g, const float* b, bf16* O, int lane) {
    if (m0 >= nrows) return;
    asm volatile("" : "+v"(lane));
    v2u nx[4];
#pragma unroll
    for (int j = 0; j < 4; ++j) nx[j] = ((const v2u*)(X + (size_t)m0 * D))[lane + 64 * j];
    for (int m = m0; m < nrows; m += step) {
        f32x4 v[4];
#pragma unroll
        for (int j = 0; j < 4; ++j) { v[j][0] = bflo(nx[j].x); v[j][1] = bfhi(nx[j].x); v[j][2] = bflo(nx[j].y); v[j][3] = bfhi(nx[j].y); }
        if (m + step < nrows) {
#pragma unroll
            for (int j = 0; j < 4; ++j) nx[j] = ((const v2u*)(X + (size_t)(m + step) * D))[lane + 64 * j]; }
        ln_regs_bf16(v, g, b, O + (size_t)m * D, lane);
    }
}
__device__ __forceinline__ void p0_prologue(Frame& F) {
    const int gw = F.bid * NWAVES + F.wave, NGW = F.G * NWAVES;
    unsigned char* ws = F.ws;
    {
        LAS float* scr = (LAS float*)(F.lds + RING_OFF + F.wave * 16384);
        for (int it = gw; it < 5376; it += NGW) {
            int r = it, mi, K, ld, nlo, ncols, rbase, rmul; size_t doff;
            if (r < 3072) { mi = I_WIN; K = 1024; ld = 6656; nlo = 512; ncols = 6144; doff = WS_WIN; rbase = 1024; rmul = 128; }
            else if ((r -= 3072) < 512) { mi = I_WKV; K = 1024; ld = 1024; nlo = 0; ncols = 1024; doff = WS_WKV; rbase = 0; rmul = 128; }
            else if ((r -= 512) < 256) { mi = I_WFO; K = 512; ld = 1024; nlo = 0; ncols = 1024; doff = WS_WBR; rbase = 0; rmul = 128; }
            else if ((r -= 256) < 256) { mi = I_WHO; K = 512; ld = 1024; nlo = 0; ncols = 1024; doff = WS_WBR; rbase = 1024; rmul = 128; }
            else if ((r -= 256) < 256) { mi = I_WXO; K = 512; ld = 1024; nlo = 0; ncols = 1024; doff = WS_WBR; rbase = 2048; rmul = 128; }
            else if ((r -= 256) < 512) { mi = I_WOUT; K = 1024; ld = 1024; nlo = 0; ncols = 1024; doff = WS_WOUT; rbase = 0; rmul = 128; }
            else if ((r -= 512) < 128) { mi = I_WR; K = 1024; ld = 256; nlo = 0; ncols = 256; doff = WS_WRS; rbase = 0; rmul = 128; }
            else if ((r -= 128) < 128) { mi = I_WSG; K = 1024; ld = 256; nlo = 0; ncols = 256; doff = WS_WRS; rbase = 256; rmul = 256; }
            else if ((r -= 128) < 128) { mi = I_WSU; K = 1024; ld = 256; nlo = 0; ncols = 256; doff = WS_WRS; rbase = 384; rmul = 256; }
            else { r -= 128; mi = I_WSD; K = 256; ld = 1024; nlo = 0; ncols = 1024; doff = WS_WSD; rbase = 0; rmul = 128; }
            const int nnb = ncols / 32, kb = r / nnb, nb = r - kb * nnb, n = nb * 32, drow = rbase + (n >> 7) * rmul + (n & 127);
            tr_item(in_ptr(mi) + (size_t)(kb * 64) * ld + nlo + n, ld, (bf16*)(ws + doff) + (size_t)drow * K + kb * 64, K, scr, F.lane);
        }
    }
    {
        LAS float* ct = (LAS float*)(F.lds + LDSX_OFF);
        if (F.tid < 128) { float sn, cs; __sincosf(6.283185307179586f * (float)F.tid / 128.f, &sn, &cs); ct[F.tid] = cs; ct[128 + F.tid] = sn; }
        __syncthreads();
        const float* win = in_ptr(I_WIN); bf16* wt = (bf16*)(ws + WS_WIN);
        LAS float* wscr = (LAS float*)(F.lds + RING_OFF + F.wave * 16384);
        for (int it = gw; it < 1024 * 4; it += NGW) {
            const int k = it >> 2, g = it & 3;
            const f32x2 w2 = *(const f32x2*)(win + (size_t)k * 6656 + g * 128 + 2 * F.lane);
            wscr[2 * F.lane] = w2[0]; wscr[2 * F.lane + 1] = w2[1];
            LDS_WAIT(); asm volatile("" ::: "memory");
            float ac0 = 0.f, as0 = 0.f, ac1 = 0.f, as1 = 0.f;
#pragma unroll 8
            for (int c = 0; c < 128; ++c) { const float wv = wscr[c]; const int a0 = (F.lane * c) & 127, a1 = ((F.lane + 64) * c) & 127;
                ac0 += wv * ct[a0]; as0 += wv * ct[128 + a0]; ac1 += wv * ct[a1]; as1 += wv * ct[128 + a1]; }
            wt[(size_t)(g * 128 + F.lane) * 1024 + k] = f2bf(ac0); wt[(size_t)(512 + g * 128 + F.lane) * 1024 + k] = f2bf(as0);
            wt[(size_t)(g * 128 + 64 + F.lane) * 1024 + k] = f2bf(ac1); wt[(size_t)(512 + g * 128 + 64 + F.lane) * 1024 + k] = f2bf(as1);
            LDS_WAIT(); asm volatile("" ::: "memory");
        }
        bf16* a1 = (bf16*)(ws + WS_A1);
        for (int i = F.bid * NTHR + F.tid; i < 128 * 128; i += F.G * NTHR) {
            const int m = i >> 7, kk = i & 127, po = m >> 6, k1 = m & 63, pi = kk >> 6, s1 = kk & 63;
            float sn, cs; __sincosf(6.283185307179586f * (float)((s1 * k1) & 63) / 64.f, &sn, &cs);
            const float v = (po == pi) ? cs : (po == 0 ? -sn : sn);
            a1[i] = f2bf(v * 0.125f);
        }
        bf16* a3 = (bf16*)(ws + WS_A3);
        for (int i = F.bid * NTHR + F.tid; i < 64 * 128 * 256; i += F.G * NTHR) {
            const int k1 = i >> 15, k2 = (i >> 8) & 127, kk = i & 255, s2 = kk >> 1, part = kk & 1, k = k1 + 64 * k2;
            float sn, cs; __sincosf(6.283185307179586f * (float)((s2 * k) & 8191) / 8192.f, &sn, &cs);
            a3[i] = f2bf((part == 0 ? cs : -sn) * (1.f / 128.f));
        }
    }
    ln_rows_f32(in_ptr(I_X), T, gw, NGW, in_ptr(I_LNIG), in_ptr(I_LNIB), (bf16*)(ws + WS_H0), F.lane);
    ln_rows_f32(in_ptr(I_MEM), NB * MEM, gw, NGW, in_ptr(I_LNMG), in_ptr(I_LNMB), (bf16*)(ws + WS_MEMN), F.lane);
}
__device__ __forceinline__ void p_ln1(Frame& F) {
    const int gw = F.bid * NWAVES + F.wave, NGW = F.G * NWAVES;
    ln_rows_bf16((const bf16*)(F.ws + WS_S1), T, gw, NGW, in_ptr(I_LN1G), in_ptr(I_LN1B), (bf16*)(F.ws + WS_H1), F.lane);
}
template <bool ROUTED>
__device__ __forceinline__ void p_final(Frame& F) {
    const int gw = F.bid * NWAVES + F.wave, NGW = F.G * NWAVES; int lane = F.lane; asm volatile("" : "+v"(lane));
    const float* g = in_ptr(I_LN2G); const float* b = in_ptr(I_LN2B);
    if (gw >= T) return;
    v2u nx[4]; int ny[8][4];
#define FIN_FETCH(m_) do { const v2u* xr_ = (const v2u*)((const bf16*)(F.ws + WS_S2) + (size_t)(m_) * D) + lane; const unsigned* yb_ = (const unsigned*)(F.ws + WS_YR) + (size_t)(m_) * 8 * 256; \
        _Pragma("unroll") for (int j = 0; j < 4; ++j) nx[j] = xr_[64 * j]; \
        if (ROUTED) { _Pragma("unroll") for (int k = 0; k < 8; ++k) _Pragma("unroll") for (int j = 0; j < 4; ++j) ny[k][j] = (int)yb_[(size_t)k * 256 + lane + 64 * j]; } } while (0)
    FIN_FETCH(gw);
    for (int m = gw; m < T; m += NGW) {
        f32x4 v[4], ya[4];
#pragma unroll
        for (int j = 0; j < 4; ++j) { v[j][0] = bflo(nx[j].x); v[j][1] = bfhi(nx[j].x); v[j][2] = bflo(nx[j].y); v[j][3] = bfhi(nx[j].y); ya[j] = (f32x4){0.f, 0.f, 0.f, 0.f}; }
        if (ROUTED) {
#pragma unroll
            for (int k = 0; k < 8; ++k)
#pragma unroll
                for (int j = 0; j < 4; ++j) { const int w = ny[k][j];
                    ya[j][0] += __builtin_amdgcn_cvt_f32_fp8(w, 0); ya[j][1] += __builtin_amdgcn_cvt_f32_fp8(w, 1); ya[j][2] += __builtin_amdgcn_cvt_f32_fp8(w, 2); ya[j][3] += __builtin_amdgcn_cvt_f32_fp8(w, 3); }
#pragma unroll
            for (int j = 0; j < 4; ++j) v[j] = v[j] + ya[j] * (1.0f / YSCALE);
        }
        if (m + NGW < T) FIN_FETCH(m + NGW);
        float s = 0.f;
#pragma unroll
        for (int j = 0; j < 4; ++j) s += (v[j][0] + v[j][1]) + (v[j][2] + v[j][3]);
        const float mean = wave_sum(s) * (1.f / 1024.f); float s2 = 0.f;
#pragma unroll
        for (int j = 0; j < 4; ++j) { v[j] = v[j] - mean; s2 += (v[j][0] * v[j][0] + v[j][1] * v[j][1]) + (v[j][2] * v[j][2] + v[j][3] * v[j][3]); }
        const float rstd = 1.f / sqrtf(wave_sum(s2) * (1.f / 1024.f) + LN_EPS);
        f32x4* o = (f32x4*)(F.out + (size_t)m * D) + lane;
#pragma unroll
        for (int j = 0; j < 4; ++j) { const f32x4 gg = ((const f32x4*)g)[lane + 64 * j], bb = ((const f32x4*)b)[lane + 64 * j]; o[64 * j] = v[j] * rstd * gg + bb; }
    }
#undef FIN_FETCH
}


__device__ __forceinline__ void p_proj(Frame& F) {
    pg8::Gemm g{(const bf16*)(F.ws + WS_H0), (const bf16*)(F.ws + WS_WIN), 1024};
    pg8::StaticOrder S; S.init(T, NPROJ, F.G, F.bid);
    EpiProj E{(bf16*)(F.ws + WS_F), (bf16*)(F.ws + WS_Q), (bf16*)(F.ws + WS_GATES), in_ptr(I_BGATE)};
    pg8::gemm_phase<EpiProj, pg8::StaticOrder, false>(F.lds + RING_OFF, g, S, E, nullptr);
}
__device__ __forceinline__ void p_kv(Frame& F) {
    pg8::Gemm g{(const bf16*)(F.ws + WS_MEMN), (const bf16*)(F.ws + WS_WKV), 1024};
    pg8::StaticOrder S; S.init(NB * MEM, 1024, F.G, F.bid);
    EpiPlain E{(bf16*)(F.ws + WS_KV), 1024};
    pg8::gemm_phase<EpiPlain, pg8::StaticOrder, false>(F.lds + RING_OFF, g, S, E, nullptr);
}
__device__ __forceinline__ void p_branch(Frame& F) {
    pg8::Gemm g{(const bf16*)(F.ws + WS_MIX), (const bf16*)(F.ws + WS_WBR), 512};
    ChainOrder S; S.S.init(T, 1024, F.G, F.bid);
    EpiMix E{(bf16*)(F.ws + WS_MERGED), (const bf16*)(F.ws + WS_GATES), in_ptr(I_BFO)};
    pg8::gemm_phase<EpiMix, ChainOrder, false>(F.lds + RING_OFF, g, S, E, nullptr);
}
__device__ __forceinline__ void p_wout(Frame& F) {
    pg8::Gemm g{(const bf16*)(F.ws + WS_MERGED), (const bf16*)(F.ws + WS_WOUT), 1024};
    pg8::StaticOrder S; S.init(T, 1024, F.G, F.bid);
    EpiResid E{(bf16*)(F.ws + WS_S1), (const bf16*)(F.ws + WS_H0)};
    pg8::gemm_phase<EpiResid, pg8::StaticOrder, false>(F.lds + RING_OFF, g, S, E, nullptr);
}
__device__ __forceinline__ void p_router_shared(Frame& F) {
    pg8::Gemm g{(const bf16*)(F.ws + WS_H1), (const bf16*)(F.ws + WS_WRS), 1024};
    pg8::StaticOrder S; S.init(T, 768, F.G, F.bid);
    EpiRouterShared E{(float*)(F.ws + WS_LOGIT), (bf16*)(F.ws + WS_HS)};
    pg8::gemm_phase<EpiRouterShared, pg8::StaticOrder, false>(F.lds + RING_OFF, g, S, E, nullptr);
}
__device__ __forceinline__ void p_shared_down(Frame& F) {
    pg8::Gemm g{(const bf16*)(F.ws + WS_HS), (const bf16*)(F.ws + WS_WSD), 256};
    pg8::StaticOrder S; S.init(T, 1024, F.G, F.bid);
    EpiResid E{(bf16*)(F.ws + WS_S2), (const bf16*)(F.ws + WS_H1)};
    pg8::gemm_phase<EpiResid, pg8::StaticOrder, false>(F.lds + RING_OFF, g, S, E, nullptr);
}

constexpr int XA_PITCH = 136;
__device__ __forceinline__ void p_xattn(Frame& F) {
    LAS bf16* Ks = (LAS bf16*)(F.lds); LAS bf16* Vs = Ks + 256 * XA_PITCH;
    const bf16* KV = (const bf16*)(F.ws + WS_KV); const bf16* XQ = (const bf16*)(F.ws + WS_Q + 5 * SEC_STRIDE); bf16* XO = (bf16*)(F.ws + WS_MIX) + (size_t)2 * T * 512;
    const int lane = F.lane, r = lane & 15, q = lane >> 4, qp = (lane & 15) >> 2, pp = lane & 3;
    int cur_bh = -1;
    for (int u = F.bid; u < 512; u += F.G) {
        const int bh = u & 15, tile = u >> 4, b = bh >> 2, h = bh & 3;
        if (bh != cur_bh) {
            __syncthreads();
            for (int c = F.tid; c < 256 * 16; c += NTHR) { const int key = c >> 4, ch = c & 15;
                const v4u kv = *(const v4u*)(KV + (size_t)(b * 256 + key) * 1024 + h * 128 + ch * 8);
                const v4u vv = *(const v4u*)(KV + (size_t)(b * 256 + key) * 1024 + 512 + h * 128 + ch * 8);
                *(LAS v4u*)(Ks + key * XA_PITCH + ch * 8) = kv; *(LAS v4u*)(Vs + key * XA_PITCH + ch * 8) = vv; }
            __syncthreads();
            cur_bh = bh;
        }
        const int t0 = b * SEQ + tile * 256 + F.wave * 32;
#pragma unroll 1
        for (int mq = 0; mq < 2; ++mq) {
            const bf16* qrow = XQ + (size_t)(t0 + 16 * mq + r) * 512 + h * 128 + 8 * q;
            bf16x8 qf[4];
#pragma unroll
            for (int ks = 0; ks < 4; ++ks) qf[ks] = *(const bf16x8*)(qrow + 32 * ks);
            f32x4 sc[16];
#pragma unroll
            for (int nk = 0; nk < 16; ++nk) { sc[nk] = (f32x4){0.f, 0.f, 0.f, 0.f};
#pragma unroll
                for (int ks = 0; ks < 4; ++ks) { const bf16x8 kf = *(const LAS bf16x8*)(Ks + (16 * nk + r) * XA_PITCH + 32 * ks + 8 * q);
                    sc[nk] = __builtin_amdgcn_mfma_f32_16x16x32_bf16(kf, qf[ks], sc[nk], 0, 0, 0); } }
            float mx = -3.0e38f;
#pragma unroll
            for (int nk = 0; nk < 16; ++nk) mx = fmaxf(mx, fmaxf(fmaxf(sc[nk][0], sc[nk][1]), fmaxf(sc[nk][2], sc[nk][3])));
            mx = fmaxf(mx, __shfl_xor(mx, 16)); mx = fmaxf(mx, __shfl_xor(mx, 32));
            float l = 0.f;
#pragma unroll
            for (int nk = 0; nk < 16; ++nk) {
#pragma unroll
                for (int j = 0; j < 4; ++j) { sc[nk][j] = __builtin_amdgcn_exp2f(sc[nk][j] - mx); l += sc[nk][j]; } }
            l += __shfl_xor(l, 16); l += __shfl_xor(l, 32);
            const float inv = 1.0f / l;
            bf16x8 pf[8];
#pragma unroll
            for (int s = 0; s < 8; ++s) { v4u w; w.x = cvt_pk_bf16(sc[2 * s][0], sc[2 * s][1]); w.y = cvt_pk_bf16(sc[2 * s][2], sc[2 * s][3]);
                w.z = cvt_pk_bf16(sc[2 * s + 1][0], sc[2 * s + 1][1]); w.w = cvt_pk_bf16(sc[2 * s + 1][2], sc[2 * s + 1][3]); pf[s] = __builtin_bit_cast(bf16x8, w); }
            bf16* orow = XO + (size_t)(t0 + 16 * mq + r) * 512 + h * 128 + 4 * q;
#pragma unroll
            for (int nd = 0; nd < 8; ++nd) { f32x4 o = (f32x4){0.f, 0.f, 0.f, 0.f};
#pragma unroll
                for (int s = 0; s < 8; ++s) {
                    const s16x4 v0 = __builtin_amdgcn_ds_read_tr16_b64_v4i16((LAS s16x4*)(Vs + (32 * s + 4 * q + qp) * XA_PITCH + 16 * nd + 4 * pp));
                    const s16x4 v1 = __builtin_amdgcn_ds_read_tr16_b64_v4i16((LAS s16x4*)(Vs + (32 * s + 16 + 4 * q + qp) * XA_PITCH + 16 * nd + 4 * pp));
                    const bf16x8 vf = {v0[0], v0[1], v0[2], v0[3], v1[0], v1[1], v1[2], v1[3]};
                    o = __builtin_amdgcn_mfma_f32_16x16x32_bf16(vf, pf[s], o, 0, 0, 0); }
                o = o * inv;
                v2u w; w.x = cvt_pk_bf16(o[0], o[1]); w.y = cvt_pk_bf16(o[2], o[3]); *(v2u*)(orow + 16 * nd) = w; }
        }
    }
    __syncthreads();
}

__device__ __forceinline__ unsigned fkey(float x) { const unsigned b = __float_as_uint(x); return (b & 0x80000000u) ? ~b : (b | 0x80000000u); }
__device__ __forceinline__ int popc64(unsigned long long m) { return __builtin_popcountll(m); }
__device__ __forceinline__ void p_routing(Frame& F) {
    const int gw = F.bid * NWAVES + F.wave, NGW = F.G * NWAVES, lane = F.lane;
    const float* L = (const float*)(F.ws + WS_LOGIT);
    int* eidx = (int*)(F.ws + WS_ROUTE + RT_EIDX); float* wgt = (float*)(F.ws + WS_ROUTE + RT_WGT); int* pos = (int*)(F.ws + WS_ROUTE + RT_POS);
    unsigned* cnt = F.ctl + CW_CNT;
    const f32x4 rb = ((const f32x4*)in_ptr(I_RB))[lane];
    const float NEG = -__builtin_inff();
    const unsigned long long below = (lane == 0) ? 0ull : (~0ull >> (64 - lane));
    LAS int* le = (LAS int*)(F.lds + F.wave * 1024); LAS float* lw = (LAS float*)(F.lds + F.wave * 1024 + 256);
    f32x4 lgn = ((const f32x4*)(L + (size_t)gw * 256))[lane];
    for (int base = gw; base < T; base += 8 * NGW) {
#pragma unroll 1
      for (int jt = 0; jt < 8; ++jt) {
        const int t = base + jt * NGW; if (t >= T) break;
        const f32x4 lg = lgn;
        if (t + NGW < T) lgn = ((const f32x4*)(L + (size_t)(t + NGW) * 256))[lane];
        const float a0 = sigmoidf_(lg[0]), a1 = sigmoidf_(lg[1]), a2 = sigmoidf_(lg[2]), a3 = sigmoidf_(lg[3]);
        float s0 = a0 + rb[0], s1 = a1 + rb[1], s2 = a2 + rb[2], s3 = a3 + rb[3];
        float m1 = fmaxf(s0, s1), m2 = fminf(s0, s1);
        { const float n1 = fmaxf(m1, s2), n2 = fmaxf(fminf(m1, s2), m2); m1 = n1; m2 = n2; }
        { const float n1 = fmaxf(m1, s3), n2 = fmaxf(fminf(m1, s3), m2); m1 = n1; m2 = n2; }
#pragma unroll
        for (int o = 1; o < 8; o <<= 1) { const float p1 = __shfl_xor(m1, o), p2 = __shfl_xor(m2, o); const float n1 = fmaxf(m1, p1), n2 = fmaxf(fminf(m1, p1), fmaxf(m2, p2)); m1 = n1; m2 = n2; }
        const float gs = m1 + m2; const int grp = lane >> 3; int rank = 0;
#pragma unroll
        for (int g2 = 0; g2 < 8; ++g2) { const float o = __uint_as_float((unsigned)__builtin_amdgcn_readlane((int)__float_as_uint(gs), g2 * 8)); rank += (o > gs || (o == gs && g2 < grp)) ? 1 : 0; }
        if (rank >= 4) { s0 = NEG; s1 = NEG; s2 = NEG; s3 = NEG; }
        const unsigned k0 = fkey(s0), k1 = fkey(s1), k2 = fkey(s2), k3 = fkey(s3);
        unsigned Tk = 0u;
#pragma unroll 1
        for (int bit = 31; bit >= 0; --bit) { const unsigned cand = Tk | (1u << bit);
            const int c = popc64(__ballot(k0 >= cand)) + popc64(__ballot(k1 >= cand)) + popc64(__ballot(k2 >= cand)) + popc64(__ballot(k3 >= cand));
            if (c >= 8) Tk = cand; }
        const unsigned long long g0 = __ballot(k0 > Tk), g1 = __ballot(k1 > Tk), g2b = __ballot(k2 > Tk), g3 = __ballot(k3 > Tk);
        const unsigned long long e0 = __ballot(k0 == Tk), e1 = __ballot(k1 == Tk), e2 = __ballot(k2 == Tk), e3 = __ballot(k3 == Tk);
        const int need = 8 - (popc64(g0) + popc64(g1) + popc64(g2b) + popc64(g3));
        const int r0 = popc64(e0 & below), r1 = popc64(e0) + popc64(e1 & below), r2 = popc64(e0) + popc64(e1) + popc64(e2 & below), r3 = popc64(e0) + popc64(e1) + popc64(e2) + popc64(e3 & below);
        const bool c0 = (k0 > Tk) || (k0 == Tk && r0 < need), c1 = (k1 > Tk) || (k1 == Tk && r1 < need), c2 = (k2 > Tk) || (k2 == Tk && r2 < need), c3 = (k3 > Tk) || (k3 == Tk && r3 < need);
        const unsigned long long b0 = __ballot(c0), b1 = __ballot(c1), b2 = __ballot(c2), b3 = __ballot(c3);
        float asum = (c0 ? a0 : 0.f) + (c1 ? a1 : 0.f) + (c2 ? a2 : 0.f) + (c3 ? a3 : 0.f);
        asum = wave_sum(asum);
        const float sc = 2.5f / asum;
        const int p0 = popc64(b0 & below), p1 = popc64(b0) + popc64(b1 & below), p2 = popc64(b0) + popc64(b1) + popc64(b2 & below), p3 = popc64(b0) + popc64(b1) + popc64(b2) + popc64(b3 & below);
        if (c0) { le[jt * 8 + p0] = 4 * lane; lw[jt * 8 + p0] = a0 * sc; }
        if (c1) { le[jt * 8 + p1] = 4 * lane + 1; lw[jt * 8 + p1] = a1 * sc; }
        if (c2) { le[jt * 8 + p2] = 4 * lane + 2; lw[jt * 8 + p2] = a2 * sc; }
        if (c3) { le[jt * 8 + p3] = 4 * lane + 3; lw[jt * 8 + p3] = a3 * sc; }
      }
      { const int t = base + (lane >> 3) * NGW;
        if (t < T) { const int e = le[lane]; const float wv = lw[lane];
            const unsigned p = __hip_atomic_fetch_add(cnt + e, 1u, __ATOMIC_RELAXED, __HIP_MEMORY_SCOPE_AGENT);
            const size_t o = (size_t)t * 8 + (lane & 7); eidx[o] = e; wgt[o] = wv; pos[o] = (int)p; } }
    }
}
__device__ __forceinline__ int build_expert_tables(Frame& F, LAS unsigned short* te, LAS int* roff) {
    LAS int* tmp = (LAS int*)(F.lds + LDSX_OFF + 6656);
    const unsigned* cnt = F.ctl + CW_CNT;
    __syncthreads();
    if (F.tid < 256) tmp[F.tid] = (int)((__hip_atomic_load(cnt + F.tid, __ATOMIC_RELAXED, __HIP_MEMORY_SCOPE_AGENT) + 255u) >> 8);
    __syncthreads();
    if (F.tid < 256) { int s = 0; for (int j = 0; j < F.tid; ++j) s += tmp[j]; const int nt = tmp[F.tid];
        for (int i = 0; i < nt; ++i) te[s + i] = (unsigned short)F.tid;
        if (roff) roff[F.tid] = s * 256;
        if (F.tid == 255) tmp[256] = s + nt; }
    __syncthreads();
    return tmp[256];
}
__device__ __forceinline__ void p_fill(Frame& F) {
    LAS unsigned short* te = (LAS unsigned short*)(F.lds + LDSX_OFF); LAS int* roff = (LAS int*)(F.lds + LDSX_OFF + 8192);
    (void)build_expert_tables(F, te, roff);
    const int* eidx = (const int*)(F.ws + WS_ROUTE + RT_EIDX); const float* wgt = (const float*)(F.ws + WS_ROUTE + RT_WGT); const int* pos = (const int*)(F.ws + WS_ROUTE + RT_POS);
    int* rowtok = (int*)(F.ws + WS_ROUTE + RT_ROWTOK); v2u* rowinfo = (v2u*)(F.ws + WS_ROUTE + RT_ROWSLOT);
    for (int i = F.bid * NTHR + F.tid; i < T * TOPK; i += F.G * NTHR) { const int e = eidx[i]; const int r = roff[e] + pos[i]; rowtok[r] = i >> 3; rowinfo[r] = (v2u){(unsigned)i, __float_as_uint(wgt[i])}; }
    const unsigned* cnt = F.ctl + CW_CNT;
    for (int e = F.bid; e < NE; e += F.G) { const int c = (int)__hip_atomic_load(cnt + e, __ATOMIC_RELAXED, __HIP_MEMORY_SCOPE_AGENT), r0 = roff[e] + c, r1 = roff[e] + ((c + 255) & ~255);
        for (int r = r0 + F.tid; r < r1; r += NTHR) { rowtok[r] = 0; rowinfo[r] = (v2u){0xffffffffu, 0u}; } }
    __syncthreads();
}
__device__ __forceinline__ void p_exp_gu(Frame& F) {
    LAS unsigned short* te = (LAS unsigned short*)(F.lds + LDSX_OFF);
    const int ntiles = build_expert_tables(F, te, nullptr);
    pg8::Gemm g{(const bf16*)(F.ws + WS_H1), (const bf16*)(F.ws + WS_EXPGU), 1024};
    pg8::ExpertOrder<2> S{ntiles * 2, F.G, F.bid, te};
    EpiExpGU E{(bf16*)(F.ws + WS_HACT)};
    pg8::gemm_phase<EpiExpGU, pg8::ExpertOrder<2>, true>(F.lds + RING_OFF, g, S, E, (const int*)(F.ws + WS_ROUTE + RT_ROWTOK));
}
__device__ __forceinline__ void p_exp_down(Frame& F) {
    LAS unsigned short* te = (LAS unsigned short*)(F.lds + LDSX_OFF);
    const int ntiles = build_expert_tables(F, te, nullptr);
    pg8::Gemm g{(const bf16*)(F.ws + WS_HACT), (const bf16*)(F.ws + WS_EXPD), 256};
    pg8::ExpertOrder<4> S{ntiles * 4, F.G, F.bid, te};
    EpiExpDown E{(unsigned char*)(F.ws + WS_YR), (const v2u*)(F.ws + WS_ROUTE + RT_ROWSLOT), (unsigned char*)(F.ws + WS_ROUTE + RT_TRASH)};
    pg8::gemm_phase<EpiExpDown, pg8::ExpertOrder<4>, false>(F.lds + RING_OFF, g, S, E, nullptr);
}

template <int STEP>
__device__ __forceinline__ void p_dft(Frame& F) {
    constexpr int K = STEP == 1 ? 128 : 256, NBC = STEP == 1 ? 256 : 128, WM = STEP == 1 ? 1 : 2, WN = 8 / WM;
    constexpr int MT = 128 / WM / 16, NT = NBC / WN / 16, PITCH = NBC + 8, CPR = NBC / 8;
    LAS bf16* Bs = (LAS bf16*)F.lds;
    const bf16* Fb = (const bf16*)(F.ws + WS_F); bf16* Yb = (bf16*)(F.ws + WS_Y); bf16* FM = (bf16*)(F.ws + WS_MIX);
    const int lane = F.lane, r = lane & 15, q = lane >> 4, qp = (lane & 15) >> 2, pp = lane & 3;
    const int wm = F.wave / WN, wn = F.wave % WN;
    bf16x8 af[K / 32][MT];
    if (STEP == 1) {
#pragma unroll
        for (int ks = 0; ks < K / 32; ++ks)
#pragma unroll
            for (int mi = 0; mi < MT; ++mi) af[ks][mi] = *(const bf16x8*)((const bf16*)(F.ws + WS_A1) + (size_t)(wm * (128 / WM) + 16 * mi + r) * K + 32 * ks + 8 * q);
    }
    for (int u = F.bid; u < 1024; u += F.G) {
        const int b = u >> 8, mid = STEP == 1 ? (u >> 1) & 127 : (u >> 2) & 63, n0 = STEP == 1 ? (u & 1) * 256 : (u & 3) * 128;
        if (STEP == 3) { const bf16* A = (const bf16*)(F.ws + WS_A3) + (size_t)mid * 128 * 256;
#pragma unroll
            for (int ks = 0; ks < K / 32; ++ks)
#pragma unroll
                for (int mi = 0; mi < MT; ++mi) af[ks][mi] = *(const bf16x8*)(A + (size_t)(wm * (128 / WM) + 16 * mi + r) * K + 32 * ks + 8 * q); }
        __syncthreads();
        for (int c = F.tid; c < K * CPR; c += NTHR) { const int kk = c / CPR, ch = c % CPR;
            const bf16* src = STEP == 1 ? Fb + (size_t)(b * SEQ + 128 * (kk & 63) + mid) * 1024 + (kk >> 6) * 512 + n0 + ch * 8
                                        : Yb + ((size_t)(b * 64 + mid) * 256 + kk) * 512 + n0 + ch * 8;
            *(LAS v4u*)(Bs + kk * PITCH + ch * 8) = *(const v4u*)src; }
        __syncthreads();
        f32x4 acc[MT][NT];
#pragma unroll
        for (int mi = 0; mi < MT; ++mi)
#pragma unroll
            for (int ni = 0; ni < NT; ++ni) acc[mi][ni] = (f32x4){0.f, 0.f, 0.f, 0.f};
#pragma unroll
        for (int ks = 0; ks < K / 32; ++ks) {
#pragma unroll
            for (int ni = 0; ni < NT; ++ni) { const int n = wn * (NBC / WN) + 16 * ni;
                const s16x4 v0 = __builtin_amdgcn_ds_read_tr16_b64_v4i16((LAS s16x4*)(Bs + (32 * ks + 8 * q + qp) * PITCH + n + 4 * pp));
                const s16x4 v1 = __builtin_amdgcn_ds_read_tr16_b64_v4i16((LAS s16x4*)(Bs + (32 * ks + 8 * q + 4 + qp) * PITCH + n + 4 * pp));
                const bf16x8 xf = {v0[0], v0[1], v0[2], v0[3], v1[0], v1[1], v1[2], v1[3]};
#pragma unroll
                for (int mi = 0; mi < MT; ++mi) acc[mi][ni] = __builtin_amdgcn_mfma_f32_16x16x32_bf16(xf, af[ks][mi], acc[mi][ni], 0, 0, 0); }
        }
#pragma unroll
        for (int mi = 0; mi < MT; ++mi) { const int m = wm * (128 / WM) + 16 * mi + r;
            bf16* drow = STEP == 1 ? Yb + ((((size_t)(b * 64 + (m & 63)) * 128 + mid) * 2 + (m >> 6)) * 512)
                                   : FM + (size_t)(b * SEQ + mid + 64 * m) * 512;
#pragma unroll
            for (int ni = 0; ni < NT; ++ni) { const int n = n0 + wn * (NBC / WN) + 16 * ni + 4 * q; const f32x4 o = acc[mi][ni];
                v2u w; w.x = cvt_pk_bf16_c(o[0], o[1]); w.y = cvt_pk_bf16_c(o[2], o[3]); *(v2u*)(drow + n) = w; } }
    }
    __syncthreads();
}

__device__ __forceinline__ v2u pack4c(const f32x4 o) { v2u w; w.x = cvt_pk_bf16_c(o[0], o[1]); w.y = cvt_pk_bf16_c(o[2], o[3]); return w; }
__device__ __forceinline__ bf16x8 tr8(const LAS bf16* p0, const LAS bf16* p1) {
    const s16x4 a = __builtin_amdgcn_ds_read_tr16_b64_v4i16((LAS s16x4*)p0), b = __builtin_amdgcn_ds_read_tr16_b64_v4i16((LAS s16x4*)p1);
    return (bf16x8){a[0], a[1], a[2], a[3], b[0], b[1], b[2], b[3]};
}
constexpr int HP = 136;
__device__ __forceinline__ void p_hgrn1(Frame& F) {
    LAS bf16* Qd = (LAS bf16*)F.lds; LAS bf16* Ki = Qd + 64 * HP; LAS bf16* Ke = Ki + 64 * HP; LAS bf16* Vs = Ke + 64 * HP; LAS bf16* Sb = Vs + 64 * HP;
    LAS float* tot = (LAS float*)(Sb + 128 * HP); LAS float* dec = tot + 16 * 128;
    const int tid = F.tid, lane = F.lane, r = lane & 15, q = lane >> 4, qp = (lane & 15) >> 2, pp = lane & 3, w = F.wave, tb = w & 3, dh = w >> 2;
    const int d4 = tid & 31, tg = tid >> 5;
    for (int u = F.bid; u < 512; u += F.G) {
        const int sg = u & 15, dir = (u >> 4) & 1, h = (u >> 5) & 3, b = u >> 7;
        const bf16* Qg = (const bf16*)(F.ws + WS_Q) + h * 128; const bf16* Vg = (const bf16*)(F.ws + WS_Q + SEC_STRIDE) + h * 128;
        const bf16* Zg = (const bf16*)(F.ws + WS_Q + (dir ? 3 : 2) * SEC_STRIDE) + h * 128;
        bf16* OL = (bf16*)(F.ws + (dir ? WS_OLB : WS_OLF)) + h * 128; bf16* QS = (bf16*)(F.ws + (dir ? WS_QSB : WS_QSF)) + h * 128;
        const float* lbp = in_ptr(dir ? I_LBB : I_LBF);
        f32x4 lb, G2 = (f32x4){0.f, 0.f, 0.f, 0.f};
        { const f32x4 p0 = *(const f32x4*)(lbp + h * 128 + 4 * d4), p1 = *(const f32x4*)(lbp + 512 + h * 128 + 4 * d4);
#pragma unroll
          for (int c = 0; c < 4; ++c) lb[c] = sigmoidf_(p0[c] - p1[c]); }
        f32x4 sS[8];
#pragma unroll
        for (int nd = 0; nd < 8; ++nd) sS[nd] = (f32x4){0.f, 0.f, 0.f, 0.f};
        __syncthreads();
        for (int i = tid; i < 128 * HP / 8; i += NTHR) ((LAS v4u*)Sb)[i] = (v4u){0u, 0u, 0u, 0u};
#pragma unroll 1
        for (int c = 0; c < 8; ++c) {
            __syncthreads();
            const int tbase = sg * SEG + 64 * c;
            f32x4 qv[4], kv[4], cs[4], run = (f32x4){0.f, 0.f, 0.f, 0.f};
            v2u zr[4], qr[4];
#pragma unroll
            for (int i = 0; i < 4; ++i) { const int pos = tbase + 4 * tg + i; const size_t tok = (size_t)(b * SEQ + (dir ? SEQ - 1 - pos : pos));
                zr[i] = *(const v2u*)(Zg + tok * 512 + 4 * d4); qr[i] = *(const v2u*)(Qg + tok * 512 + 4 * d4); }
#pragma unroll
            for (int i = 0; i < 4; ++i) { const f32x4 z = (f32x4){bflo(zr[i].x), bfhi(zr[i].x), bflo(zr[i].y), bfhi(zr[i].y)};
                qv[i] = (f32x4){bflo(qr[i].x), bfhi(qr[i].x), bflo(qr[i].y), bfhi(qr[i].y)};
#pragma unroll
                for (int e = 0; e < 4; ++e) { const float f = lb[e] + (1.0f - lb[e]) * sigmoidf_(z[e]); kv[i][e] = 1.0f - f; run[e] += __builtin_amdgcn_logf(f); }
                cs[i] = run; }
            *(LAS f32x4*)(tot + tg * 128 + 4 * d4) = run;
            for (int cc = tid; cc < 1024; cc += NTHR) { const int tp = cc >> 4, ch = cc & 15, pos = tbase + tp; const size_t tok = (size_t)(b * SEQ + (dir ? SEQ - 1 - pos : pos));
                *(LAS v4u*)(Vs + tp * HP + ch * 8) = *(const v4u*)(Vg + tok * 512 + ch * 8); }
            __syncthreads();
            f32x4 pre = (f32x4){0.f, 0.f, 0.f, 0.f}, aend = pre;
#pragma unroll
            for (int j = 0; j < 16; ++j) { const f32x4 x = *(const LAS f32x4*)(tot + j * 128 + 4 * d4); aend = aend + x; if (j < tg) pre = pre + x; }
            f32x4 eend, eG;
#pragma unroll
            for (int e = 0; e < 4; ++e) { eend[e] = __builtin_amdgcn_exp2f(aend[e]); eG[e] = __builtin_amdgcn_exp2f(G2[e]); }
#pragma unroll
            for (int i = 0; i < 4; ++i) { const int tp = 4 * tg + i, pos = tbase + tp; const size_t tok = (size_t)(b * SEQ + (dir ? SEQ - 1 - pos : pos));
                f32x4 qd, ki, ke, qs;
#pragma unroll
                for (int e = 0; e < 4; ++e) { const float ea = __builtin_amdgcn_exp2f(pre[e] + cs[i][e]), ei = __builtin_amdgcn_rcpf(ea);
                    qd[e] = qv[i][e] * ea; ki[e] = kv[i][e] * ei; ke[e] = ki[e] * eend[e]; qs[e] = qd[e] * eG[e]; }
                v2u wq, wk, we, ws2; wq.x = cvt_pk_bf16(qd[0], qd[1]); wq.y = cvt_pk_bf16(qd[2], qd[3]); wk.x = cvt_pk_bf16(ki[0], ki[1]); wk.y = cvt_pk_bf16(ki[2], ki[3]);
                we.x = cvt_pk_bf16(ke[0], ke[1]); we.y = cvt_pk_bf16(ke[2], ke[3]); ws2.x = cvt_pk_bf16(qs[0], qs[1]); ws2.y = cvt_pk_bf16(qs[2], qs[3]);
                *(LAS v2u*)(Qd + tp * HP + 4 * d4) = wq; *(LAS v2u*)(Ki + tp * HP + 4 * d4) = wk; *(LAS v2u*)(Ke + tp * HP + 4 * d4) = we;
                *(v2u*)(QS + tok * 512 + 4 * d4) = ws2; }
            if (tg == 0) *(LAS f32x4*)(dec + 4 * d4) = eend;
            G2 = G2 + aend;
            __syncthreads();
            bf16x8 qf[4];
#pragma unroll
            for (int ks = 0; ks < 4; ++ks) qf[ks] = *(const LAS bf16x8*)(Qd + (16 * tb + r) * HP + 32 * ks + 8 * q);
            f32x4 sc[4];
#pragma unroll
            for (int sb = 0; sb < 4; ++sb) { sc[sb] = (f32x4){0.f, 0.f, 0.f, 0.f};
#pragma unroll
                for (int ks = 0; ks < 4; ++ks) { const bf16x8 kf = *(const LAS bf16x8*)(Ki + (16 * sb + r) * HP + 32 * ks + 8 * q); sc[sb] = __builtin_amdgcn_mfma_f32_16x16x32_bf16(kf, qf[ks], sc[sb], 0, 0, 0); }
#pragma unroll
                for (int j = 0; j < 4; ++j) sc[sb][j] = (16 * sb + 4 * q + j > 16 * tb + r) ? 0.f : sc[sb][j]; }
            bf16x8 pf[2];
#pragma unroll
            for (int k2 = 0; k2 < 2; ++k2) { v4u wv; wv.x = cvt_pk_bf16(sc[2 * k2][0], sc[2 * k2][1]); wv.y = cvt_pk_bf16(sc[2 * k2][2], sc[2 * k2][3]);
                wv.z = cvt_pk_bf16(sc[2 * k2 + 1][0], sc[2 * k2 + 1][1]); wv.w = cvt_pk_bf16(sc[2 * k2 + 1][2], sc[2 * k2 + 1][3]); pf[k2] = __builtin_bit_cast(bf16x8, wv); }
            { const int pos = tbase + 16 * tb + r; const size_t tok = (size_t)(b * SEQ + (dir ? SEQ - 1 - pos : pos));
#pragma unroll
            for (int nd = 0; nd < 4; ++nd) { f32x4 o = (f32x4){0.f, 0.f, 0.f, 0.f}; const int cb = 64 * dh + 16 * nd + 4 * pp;
#pragma unroll
                for (int k2 = 0; k2 < 2; ++k2) o = __builtin_amdgcn_mfma_f32_16x16x32_bf16(tr8(Vs + (32 * k2 + 4 * q + qp) * HP + cb, Vs + (32 * k2 + 16 + 4 * q + qp) * HP + cb), pf[k2], o, 0, 0, 0);
#pragma unroll
                for (int ks = 0; ks < 4; ++ks) o = __builtin_amdgcn_mfma_f32_16x16x32_bf16(tr8(Sb + (32 * ks + 8 * q + qp) * HP + cb, Sb + (32 * ks + 8 * q + 4 + qp) * HP + cb), qf[ks], o, 0, 0, 0);
                *(v2u*)(OL + tok * 512 + 64 * dh + 16 * nd + 4 * q) = pack4c(o); } }
            { const float dc = dec[16 * w + r];
#pragma unroll
            for (int nd = 0; nd < 8; ++nd) { sS[nd] = sS[nd] * dc;
#pragma unroll
                for (int k2 = 0; k2 < 2; ++k2) sS[nd] = __builtin_amdgcn_mfma_f32_16x16x32_bf16(tr8(Vs + (32 * k2 + 8 * q + qp) * HP + 16 * nd + 4 * pp, Vs + (32 * k2 + 8 * q + 4 + qp) * HP + 16 * nd + 4 * pp),
                                                                                              tr8(Ke + (32 * k2 + 8 * q + qp) * HP + 16 * w + 4 * pp, Ke + (32 * k2 + 8 * q + 4 + qp) * HP + 16 * w + 4 * pp), sS[nd], 0, 0, 0); } }
            __syncthreads();
#pragma unroll
            for (int nd = 0; nd < 8; ++nd) *(LAS v2u*)(Sb + (16 * w + r) * HP + 16 * nd + 4 * q) = pack4c(sS[nd]);
        }
        float* U = (float*)(F.ws + WS_U) + (size_t)u * 16384;
#pragma unroll
        for (int nd = 0; nd < 8; ++nd) *(f32x4*)(U + (16 * w + r) * 128 + 16 * nd + 4 * q) = sS[nd];
        if (tg == 0) { f32x4 dg; dg[0] = __builtin_amdgcn_exp2f(G2[0]); dg[1] = __builtin_amdgcn_exp2f(G2[1]); dg[2] = __builtin_amdgcn_exp2f(G2[2]); dg[3] = __builtin_amdgcn_exp2f(G2[3]); *(f32x4*)((float*)(F.ws + WS_DEC) + u * 128 + 4 * d4) = dg; }
    }
    __syncthreads();
}
__device__ __forceinline__ void p_hgrn_scan(Frame& F) {
    const float* U = (const float*)(F.ws + WS_U); const float* DEC = (const float*)(F.ws + WS_DEC); bf16* SST = (bf16*)(F.ws + WS_SST);
    for (int it = F.bid * NTHR + F.tid; it < 32 * 128 * 32; it += F.G * NTHR) {
        const int cmb = it >> 12, dk = (it >> 5) & 127, dv4 = it & 31;
        f32x4 st = (f32x4){0.f, 0.f, 0.f, 0.f};
#pragma unroll 4
        for (int sg = 0; sg < NSEG; ++sg) { const size_t un = (size_t)(cmb * 16 + sg);
            v2u wv; wv.x = cvt_pk_bf16(st[0], st[1]); wv.y = cvt_pk_bf16(st[2], st[3]); *(v2u*)(SST + un * 16384 + dk * 128 + dv4 * 4) = wv;
            const float dcy = DEC[un * 128 + dk]; const f32x4 uu = *(const f32x4*)(U + un * 16384 + dk * 128 + dv4 * 4); st = st * dcy + uu; }
    }
}
__device__ __forceinline__ void p_hgrn2(Frame& F) {
    LAS bf16* Sf = (LAS bf16*)F.lds; LAS bf16* Sw = Sf + 128 * HP;
    const int lane = F.lane, r = lane & 15, q = lane >> 4, qp = (lane & 15) >> 2, pp = lane & 3;
    const bf16* SST = (const bf16*)(F.ws + WS_SST);
    for (int u = F.bid; u < 512; u += F.G) {
        const int tile = u & 31, h = (u >> 5) & 3, b = u >> 7;
        const int unf = ((b * 4 + h) * 2 + 0) * 16 + (tile >> 1), unb = ((b * 4 + h) * 2 + 1) * 16 + ((31 - tile) >> 1);
        __syncthreads();
        for (int c = F.tid; c < 128 * 16; c += NTHR) { const int dk = c >> 4, ch = c & 15;
            *(LAS v4u*)(Sf + dk * HP + ch * 8) = *(const v4u*)(SST + (size_t)unf * 16384 + dk * 128 + ch * 8);
            *(LAS v4u*)(Sw + dk * HP + ch * 8) = *(const v4u*)(SST + (size_t)unb * 16384 + dk * 128 + ch * 8); }
        __syncthreads();
        const float* ng = in_ptr(I_HNG) + h * 128;
#pragma unroll 1
        for (int mq = 0; mq < 2; ++mq) {
            const size_t tok = (size_t)(b * SEQ + tile * 256 + F.wave * 32 + 16 * mq + r);
            const bf16* qsf = (const bf16*)(F.ws + WS_QSF) + tok * 512 + h * 128 + 8 * q; const bf16* qsb = (const bf16*)(F.ws + WS_QSB) + tok * 512 + h * 128 + 8 * q;
            bf16x8 ff[4], fb[4];
#pragma unroll
            for (int ks = 0; ks < 4; ++ks) { ff[ks] = *(const bf16x8*)(qsf + 32 * ks); fb[ks] = *(const bf16x8*)(qsb + 32 * ks); }
            f32x4 o[8]; float ss = 0.f;
            const size_t rb = tok * 512 + h * 128 + 4 * q;
#pragma unroll
            for (int nd = 0; nd < 8; ++nd) { f32x4 a = (f32x4){0.f, 0.f, 0.f, 0.f}; const int cb = 16 * nd + 4 * pp;
#pragma unroll
                for (int ks = 0; ks < 4; ++ks) { a = __builtin_amdgcn_mfma_f32_16x16x32_bf16(tr8(Sf + (32 * ks + 8 * q + qp) * HP + cb, Sf + (32 * ks + 8 * q + 4 + qp) * HP + cb), ff[ks], a, 0, 0, 0);
                    a = __builtin_amdgcn_mfma_f32_16x16x32_bf16(tr8(Sw + (32 * ks + 8 * q + qp) * HP + cb, Sw + (32 * ks + 8 * q + 4 + qp) * HP + cb), fb[ks], a, 0, 0, 0); }
                const v2u lf = *(const v2u*)((const bf16*)(F.ws + WS_OLF) + rb + 16 * nd), lw = *(const v2u*)((const bf16*)(F.ws + WS_OLB) + rb + 16 * nd);
                a[0] += bflo(lf.x) + bflo(lw.x); a[1] += bfhi(lf.x) + bfhi(lw.x); a[2] += bflo(lf.y) + bflo(lw.y); a[3] += bfhi(lf.y) + bfhi(lw.y);
                ss += (a[0] * a[0] + a[1] * a[1]) + (a[2] * a[2] + a[3] * a[3]); o[nd] = a; }
            ss += __shfl_xor(ss, 16); ss += __shfl_xor(ss, 32);
            const float rs = 1.0f / sqrtf(ss * (1.0f / 128.0f) + LN_EPS);
#pragma unroll
            for (int nd = 0; nd < 8; ++nd) { const f32x4 gn = *(const f32x4*)(ng + 16 * nd + 4 * q); const v2u gw = *(const v2u*)((const bf16*)(F.ws + WS_Q + 4 * SEC_STRIDE) + rb + 16 * nd);
                f32x4 y; y[0] = o[nd][0] * rs * gn[0] * bflo(gw.x); y[1] = o[nd][1] * rs * gn[1] * bfhi(gw.x); y[2] = o[nd][2] * rs * gn[2] * bflo(gw.y); y[3] = o[nd][3] * rs * gn[3] * bfhi(gw.y);
                v2u wv; wv.x = cvt_pk_bf16(y[0], y[1]); wv.y = cvt_pk_bf16(y[2], y[3]); *(v2u*)((bf16*)(F.ws + WS_MIX) + (size_t)T * 512 + rb + 16 * nd) = wv; }
        }
    }
    __syncthreads();
}
struct Args { const float* in[29]; float* out; unsigned char* ws; };
__global__ void __launch_bounds__(NTHR, 2) fwd(Args args) {
    extern __shared__ __attribute__((aligned(16))) unsigned char lds[];
    Frame F;
    F.lds = (LAS unsigned char*)lds;
    F.tid = threadIdx.x; F.lane = F.tid & 63; F.wave = __builtin_amdgcn_readfirstlane(F.tid >> 6);
    F.G = gridDim.x; F.bid = blockIdx.x;
    F.ws = args.ws; F.ctl = (unsigned*)(args.ws + WS_CTL); F.out = args.out;
    if (F.tid < 64) ((LAS unsigned*)(F.lds + LDSCTL_OFF))[F.tid] = 0u;
    __syncthreads();
    XcdBarrier bar = xcd_barrier_post(F.ctl + CW_BAR, (volatile LAS unsigned*)(F.lds + LDSCTL_OFF + 32));
#define GRID_BAR(d0, d1, g0, g1) do { gbar_arrive(bar); conv_slice(F, d0, d1, g0, g1); gbar_wait(bar); } while (0)
#ifndef DUP
#define DUP 0
#endif
#define PH(id, call) do { call; if (DUP == (id)) { __syncthreads(); call; } } while (0)
    PH(1, p0_prologue(F));
    GRID_BAR(0, 2, 0, 0);
    PH(2, p_proj(F));
    PH(3, p_kv(F));
    GRID_BAR(2, 4, 0, 0);
    PH(4, p_xattn(F));
    PH(5, p_dft<1>(F));
    PH(6, p_hgrn1(F));
    GRID_BAR(4, 6, 0, 0);
    PH(7, p_dft<3>(F));
    PH(8, p_hgrn_scan(F));
    GRID_BAR(6, 8, 0, 0);
    PH(9, p_hgrn2(F));
    GRID_BAR(8, 10, 0, 0);
    PH(10, p_branch(F));
    GRID_BAR(10, 12, 0, 0);
    PH(11, p_wout(F));
    GRID_BAR(12, 13, 0, 3);
    PH(12, p_ln1(F));
    conv_slice(F, 16, 16, 12, -1);
    GRID_BAR(13, 14, 3, 6);
    PH(14, p_router_shared(F));
    GRID_BAR(14, 15, 6, 9);
    p_routing(F);
    GRID_BAR(15, 16, 9, 12);
    PH(16, p_fill(F));
    PH(17, p_shared_down(F));
    GRID_BAR(16, -1, 0, 0);
    PH(18, p_exp_gu(F));
    GRID_BAR(0, 0, 0, 0);
    PH(19, p_exp_down(F));
    PH(30, GRID_BAR(0, 0, 0, 0));
    PH(20, p_final<true>(F));
}

extern "C" void kernel_launch(void* const* d_in, const int* in_sizes, int n_in, void* d_out, int out_size, void* d_ws, size_t ws_size, hipStream_t stream) {
    static int grid = 0;
    if (grid == 0) {
        int dev = 0, cus = 0, per_cu = 0;
        if (n_in != 29 || ws_size < WS_END) { fprintf(stderr, "kernel_launch: unexpected n_in %d / ws_size %zu\n", n_in, ws_size); }
        if (hipGetDevice(&dev) != hipSuccess || hipDeviceGetAttribute(&cus, hipDeviceAttributeMultiprocessorCount, dev) != hipSuccess) { grid = -1; return; }
        if (hipFuncSetAttribute((const void*)fwd, hipFuncAttributeMaxDynamicSharedMemorySize, LDS_BYTES) != hipSuccess) { grid = -1; return; }
        if (hipOccupancyMaxActiveBlocksPerMultiprocessor(&per_cu, (const void*)fwd, NTHR, LDS_BYTES) != hipSuccess || per_cu < 1) fprintf(stderr, "kernel_launch: occupancy query says %d\n", per_cu);
        (void)hipGetLastError();
        grid = cus;
    }
    if (grid < 0) return;
    (void)hipMemsetAsync((char*)d_ws + WS_CTL, 0, CTL_ZERO_BYTES, stream);
    Args a{};
    for (int i = 0; i < 29; ++i) a.in[i] = (const float*)d_in[i];
    a.out = (float*)d_out; a.ws = (unsigned char*)d_ws;
    hipLaunchKernelGGL(fwd, dim3(grid), dim3(NTHR), LDS_BYTES, stream, a);
}
```

```cpp
#define DUP 0
#include <hip/hip_runtime.h>
#include <cstdio>
#include <cstdint>

#define GAS __attribute__((address_space(1)))
#define LAS __attribute__((address_space(3)))
typedef unsigned short bf16;
typedef unsigned v4u __attribute__((ext_vector_type(4)));
typedef unsigned v2u __attribute__((ext_vector_type(2)));
typedef float f32x4 __attribute__((ext_vector_type(4)));
typedef float f32x2 __attribute__((ext_vector_type(2)));
typedef short bf16x8 __attribute__((ext_vector_type(8)));
typedef short s16x4 __attribute__((ext_vector_type(4)));

constexpr int NB = 4, SEQ = 8192, D = 1024, T = NB * SEQ, MEM = 256;
constexpr int NPROJ = 7168;
constexpr int NE = 256, TOPK = 8, FF = 256;
constexpr float LN_EPS = 1e-5f;
constexpr float YSCALE = 128.f;
constexpr float ALPHA = 1.189207115002721f;
constexpr int NWAVES = 8, NTHR = 512;
constexpr int SEG = 512, NSEG = SEQ / SEG, CH = 64;

constexpr size_t MiB = 1u << 20;
constexpr size_t WS_CTL = 0, CTL_ZERO_BYTES = 1 * MiB;
constexpr size_t WS_WIN = 1 * MiB;
constexpr size_t WS_WKV = 15 * MiB;
constexpr size_t WS_WFO = 17 * MiB;
constexpr size_t WS_WHO = 18 * MiB;
constexpr size_t WS_WXO = 19 * MiB;
constexpr size_t WS_WOUT = 20 * MiB;
constexpr size_t WS_WRS = 22 * MiB;
constexpr size_t WS_WSD = 24 * MiB;
constexpr size_t WS_A1 = 25 * MiB;
constexpr size_t WS_A3 = 26 * MiB;
constexpr size_t WS_MEMN = 30 * MiB;
constexpr size_t WS_H0 = 32 * MiB;
constexpr size_t WS_F = 96 * MiB;
constexpr size_t WS_MERGED = 96 * MiB;
constexpr size_t WS_WBR = 17 * MiB;
constexpr size_t WS_Q = 160 * MiB;
constexpr size_t SEC_STRIDE = 32 * MiB;
constexpr size_t WS_GATES = 352 * MiB;
constexpr size_t WS_KV = 544 * MiB;
constexpr size_t WS_Y = 546 * MiB;
constexpr size_t WS_MIX = 610 * MiB;
constexpr size_t WS_OLF = 706 * MiB, WS_OLB = 738 * MiB;
constexpr size_t WS_QSF = 770 * MiB, WS_QSB = 802 * MiB;
constexpr size_t WS_U = 834 * MiB;
constexpr size_t WS_DEC = 866 * MiB;
constexpr size_t WS_SST = 867 * MiB;
constexpr size_t WS_EXPD = 883 * MiB;
constexpr size_t WS_LOGIT = 32 * MiB;
constexpr size_t WS_HS = 64 * MiB;
constexpr size_t WS_ROUTE = 80 * MiB;
constexpr size_t WS_S2 = 96 * MiB;
constexpr size_t WS_S1 = 160 * MiB;
constexpr size_t WS_HACT = 160 * MiB;
constexpr size_t WS_EXPGU = 546 * MiB;
constexpr size_t WS_YR = 546 * MiB;
constexpr size_t WS_H1 = 802 * MiB;
constexpr size_t WS_END = 1024 * MiB;
constexpr size_t RT_EIDX = 0, RT_WGT = 1 * MiB, RT_POS = 2 * MiB, RT_ROWTOK = 3 * MiB, RT_ROWSLOT = 5 * MiB, RT_ROWGATE = 6 * MiB + 512 * 1024, RT_TRASH = 7 * MiB + 768 * 1024;
constexpr int RPAD_MAX = T * TOPK + NE * 255;
constexpr int CW_BAR = 4096;
constexpr int CW_CNT = 16384;

#define LDS_WAIT() asm volatile("s_waitcnt lgkmcnt(0)" ::: "memory")
#define VM_WAIT() asm volatile("s_waitcnt vmcnt(0)" ::: "memory")
typedef __bf16 bf16x2v __attribute__((ext_vector_type(2)));
__device__ __forceinline__ unsigned cvt_pk_bf16_c(float lo, float hi) { const f32x2 v = {lo, hi}; const bf16x2v b = __builtin_convertvector(v, bf16x2v); return __builtin_bit_cast(unsigned, b); }
__device__ __forceinline__ unsigned cvt_pk_bf16(float lo, float hi) { unsigned r; asm volatile("v_cvt_pk_bf16_f32 %0, %1, %2" : "=v"(r) : "v"(lo), "v"(hi)); return r; }
__device__ __forceinline__ float bflo(unsigned w) { return __uint_as_float(w << 16); }
__device__ __forceinline__ float bfhi(unsigned w) { return __uint_as_float(w & 0xffff0000u); }
__device__ __forceinline__ float bf2f(bf16 h) { return __uint_as_float(((unsigned)h) << 16); }
__device__ __forceinline__ bf16 f2bf(float f) { return (bf16)(cvt_pk_bf16(f, 0.f) & 0xffffu); }
__device__ __forceinline__ float sigmoidf_(float x) { return __builtin_amdgcn_rcpf(1.0f + __builtin_amdgcn_exp2f(-1.4426950408889634f * x)); }
__device__ __forceinline__ float siluf_(float x) { return x * __builtin_amdgcn_rcpf(1.0f + __builtin_amdgcn_exp2f(-1.4426950408889634f * x)); }
__device__ __forceinline__ float wave_sum(float v) {
#pragma unroll
    for (int o = 1; o < 64; o <<= 1) v += __shfl_xor(v, o);
    return v;
}

#define XB_TMO      128
#define XB_XCNT(j)  (256  + 64 * (j))
#define XB_XSUB(j)  (1280 + 64 * (j))
#define XB_XGEN(j)  (2304 + 64 * (j))
#define XB_TOP      3328
#define XB_TOPGEN   3392
#define XCD_BAR_WORDS 3456
#define XB_SPIN_CAP (1u << 22)
__device__ __forceinline__ unsigned xb_ld(unsigned* p)              { return __hip_atomic_load(p, __ATOMIC_RELAXED, __HIP_MEMORY_SCOPE_AGENT); }
__device__ __forceinline__ unsigned xb_add(unsigned* p, unsigned v) { return __hip_atomic_fetch_add(p, v, __ATOMIC_RELAXED, __HIP_MEMORY_SCOPE_AGENT); }
__device__ __forceinline__ unsigned xb_xcc_id() { return (unsigned)__builtin_amdgcn_s_getreg((3 << 11) | 20) & 0xFu; }
#define XB_SPIN(cond, bar) do { unsigned _sp = 0; while (cond) { __builtin_amdgcn_s_sleep(1); \
    if ((++_sp & 255u) == 0u) { if (xb_ld(&(bar)[XB_TMO])) break; if (_sp > XB_SPIN_CAP) { atomicAdd(&(bar)[XB_TMO], 1u); break; } } } } while (0)
struct XcdBarrier { unsigned* bar; unsigned x; volatile LAS unsigned* st; };
__device__ __forceinline__ XcdBarrier xcd_barrier_post(unsigned* bar, volatile LAS unsigned* st) {
    XcdBarrier b; b.bar = bar; b.x = xb_xcc_id(); b.st = st;
    if (threadIdx.x == 0) (void)xb_add(&bar[XB_XCNT(b.x)], 1u);
    return b;
}
__device__ __forceinline__ void xcd_barrier_complete(unsigned* bar, unsigned x, unsigned& nloc, unsigned& nx) {
    const unsigned G = gridDim.x * gridDim.y * gridDim.z;
    unsigned sum, cnt, mine, sp = 0u;
    for (;;) {
        sum = 0u; cnt = 0u; mine = 0u;
#pragma unroll
        for (unsigned j = 0; j < 16; ++j) { const unsigned c = xb_ld(&bar[XB_XCNT(j)]); sum += c; cnt += (c > 0u) ? 1u : 0u; mine = (j == x) ? c : mine; }
        if (sum == G) break;
        __builtin_amdgcn_s_sleep(1);
        if ((++sp & 255u) == 0u) { if (xb_ld(&bar[XB_TMO])) break; if (sp > XB_SPIN_CAP) { atomicAdd(&bar[XB_TMO], 1u); break; } }
    }
    nloc = mine > 0u ? mine : 1u; nx = cnt > 0u ? cnt : 1u;
}
__device__ __forceinline__ void xcd_barrier(const XcdBarrier& b) {
    asm volatile("s_waitcnt vmcnt(0)" ::: "memory");
    __syncthreads();
    if (threadIdx.x == 0) {
        unsigned* bar = b.bar;
        __builtin_amdgcn_s_waitcnt(0);
        unsigned nloc = b.st[0], nx = b.st[1];
        if (nloc == 0u) { xcd_barrier_complete(bar, b.x, nloc, nx); b.st[0] = nloc; b.st[1] = nx; }
        const unsigned old = xb_add(&bar[XB_XSUB(b.x)], 1u);
        const unsigned gen = old / nloc;
        if (old + 1u == (gen + 1u) * nloc) {
            __builtin_amdgcn_fence(__ATOMIC_RELEASE, "agent");
            asm volatile("s_waitcnt vmcnt(0)" ::: "memory");
            const unsigned og = xb_add(&bar[XB_TOP], 1u);
            const unsigned tg = og / nx;
            if (og + 1u == (tg + 1u) * nx) xb_add(&bar[XB_TOPGEN], 1u);
            else XB_SPIN(xb_ld(&bar[XB_TOPGEN]) == tg, bar);
            __builtin_amdgcn_fence(__ATOMIC_ACQUIRE, "agent");
            xb_add(&bar[XB_XGEN(b.x)], 1u);
            asm volatile("s_waitcnt vmcnt(0)" ::: "memory");
        } else {
            XB_SPIN(xb_ld(&bar[XB_XGEN(b.x)]) == gen, bar);
            __builtin_amdgcn_fence(__ATOMIC_ACQUIRE, "agent");
            asm volatile("s_waitcnt vmcnt(0)" ::: "memory");
        }
    }
    __syncthreads();
}

namespace pg8 {
constexpr int BM = 256, BK = 64, HALF = 128, HTB = HALF * BK * 2, STAGE_BYTES = 8 * HTB, NXCD = 8, WGM = 8;
__host__ __device__ __forceinline__ int lds_byte(int r, int c) { const int st = (r >> 4) * 2 + (c >> 5), rr = r & 15, cc = c & 31, ob = rr * 64 + cc * 2; return st * 1024 + (ob ^ (((ob >> 9) & 1) << 5)); }
__host__ __device__ __forceinline__ void stage_rc(int b, int& R, int& C) { const int st = b / 1024, sb = b % 1024, swz = sb ^ (((sb >> 9) & 1) << 5); R = (st >> 1) * 16 + swz / 64; C = (st & 1) * 32 + (swz % 64) / 2; }
__host__ __device__ __forceinline__ int perm32(int rho) { const int n = rho >> 4, i = rho & 15; return 8 * (i >> 2) + 4 * n + (i & 3); }
struct Unit { int pm, pn; };
struct Gemm { const bf16* A; const bf16* Bt; int K; };
struct StaticOrder {
    int nM, nN, nwg, G, c;
    __device__ void init(int M, int N, int G_, int c_) { nM = M / BM; nN = N / BM; nwg = nM * nN; G = G_; c = c_; }
    __device__ bool next(int i, Unit& u) const {
        const long L = (long)i * G + c; if (L >= nwg) return false;
        int wgid = (int)L; { const int q = nwg / NXCD, r = nwg % NXCD, xcd = wgid % NXCD, off = wgid / NXCD; wgid = (xcd < r ? xcd * (q + 1) : r * (q + 1) + (xcd - r) * q) + off; }
        const int nig = WGM * nN, gid = wgid / nig, fm = gid * WGM, gsz = (nM - fm) < WGM ? (nM - fm) : WGM;
        u.pm = fm + ((wgid % nig) % gsz); u.pn = (wgid % nig) / gsz; return true;
    }
};
template <int J> struct ExpertOrder {
    int nunits, G, c; const LAS unsigned short* te;
    __device__ bool next(int i, Unit& u) const {
        const int nb = G >> 3, tpx = nb / J, x = c & 7, k = c >> 3;
        int tau, j;
        if ((G & 7) == 0 && tpx * J == nb) { tau = (i * 8 + x) * tpx + k / J; j = k % J; }
        else { const int L = i * G + c; tau = L / J; j = L - tau * J; }
        if (tau * J + j >= nunits) return false;
        u.pm = tau; u.pn = (int)te[tau] * J + j; return true;
    }
};
template <class Epi, class Sched, bool GATHER>
__device__ __forceinline__ void gemm_phase(LAS unsigned char* lds, const Gemm g, const Sched& S, const Epi& E, const int* rowidx) {
    int tid_ = threadIdx.x; asm volatile("" : "+v"(tid_));
    const int tid = tid_, wid = __builtin_amdgcn_readfirstlane(tid >> 6), lane = tid & 63, wr = wid >> 2, wc = wid & 3, fr = lane & 15, fq = lane >> 4;
    const int K = g.K, nt = K / BK;
    unsigned voffB[2], voffC[2][2];
    LAS v4u* gsl = (LAS v4u*)(lds + STAGE_BYTES + 8192) + tid;
    const size_t kstep = (size_t)(BK * 2);
    const size_t hstep = (size_t)HALF * K * 2;
    const size_t tstep = 2 * hstep;
#pragma unroll
    for (int i = 0; i < 2; ++i) { int R, C; stage_rc(tid * 16 + i * 8192, R, C); const int Rb = Epi::PERM ? ((R & ~31) + perm32(R & 31)) : R;
        voffB[i] = (unsigned)(Rb * K + C) * 2u; voffC[0][i] = (unsigned)(R * K + C) * 2u; voffC[1][i] = voffC[0][i] + (unsigned)hstep; }
    const unsigned ldsw = (unsigned)wid * 1024u;
    const int aoff = lds_byte(wr * 64 + fr, fq * 8), boff = lds_byte(wc * 32 + fr, fq * 8);
#define PG8_SA(b, h) (((b) * 2 + (h)) * HTB)
#define PG8_SB(b, h) ((4 + (b) * 2 + (h)) * HTB)
#define PG8_STAGE(bufoff, gbase, voff) do { const char* _gb = (const char*)(gbase); _Pragma("unroll") for (int _i = 0; _i < 2; ++_i) { unsigned _keep; \
        asm volatile("s_mov_b32 %0, m0\n\ts_mov_b32 m0, %3\n\ts_nop 0\n\tglobal_load_lds_dwordx4 %1, %2\n\ts_mov_b32 m0, %0" : "=&s"(_keep) : "v"((voff)[_i]), "s"(_gb), "s"((unsigned)(size_t)(lds + (bufoff) + ldsw + _i * 8192)) : "memory"); } } while (0)
#define PG8_LDA(dst, b, h) do { _Pragma("unroll") for (int m = 0; m < 4; ++m) _Pragma("unroll") for (int k = 0; k < 2; ++k) dst[m][k] = *(const LAS bf16x8*)(lds + PG8_SA(b, h) + aoff + m * 2048 + k * 1024); } while (0)
#define PG8_LDB(dst, b, h) do { _Pragma("unroll") for (int n = 0; n < 2; ++n) _Pragma("unroll") for (int k = 0; k < 2; ++k) dst[n][k] = *(const LAS bf16x8*)(lds + PG8_SB(b, h) + boff + n * 2048 + k * 1024); } while (0)
#define PG8_MMA(ai, bj, At, Bt) do { __builtin_amdgcn_s_setprio(1); _Pragma("unroll") for (int m = 0; m < 4; ++m) _Pragma("unroll") for (int n = 0; n < 2; ++n) _Pragma("unroll") for (int k = 0; k < 2; ++k) \
        acc[ai][bj][m][n] = __builtin_amdgcn_mfma_f32_16x16x32_bf16(Bt[n][k], At[m][k], acc[ai][bj][m][n], 0, 0, 0); __builtin_amdgcn_s_setprio(0); } while (0)
#define PG8_WAIT_V(n) asm volatile("s_waitcnt vmcnt(" #n ")" ::: "memory")
#define PG8_WAIT_L(n) asm volatile("s_waitcnt lgkmcnt(" #n ")" ::: "memory")
#define PG8_BAR __builtin_amdgcn_s_barrier()
#define PG8_SCHED __builtin_amdgcn_sched_barrier(0)
#define PG8_GSTORE(set, u) do { unsigned _v[2][2]; _Pragma("unroll") for (int _i = 0; _i < 2; ++_i) { int _R, _C; stage_rc(tid * 16 + _i * 8192, _R, _C); \
        _Pragma("unroll") for (int _h = 0; _h < 2; ++_h) _v[_h][_i] = ((unsigned)rowidx[(u).pm * BM + _h * HALF + _R] * (unsigned)K + (unsigned)_C) * 2u; } \
        gsl[(set) * 512] = (v4u){_v[0][0], _v[0][1], _v[1][0], _v[1][1]}; } while (0)
#define PG8_GRD(dst, h, set) unsigned dst[2]; do { if constexpr (GATHER) { const v2u _o = ((const LAS v2u*)(gsl + (set) * 512))[h]; dst[0] = _o.x; dst[1] = _o.y; } else { dst[0] = voffC[h][0]; dst[1] = voffC[h][1]; } } while (0)
    Unit cur, nxt; int ui = 0;
    if (!S.next(0, cur)) return;
    f32x4 acc[2][2][4][2];
#pragma unroll
    for (int a = 0; a < 2; ++a)
#pragma unroll
        for (int b = 0; b < 2; ++b)
#pragma unroll
            for (int m = 0; m < 4; ++m)
#pragma unroll
                for (int n = 0; n < 2; ++n) acc[a][b][m][n] = (f32x4){0.f, 0.f, 0.f, 0.f};
    bf16x8 At[4][2], B0[2][2], B1[2][2];
    const char* cA = GATHER ? (const char*)g.A : (const char*)g.A + (size_t)cur.pm * tstep; const char* cB = (const char*)g.Bt + (size_t)cur.pn * tstep;
    int par = 0;
    LAS v2u* const rib = (LAS v2u*)(lds + STAGE_BYTES + 2560);
    if constexpr (GATHER) { PG8_GSTORE(0, cur); }
    if constexpr (Epi::PRE) E.pre(cur, rib, tid);
    { PG8_GRD(p0, 0, 0); PG8_GRD(p1, 1, 0);
    PG8_STAGE(PG8_SB(0, 0), cB, voffB); PG8_STAGE(PG8_SB(0, 1), cB + hstep, voffB); PG8_STAGE(PG8_SA(0, 0), cA, p0); PG8_STAGE(PG8_SA(0, 1), cA, p1);
    if (wr == 1) PG8_BAR;
    PG8_WAIT_V(2); PG8_BAR;
    PG8_STAGE(PG8_SB(1, 0), cB + kstep, voffB); PG8_STAGE(PG8_SA(1, 0), cA + kstep, p0); PG8_STAGE(PG8_SB(1, 1), cB + hstep + kstep, voffB); }
    PG8_WAIT_V(6); PG8_BAR;
    for (;;) {
        const bool has_next = S.next(ui + 1, nxt);
        const char* nA = GATHER ? (const char*)g.A : (has_next ? (const char*)g.A + (size_t)nxt.pm * tstep : cA); const char* nB = has_next ? (const char*)g.Bt + (size_t)nxt.pn * tstep : cB;
        if constexpr (GATHER) { if (has_next) { PG8_GSTORE(par ^ 1, nxt); } else { gsl[(par ^ 1) * 512] = gsl[par * 512]; } }
        for (int t = 0; t < nt; t += 2) {
            const bool last = (t == nt - 2);
            const char* a1 = cA + (size_t)(t + 1) * kstep;
            const char* a2 = last ? nA : cA + (size_t)(t + 2) * kstep; const char* b2 = last ? nB : cB + (size_t)(t + 2) * kstep;
            const char* a3 = a2 + kstep; const char* b3 = b2 + kstep;
            const int s2 = (GATHER && last) ? (par ^ 1) : par;
            { PG8_GRD(o, 1, par); PG8_LDB(B0, 0, 0); PG8_LDB(B1, 0, 1); PG8_SCHED; PG8_LDA(At, 0, 0); PG8_STAGE(PG8_SA(1, 1), a1, o); }
            PG8_WAIT_V(8); PG8_WAIT_L(0); PG8_BAR; PG8_MMA(0, 0, At, B0); PG8_MMA(0, 1, At, B1); PG8_BAR; PG8_SCHED;
            { PG8_GRD(o, 0, s2); PG8_LDA(At, 0, 1); PG8_STAGE(PG8_SB(0, 0), b2, voffB); PG8_STAGE(PG8_SB(0, 1), b2 + hstep, voffB); PG8_STAGE(PG8_SA(0, 0), a2, o); }
            PG8_WAIT_V(8); PG8_WAIT_L(0); PG8_BAR; PG8_MMA(1, 0, At, B0); PG8_MMA(1, 1, At, B1); PG8_BAR; PG8_SCHED;
            { PG8_GRD(o, 1, s2); PG8_LDB(B0, 1, 0); PG8_LDB(B1, 1, 1); PG8_SCHED; PG8_LDA(At, 1, 0); PG8_STAGE(PG8_SA(0, 1), a2, o); }
            PG8_WAIT_V(8); PG8_WAIT_L(0); PG8_BAR; PG8_MMA(0, 0, At, B0); PG8_MMA(0, 1, At, B1); PG8_BAR; PG8_SCHED;
            { PG8_GRD(o, 0, s2); PG8_LDA(At, 1, 1); PG8_STAGE(PG8_SB(1, 0), b3, voffB); PG8_STAGE(PG8_SB(1, 1), b3 + hstep, voffB); PG8_STAGE(PG8_SA(1, 0), a3, o); }
            PG8_WAIT_V(8); PG8_WAIT_L(0); PG8_BAR; PG8_MMA(1, 0, At, B0); PG8_MMA(1, 1, At, B1); PG8_BAR; PG8_SCHED;
        }
        if (wr == 0) PG8_BAR;
        asm volatile("s_nop 15\n\ts_nop 15" ::: "memory");
        if constexpr (Epi::PRE) E(acc, cur, wr, wc, fr, fq, rib + par * 256); else E(acc, cur, wr, wc, fr, fq);
        if (!has_next) break;
        bool zero = true;
        if constexpr (Epi::CHAIN) zero = !E.keep(cur);
        if (zero) {
#pragma unroll
        for (int a = 0; a < 2; ++a)
#pragma unroll
            for (int b = 0; b < 2; ++b)
#pragma unroll
                for (int m = 0; m < 4; ++m)
#pragma unroll
                    for (int n = 0; n < 2; ++n) acc[a][b][m][n] = (f32x4){0.f, 0.f, 0.f, 0.f};
        }
        cur = nxt; cA = nA; cB = nB; ++ui; par ^= 1;
        if constexpr (Epi::PRE) E.pre(cur, rib + par * 256, tid);
        if (wr == 1) PG8_BAR;
    }
    PG8_WAIT_V(0);
    PG8_BAR;
#undef PG8_SA
#undef PG8_SB
#undef PG8_STAGE
#undef PG8_LDA
#undef PG8_LDB
#undef PG8_MMA
#undef PG8_WAIT_V
#undef PG8_WAIT_L
#undef PG8_BAR
#undef PG8_SCHED
#undef PG8_GSTORE
#undef PG8_GRD
}
}
using pg8::Unit;

typedef f32x4 AccT[2][2][4][2];
__device__ __forceinline__ v4u pack8(const f32x4 a, const f32x4 b) { v4u w; w.x = cvt_pk_bf16(a[0], a[1]); w.y = cvt_pk_bf16(a[2], a[3]); w.z = cvt_pk_bf16(b[0], b[1]); w.w = cvt_pk_bf16(b[2], b[3]); return w; }

struct EpiProj {
    static constexpr bool PERM = true, PRE = false, CHAIN = false;
    bf16* F; bf16* SEC; bf16* GATES; const float* bgate;
    __device__ __forceinline__ void operator()(const AccT& acc, const Unit& u, int wr, int wc, int fr, int fq) const {
        const int pn = u.pn; bf16* base; int ldc, colt, mode;
        if (pn < 4) { base = F; ldc = 1024; colt = pn * 256; mode = 0; }
        else if (pn < 16) { const int s = (pn - 4) >> 1; base = SEC + (size_t)s * (SEC_STRIDE / 2); ldc = 512; colt = ((pn - 4) & 1) * 256; mode = (s == 0 || s == 4) ? 1 : (s == 5 ? 3 : 0); }
        else { base = GATES; ldc = 3072; colt = (pn - 16) * 256; mode = 2; }
        const int row0 = u.pm * 256 + wr * 64 + fr, col0 = colt + wc * 32 + 8 * fq;
        f32x4 bv[2][2];
#pragma unroll
        for (int bj = 0; bj < 2; ++bj)
#pragma unroll
            for (int n = 0; n < 2; ++n) bv[bj][n] = (mode == 2) ? *(const f32x4*)(bgate + col0 + bj * 128 + 4 * n) : (f32x4){0.f, 0.f, 0.f, 0.f};
#pragma unroll
        for (int ai = 0; ai < 2; ++ai)
#pragma unroll
            for (int m = 0; m < 4; ++m) { bf16* rowp = base + (size_t)(row0 + ai * 128 + m * 16) * ldc + col0;
#pragma unroll
                for (int bj = 0; bj < 2; ++bj) { f32x4 v0 = acc[ai][bj][m][0] + bv[bj][0], v1 = acc[ai][bj][m][1] + bv[bj][1];
                    if (mode == 1) {
#pragma unroll
                        for (int j = 0; j < 4; ++j) { v0[j] = siluf_(v0[j]); v1[j] = siluf_(v1[j]); } }
                    else if (mode == 2) {
#pragma unroll
                        for (int j = 0; j < 4; ++j) { v0[j] = sigmoidf_(v0[j]); v1[j] = sigmoidf_(v1[j]); } }
                    else if (mode == 3) { v0 = v0 * 0.12751743f; v1 = v1 * 0.12751743f; }
                    *(v4u*)(rowp + bj * 128) = pack8(v0, v1); } }
    }
};
struct EpiPlain {
    static constexpr bool PERM = true, PRE = false, CHAIN = false;
    bf16* O; int ldc;
    __device__ __forceinline__ void operator()(const AccT& acc, const Unit& u, int wr, int wc, int fr, int fq) const {
        const int row0 = u.pm * 256 + wr * 64 + fr, col0 = u.pn * 256 + wc * 32 + 8 * fq;
#pragma unroll
        for (int ai = 0; ai < 2; ++ai)
#pragma unroll
            for (int m = 0; m < 4; ++m) { bf16* rowp = O + (size_t)(row0 + ai * 128 + m * 16) * ldc + col0;
#pragma unroll
                for (int bj = 0; bj < 2; ++bj) *(v4u*)(rowp + bj * 128) = pack8(acc[ai][bj][m][0], acc[ai][bj][m][1]); }
    }
};
struct EpiMix {
    static constexpr bool PERM = true, PRE = false, CHAIN = true;
    bf16* M; const bf16* gates; const float* bias;
    static __device__ __forceinline__ float rt(float n, float d) { return fmaxf(n, 1e-7f) * __builtin_amdgcn_rcpf(fmaxf(d, 1e-7f)); }
    __device__ __forceinline__ bool keep(const Unit& u) const { return (u.pn >> 2) < 2; }
    __device__ __forceinline__ void operator()(AccT& acc, const Unit& u, int wr, int wc, int fr, int fq) const {
        const int s = u.pn >> 2, row0 = (u.pm & 127) * 256 + wr * 64 + fr, col0 = (u.pn & 3) * 256 + wc * 32 + 8 * fq;
        if (s < 2) {
#pragma unroll
            for (int bj = 0; bj < 2; ++bj) {
                f32x4 b0 = (f32x4){0.f, 0.f, 0.f, 0.f}, b1 = b0;
                if (s == 0) { b0 = *(const f32x4*)(bias + col0 + bj * 128); b1 = *(const f32x4*)(bias + col0 + bj * 128 + 4); }
#pragma unroll
                for (int ai = 0; ai < 2; ++ai)
#pragma unroll
                    for (int m = 0; m < 4; ++m) { const bf16* gp = gates + (size_t)(row0 + ai * 128 + m * 16) * 3072 + s * 1024 + col0 + bj * 128;
                        const v4u gn = *(const v4u*)gp, gd = *(const v4u*)(gp + 1024);
                        f32x4 r0, r1;
                        r0[0] = rt(bflo(gn.x), bflo(gd.x)); r0[1] = rt(bfhi(gn.x), bfhi(gd.x)); r0[2] = rt(bflo(gn.y), bflo(gd.y)); r0[3] = rt(bfhi(gn.y), bfhi(gd.y));
                        r1[0] = rt(bflo(gn.z), bflo(gd.z)); r1[1] = rt(bfhi(gn.z), bfhi(gd.z)); r1[2] = rt(bflo(gn.w), bflo(gd.w)); r1[3] = rt(bfhi(gn.w), bfhi(gd.w));
                        acc[ai][bj][m][0] = (acc[ai][bj][m][0] + b0) * r0; acc[ai][bj][m][1] = (acc[ai][bj][m][1] + b1) * r1;
                        asm volatile("" ::: "memory"); }
            }
        } else {
#pragma unroll
            for (int ai = 0; ai < 2; ++ai)
#pragma unroll
                for (int m = 0; m < 4; ++m) { const size_t row = (size_t)(row0 + ai * 128 + m * 16);
#pragma unroll
                    for (int bj = 0; bj < 2; ++bj) { const v4u gw = *(const v4u*)(gates + row * 3072 + 2048 + col0 + bj * 128);
                        const f32x4 v0 = acc[ai][bj][m][0], v1 = acc[ai][bj][m][1]; f32x4 o0, o1;
                        o0[0] = fmaxf(bflo(gw.x), 1e-7f) * v0[0]; o0[1] = fmaxf(bfhi(gw.x), 1e-7f) * v0[1]; o0[2] = fmaxf(bflo(gw.y), 1e-7f) * v0[2]; o0[3] = fmaxf(bfhi(gw.y), 1e-7f) * v0[3];
                        o1[0] = fmaxf(bflo(gw.z), 1e-7f) * v1[0]; o1[1] = fmaxf(bfhi(gw.z), 1e-7f) * v1[1]; o1[2] = fmaxf(bflo(gw.w), 1e-7f) * v1[2]; o1[3] = fmaxf(bfhi(gw.w), 1e-7f) * v1[3];
                        *(v4u*)(M + row * 1024 + col0 + bj * 128) = pack8(o0, o1); } }
        }
    }
};
struct ChainOrder {
    pg8::StaticOrder S;
    __device__ bool next(int i, Unit& u) const { const int ti = i / 3, s = i - 3 * ti; if (!S.next(ti, u)) return false; u.pm += 128 * s; u.pn += 4 * s; return true; }
};
struct EpiResid {
    static constexpr bool PERM = true, PRE = false, CHAIN = false;
    bf16* O; const bf16* R;
    __device__ __forceinline__ void operator()(const AccT& acc, const Unit& u, int wr, int wc, int fr, int fq) const {
        const int row0 = u.pm * 256 + wr * 64 + fr, col0 = u.pn * 256 + wc * 32 + 8 * fq;
#pragma unroll
        for (int ai = 0; ai < 2; ++ai)
#pragma unroll
            for (int m = 0; m < 4; ++m) { const size_t off = (size_t)(row0 + ai * 128 + m * 16) * 1024 + col0;
#pragma unroll
                for (int bj = 0; bj < 2; ++bj) { const v4u rw = *(const v4u*)(R + off + bj * 128);
                    f32x4 o0 = acc[ai][bj][m][0], o1 = acc[ai][bj][m][1];
                    o0[0] += ALPHA * bflo(rw.x); o0[1] += ALPHA * bfhi(rw.x); o0[2] += ALPHA * bflo(rw.y); o0[3] += ALPHA * bfhi(rw.y);
                    o1[0] += ALPHA * bflo(rw.z); o1[1] += ALPHA * bfhi(rw.z); o1[2] += ALPHA * bflo(rw.w); o1[3] += ALPHA * bfhi(rw.w);
                    *(v4u*)(O + off + bj * 128) = pack8(o0, o1); } }
    }
};
struct EpiRouterShared {
    static constexpr bool PERM = true, PRE = false, CHAIN = false;
    float* L; bf16* HS;
    __device__ __forceinline__ void operator()(const AccT& acc, const Unit& u, int wr, int wc, int fr, int fq) const {
        const int row0 = u.pm * 256 + wr * 64 + fr, cl = wc * 32 + 8 * fq;
        if (u.pn == 0) {
#pragma unroll
            for (int ai = 0; ai < 2; ++ai)
#pragma unroll
                for (int m = 0; m < 4; ++m) { float* rowp = L + (size_t)(row0 + ai * 128 + m * 16) * 256 + cl;
#pragma unroll
                    for (int bj = 0; bj < 2; ++bj)
#pragma unroll
                        for (int n = 0; n < 2; ++n) *(f32x4*)(rowp + bj * 128 + 4 * n) = acc[ai][bj][m][n]; }
        } else {
            const int colt = (u.pn - 1) * 128;
#pragma unroll
            for (int ai = 0; ai < 2; ++ai)
#pragma unroll
                for (int m = 0; m < 4; ++m) { bf16* rowp = HS + (size_t)(row0 + ai * 128 + m * 16) * 256 + colt + cl;
                    f32x4 h0, h1;
#pragma unroll
                    for (int j = 0; j < 4; ++j) { h0[j] = siluf_(acc[ai][0][m][0][j]) * acc[ai][1][m][0][j]; h1[j] = siluf_(acc[ai][0][m][1][j]) * acc[ai][1][m][1][j]; }
                    *(v4u*)rowp = pack8(h0, h1); }
        }
    }
};
struct EpiExpGU {
    static constexpr bool PERM = true, PRE = false, CHAIN = false;
    bf16* H;
    __device__ __forceinline__ void operator()(const AccT& acc, const Unit& u, int wr, int wc, int fr, int fq) const {
        const int row0 = u.pm * 256 + wr * 64 + fr, col0 = (u.pn & 1) * 128 + wc * 32 + 8 * fq;
#pragma unroll
        for (int ai = 0; ai < 2; ++ai)
#pragma unroll
            for (int m = 0; m < 4; ++m) { bf16* rowp = H + (size_t)(row0 + ai * 128 + m * 16) * 256 + col0;
                f32x4 h0, h1;
#pragma unroll
                for (int j = 0; j < 4; ++j) { h0[j] = siluf_(acc[ai][0][m][0][j]) * acc[ai][1][m][0][j]; h1[j] = siluf_(acc[ai][0][m][1][j]) * acc[ai][1][m][1][j]; }
                *(v4u*)rowp = pack8(h0, h1); }
    }
};
struct EpiExpDown {
    static constexpr bool PERM = true, PRE = true, CHAIN = false;
    unsigned char* Y; const v2u* rowinfo; unsigned char* trash;
    __device__ __forceinline__ void pre(const Unit& u, LAS v2u* ri, int tid) const { if (tid < 256) ri[tid] = rowinfo[(size_t)u.pm * 256 + tid]; }
    __device__ __forceinline__ void operator()(const AccT& acc, const Unit& u, int wr, int wc, int fr, int fq, const LAS v2u* ri) const {
        const int rl0 = wr * 64 + fr, col0 = (u.pn & 3) * 256 + wc * 32 + 8 * fq;
#pragma unroll
        for (int ai = 0; ai < 2; ++ai)
#pragma unroll
            for (int m = 0; m < 4; ++m) { const v2u info = ri[rl0 + ai * 128 + m * 16]; const int slot = (int)info.x; const float gt = __uint_as_float(info.y) * YSCALE;
                unsigned char* rowp = (slot >= 0 ? Y + (size_t)slot * 1024 : trash) + col0;
#pragma unroll
                for (int bj = 0; bj < 2; ++bj) { const f32x4 a = acc[ai][bj][m][0] * gt, b = acc[ai][bj][m][1] * gt; v2u w;
                    int p = __builtin_amdgcn_cvt_pk_fp8_f32(__builtin_amdgcn_fmed3f(a[0], -448.f, 448.f), __builtin_amdgcn_fmed3f(a[1], -448.f, 448.f), 0, false);
                    p = __builtin_amdgcn_cvt_pk_fp8_f32(__builtin_amdgcn_fmed3f(a[2], -448.f, 448.f), __builtin_amdgcn_fmed3f(a[3], -448.f, 448.f), p, true); w.x = (unsigned)p;
                    p = __builtin_amdgcn_cvt_pk_fp8_f32(__builtin_amdgcn_fmed3f(b[0], -448.f, 448.f), __builtin_amdgcn_fmed3f(b[1], -448.f, 448.f), 0, false);
                    p = __builtin_amdgcn_cvt_pk_fp8_f32(__builtin_amdgcn_fmed3f(b[2], -448.f, 448.f), __builtin_amdgcn_fmed3f(b[3], -448.f, 448.f), p, true); w.y = (unsigned)p;
                    *(v2u*)(rowp + bj * 128) = w; } }
    }
};

constexpr int RING_OFF = 0, RING_BYTES = 131072;
constexpr int LDSX_OFF = RING_BYTES;
constexpr int LDS_BYTES = 163840;
constexpr int LDSCTL_OFF = LDS_BYTES - 256;

struct Frame {
    LAS unsigned char* lds;
    unsigned* ctl;
    unsigned char* ws;
    int tid, lane, wave, G, bid;
    float* out;
};
__device__ __forceinline__ const float* in_ptr(int i) { const float* const* ka = (const float* const*)__builtin_amdgcn_kernarg_segment_ptr(); asm volatile("" : "+s"(ka)); return ka[i]; }
enum { I_X = 0, I_MEM, I_LNIG, I_LNIB, I_LNMG, I_LNMB, I_LBF, I_LBB, I_WIN, I_BGATE, I_HNG, I_WKV, I_WFO, I_BFO, I_WHO, I_WXO, I_WOUT, I_LN1G, I_LN1B, I_WR, I_RB, I_WEG, I_WEU, I_WED, I_WSG, I_WSU, I_WSD, I_LN2G, I_LN2B };

__device__ __forceinline__ void tr_load(const float* src0, int lds_, f32x4 (&v)[8], int lane) {
#pragma unroll
    for (int i = 0; i < 8; ++i) v[i] = *(const f32x4*)(src0 + (size_t)((lane >> 3) + 8 * i) * lds_ + 4 * (lane & 7));
}
__device__ __forceinline__ void tr_finish(const f32x4 (&v)[8], bf16* dst0, int ldd, LAS float* scr, int lane) {
#pragma unroll
    for (int i = 0; i < 8; ++i) { LAS float* d = scr + ((lane >> 3) + 8 * i) * 33 + 4 * (lane & 7); d[0] = v[i][0]; d[1] = v[i][1]; d[2] = v[i][2]; d[3] = v[i][3]; }
    LDS_WAIT(); asm volatile("" ::: "memory");
    const int c = lane & 7;
#pragma unroll
    for (int j = 0; j < 4; ++j) { const int n = (lane >> 3) + 8 * j; const LAS float* s = scr + (8 * c) * 33 + n;
        v4u o; o.x = cvt_pk_bf16(s[0 * 33], s[1 * 33]); o.y = cvt_pk_bf16(s[2 * 33], s[3 * 33]); o.z = cvt_pk_bf16(s[4 * 33], s[5 * 33]); o.w = cvt_pk_bf16(s[6 * 33], s[7 * 33]);
        *(v4u*)(dst0 + (size_t)n * ldd + 8 * c) = o; }
    LDS_WAIT(); asm volatile("" ::: "memory");
}
__device__ __forceinline__ void tr_item(const float* src0, int lds_, bf16* dst0, int ldd, LAS float* scr, int lane) {
    f32x4 v[8]; tr_load(src0, lds_, v, lane); tr_finish(v, dst0, ldd, scr, lane);
}
__device__ __forceinline__ void conv_matrix(Frame& F, const float* src, size_t mat_stride, int nmat, int K, int ldsrc, int n_lo, int ncols, bf16* dst, int rbase, int rstride, int rmul, int dld = 0, int dko = 0) {
    if (dld == 0) dld = K;
    LAS float* scr = (LAS float*)(F.lds + RING_OFF + F.wave * 16384);
    const int gw = F.bid * NWAVES + F.wave, NGW = F.G * NWAVES;
    const int nkb = K / 64, nnb = ncols / 32, per = nkb * nnb, total = per * nmat;
    for (int it = gw; it < total; it += NGW) {
        const int e = it / per, r = it - e * per, kb = r / nnb, nb = r - kb * nnb, n = nb * 32;
        const int drow = rbase + e * rstride + (n >> 7) * rmul + (n & 127);
        tr_item(src + (size_t)e * mat_stride + (size_t)(kb * 64) * ldsrc + n_lo + n, ldsrc, dst + (size_t)drow * dld + dko + kb * 64, dld, scr, F.lane);
    }
}
__device__ __forceinline__ void conv_item_d(Frame& F, int it, LAS float* scr, int lane) {
    const int e = it >> 7, r = it & 127, kb = r >> 5, n = (r & 31) * 32;
    tr_item(in_ptr(I_WED) + (size_t)e * (256 * 1024) + (size_t)(kb * 64) * 1024 + n, 1024, (bf16*)(F.ws + WS_EXPD) + (size_t)(e * 1024 + n) * 256 + kb * 64, 256, scr, lane);
}
__device__ __forceinline__ void conv_item_gu(Frame& F, int it, LAS float* scr, int lane) {
    const int up = it >> 15, e = (it & 32767) >> 7, r = it & 127, kb = r >> 3, n = (r & 7) * 32, drow = e * 512 + up * 128 + (n >> 7) * 256 + (n & 127);
    tr_item(in_ptr(up ? I_WEU : I_WEG) + (size_t)e * (1024 * 256) + (size_t)(kb * 64) * 256 + n, 256, (bf16*)(F.ws + WS_EXPGU) + (size_t)drow * 1024 + kb * 64, 1024, scr, lane);
}
__device__ __forceinline__ const float* conv_gu_src(int it) { const int up = it >> 15, e = (it & 32767) >> 7, r = it & 127, kb = r >> 3, n = (r & 7) * 32; return in_ptr(up ? I_WEU : I_WEG) + (size_t)e * (1024 * 256) + (size_t)(kb * 64) * 256 + n; }
__device__ __forceinline__ bf16* conv_gu_dst(Frame& F, int it) { const int up = it >> 15, e = (it & 32767) >> 7, r = it & 127, kb = r >> 3, n = (r & 7) * 32, drow = e * 512 + up * 128 + (n >> 7) * 256 + (n & 127); return (bf16*)(F.ws + WS_EXPGU) + (size_t)drow * 1024 + kb * 64; }
__device__ __forceinline__ void conv_slice(Frame& F, int d0, int d1, int g0, int g1) {
    int tid_ = threadIdx.x; asm volatile("" : "+v"(tid_));
    const int lane = tid_ & 63, wave = __builtin_amdgcn_readfirstlane(tid_ >> 6), gw = F.bid * NWAVES + wave, NGW = F.G * NWAVES;
    LAS float* scr = (LAS float*)(F.lds + RING_OFF + wave * 16384);
    for (int j = d0; (d1 < 0 || j < d1) && gw + j * NGW < 32768; ++j) conv_item_d(F, gw + j * NGW, scr, lane);
    for (int j = g0; (g1 < 0 || j < g1) && gw + j * NGW < 65536; ++j) conv_item_gu(F, gw + j * NGW, scr, lane);
}
__device__ __forceinline__ void gbar_arrive(const XcdBarrier& b) {
    asm volatile("s_waitcnt vmcnt(0)" ::: "memory");
    __syncthreads();
    if (threadIdx.x == 0) {
        unsigned* bar = b.bar;
        __builtin_amdgcn_s_waitcnt(0);
        unsigned nloc = b.st[0], nx = b.st[1];
        if (nloc == 0u) { xcd_barrier_complete(bar, b.x, nloc, nx); b.st[0] = nloc; b.st[1] = nx; }
        const unsigned old = xb_add(&bar[XB_XSUB(b.x)], 1u);
        const unsigned gen = old / nloc;
        if (old + 1u == (gen + 1u) * nloc) {
            __builtin_amdgcn_fence(__ATOMIC_RELEASE, "agent");
            asm volatile("s_waitcnt vmcnt(0)" ::: "memory");
            const unsigned og = xb_add(&bar[XB_TOP], 1u);
            const unsigned tg = og / nx;
            if (og + 1u == (tg + 1u) * nx) xb_add(&bar[XB_TOPGEN], 1u);
        }
    }
}
__device__ __forceinline__ void gbar_wait(const XcdBarrier& b) {
    if (threadIdx.x == 0) {
        const unsigned k = b.st[2];
        XB_SPIN(xb_ld(&b.bar[XB_TOPGEN]) <= k, b.bar);
        __builtin_amdgcn_fence(__ATOMIC_ACQUIRE, "agent");
        asm volatile("s_waitcnt vmcnt(0)" ::: "memory");
        b.st[2] = k + 1u;
    }
    __syncthreads();
}
__device__ __forceinline__ void ln_regs_bf16(f32x4 (&v)[4], const float* g, const float* b, bf16* orow, int lane) {
    float s = 0.f;
#pragma unroll
    for (int j = 0; j < 4; ++j) s += (v[j][0] + v[j][1]) + (v[j][2] + v[j][3]);
    const float mean = wave_sum(s) * (1.f / 1024.f); float s2 = 0.f;
#pragma unroll
    for (int j = 0; j < 4; ++j) { v[j] = v[j] - mean; s2 += (v[j][0] * v[j][0] + v[j][1] * v[j][1]) + (v[j][2] * v[j][2] + v[j][3] * v[j][3]); }
    const float rstd = 1.f / sqrtf(wave_sum(s2) * (1.f / 1024.f) + LN_EPS);
    v2u* o8 = (v2u*)orow + lane;
#pragma unroll
    for (int j = 0; j < 4; ++j) { const f32x4 gg = ((const f32x4*)g)[lane + 64 * j], bb = ((const f32x4*)b)[lane + 64 * j]; const f32x4 y = v[j] * rstd * gg + bb;
        v2u w; w.x = cvt_pk_bf16(y[0], y[1]); w.y = cvt_pk_bf16(y[2], y[3]); o8[64 * j] = w; }
}
__device__ __forceinline__ void ln_rows_f32(const float* X, int nrows, int m0, int step, const float* g, const float* b, bf16* O, int lane) {
    if (m0 >= nrows) return;
    asm volatile("" : "+v"(lane));
    f32x4 nx[4];
#pragma unroll
    for (int j = 0; j < 4; ++j) nx[j] = ((const f32x4*)(X + (size_t)m0 * D))[lane + 64 * j];
    for (int m = m0; m < nrows; m += step) {
        f32x4 v[4];
#pragma unroll
        for (int j = 0; j < 4; ++j) v[j] = nx[j];
        if (m + step < nrows) {
#pragma unroll
            for (int j = 0; j < 4; ++j) nx[j] = ((const f32x4*)(X + (size_t)(m + step) * D))[lane + 64 * j]; }
        ln_regs_bf16(v, g, b, O + (size_t)m * D, lane);
    }
}
__device__ __forceinline__ void ln_rows_bf16(const bf16* X, int nrows, int m0, int step, const float* g, const float* b, bf16* O, int lane) {
    if (m0 >= nrows) return;
    asm volatile("" : "+v"(lane));
    v2u nx[4];
#pragma unroll
    for (int j = 0; j < 4; ++j) nx[j] = ((const v2u*)(X + (size_t)m0 * D))[lane + 64 * j];
    for (int m = m0; m < nrows; m += step) {
        f32x4 v[4];
#pragma unroll
        for (int j = 0; j < 4; ++j) { v[j][0] = bflo(nx[j].x); v[j][1] = bfhi(nx[j].x); v[j][2] = bflo(nx[j].y); v[j][3] = bfhi(nx[j].y); }
        if (m + step < nrows) {
#pragma unroll
            for (int j = 0; j < 4; ++j) nx[j] = ((const v2u*)(X + (size_t)(m + step) * D))[lane + 64 * j]; }
        ln_regs_bf16(v, g, b, O + (size_t)m * D, lane);
    }
}
__device__ __forceinline__ void p0_prologue(Frame& F) {
    const int gw = F.bid * NWAVES + F.wave, NGW = F.G * NWAVES;
    unsigned char* ws = F.ws;
    {
        LAS float* scr = (LAS float*)(F.lds + RING_OFF + F.wave * 16384);
        for (int it = gw; it < 3584; it += NGW) {
            int r = it, mi, K, ld, nlo, ncols, rbase, rmul; size_t doff;
            if (r < 3072) { mi = I_WIN; K = 1024; ld = 6656; nlo = 512; ncols = 6144; doff = WS_WIN; rbase = 1024; rmul = 128; }
            else { r -= 3072; mi = I_WKV; K = 1024; ld = 1024; nlo = 0; ncols = 1024; doff = WS_WKV; rbase = 0; rmul = 128; }
            const int nnb = ncols / 32, kb = r / nnb, nb = r - kb * nnb, n = nb * 32, drow = rbase + (n >> 7) * rmul + (n & 127);
            tr_item(in_ptr(mi) + (size_t)(kb * 64) * ld + nlo + n, ld, (bf16*)(ws + doff) + (size_t)drow * K + kb * 64, K, scr, F.lane);
        }
    }
    {
        LAS float* ct = (LAS float*)(F.lds + LDSX_OFF);
        if (F.tid < 128) { float sn, cs; __sincosf(6.283185307179586f * (float)F.tid / 128.f, &sn, &cs); ct[F.tid] = cs; ct[128 + F.tid] = sn; }
        __syncthreads();
        const float* win = in_ptr(I_WIN); bf16* wt = (bf16*)(ws + WS_WIN);
        LAS float* wscr = (LAS float*)(F.lds + RING_OFF + F.wave * 16384);
        for (int it = gw; it < 1024 * 4; it += NGW) {
            const int k = it >> 2, g = it & 3;
            const f32x2 w2 = *(const f32x2*)(win + (size_t)k * 6656 + g * 128 + 2 * F.lane);
            wscr[2 * F.lane] = w2[0]; wscr[2 * F.lane + 1] = w2[1];
            LDS_WAIT(); asm volatile("" ::: "memory");
            float ac0 = 0.f, as0 = 0.f, ac1 = 0.f, as1 = 0.f;
#pragma unroll 8
            for (int c = 0; c < 128; ++c) { const float wv = wscr[c]; const int a0 = (F.lane * c) & 127, a1 = ((F.lane + 64) * c) & 127;
                ac0 += wv * ct[a0]; as0 += wv * ct[128 + a0]; ac1 += wv * ct[a1]; as1 += wv * ct[128 + a1]; }
            wt[(size_t)(g * 128 + F.lane) * 1024 + k] = f2bf(ac0); wt[(size_t)(512 + g * 128 + F.lane) * 1024 + k] = f2bf(as0);
            wt[(size_t)(g * 128 + 64 + F.lane) * 1024 + k] = f2bf(ac1); wt[(size_t)(512 + g * 128 + 64 + F.lane) * 1024 + k] = f2bf(as1);
            LDS_WAIT(); asm volatile("" ::: "memory");
        }
    }
    ln_rows_f32(in_ptr(I_X), T, gw, NGW, in_ptr(I_LNIG), in_ptr(I_LNIB), (bf16*)(ws + WS_H0), F.lane);
    ln_rows_f32(in_ptr(I_MEM), NB * MEM, gw, NGW, in_ptr(I_LNMG), in_ptr(I_LNMB), (bf16*)(ws + WS_MEMN), F.lane);
}
__device__ __forceinline__ void p0_late(Frame& F) {
    int tid_ = threadIdx.x; asm volatile("" : "+v"(tid_));
    const int lane = tid_ & 63, wave = __builtin_amdgcn_readfirstlane(tid_ >> 6), gw = F.bid * NWAVES + wave, NGW = F.G * NWAVES;
    unsigned char* ws = F.ws;
    LAS float* scr = (LAS float*)(F.lds + RING_OFF + wave * 16384);
    for (int it = gw; it < 1792; it += NGW) {
        int r = it, mi, K, ld, ncols, rbase, rmul; size_t doff;
        if (r < 256) { mi = I_WFO; K = 512; ld = 1024; ncols = 1024; doff = WS_WBR; rbase = 0; rmul = 128; }
        else if ((r -= 256) < 256) { mi = I_WHO; K = 512; ld = 1024; ncols = 1024; doff = WS_WBR; rbase = 1024; rmul = 128; }
        else if ((r -= 256) < 256) { mi = I_WXO; K = 512; ld = 1024; ncols = 1024; doff = WS_WBR; rbase = 2048; rmul = 128; }
        else if ((r -= 256) < 512) { mi = I_WOUT; K = 1024; ld = 1024; ncols = 1024; doff = WS_WOUT; rbase = 0; rmul = 128; }
        else if ((r -= 512) < 128) { mi = I_WR; K = 1024; ld = 256; ncols = 256; doff = WS_WRS; rbase = 0; rmul = 128; }
        else if ((r -= 128) < 128) { mi = I_WSG; K = 1024; ld = 256; ncols = 256; doff = WS_WRS; rbase = 256; rmul = 256; }
        else if ((r -= 128) < 128) { mi = I_WSU; K = 1024; ld = 256; ncols = 256; doff = WS_WRS; rbase = 384; rmul = 256; }
        else { r -= 128; mi = I_WSD; K = 256; ld = 1024; ncols = 1024; doff = WS_WSD; rbase = 0; rmul = 128; }
        const int nnb = ncols / 32, kb = r / nnb, nb = r - kb * nnb, n = nb * 32, drow = rbase + (n >> 7) * rmul + (n & 127);
        tr_item(in_ptr(mi) + (size_t)(kb * 64) * ld + n, ld, (bf16*)(ws + doff) + (size_t)drow * K + kb * 64, K, scr, lane);
    }
    {
        bf16* a1 = (bf16*)(ws + WS_A1);
        for (int i = F.bid * NTHR + tid_; i < 128 * 128; i += F.G * NTHR) {
            const int m = i >> 7, kk = i & 127, po = m >> 6, k1 = m & 63, pi = kk >> 6, s1 = kk & 63;
            float sn, cs; __sincosf(6.283185307179586f * (float)((s1 * k1) & 63) / 64.f, &sn, &cs);
            const float v = (po == pi) ? cs : (po == 0 ? -sn : sn);
            a1[i] = f2bf(v * 0.125f);
        }
        bf16* a3 = (bf16*)(ws + WS_A3);
        for (int i = F.bid * NTHR + tid_; i < 64 * 128 * 256; i += F.G * NTHR) {
            const int k1 = i >> 15, k2 = (i >> 8) & 127, kk = i & 255, s2 = kk >> 1, part = kk & 1, k = k1 + 64 * k2;
            float sn, cs; __sincosf(6.283185307179586f * (float)((s2 * k) & 8191) / 8192.f, &sn, &cs);
            a3[i] = f2bf((part == 0 ? cs : -sn) * (1.f / 128.f));
        }
        }
}
__device__ __forceinline__ void p_ln1(Frame& F) {
    const int gw = F.bid * NWAVES + F.wave, NGW = F.G * NWAVES;
    ln_rows_bf16((const bf16*)(F.ws + WS_S1), T, gw, NGW, in_ptr(I_LN1G), in_ptr(I_LN1B), (bf16*)(F.ws + WS_H1), F.lane);
}
template <bool ROUTED>
__device__ __forceinline__ void p_final(Frame& F) {
    const int gw = F.bid * NWAVES + F.wave, NGW = F.G * NWAVES; int lane = F.lane; asm volatile("" : "+v"(lane));
    const float* g = in_ptr(I_LN2G); const float* b = in_ptr(I_LN2B);
    if (gw >= T) return;
    v2u nx[4]; int ny[8][4];
#define FIN_FETCH(m_) do { const v2u* xr_ = (const v2u*)((const bf16*)(F.ws + WS_S2) + (size_t)(m_) * D) + lane; const unsigned* yb_ = (const unsigned*)(F.ws + WS_YR) + (size_t)(m_) * 8 * 256; \
        _Pragma("unroll") for (int j = 0; j < 4; ++j) nx[j] = xr_[64 * j]; \
        if (ROUTED) { _Pragma("unroll") for (int k = 0; k < 8; ++k) _Pragma("unroll") for (int j = 0; j < 4; ++j) ny[k][j] = (int)yb_[(size_t)k * 256 + lane + 64 * j]; } } while (0)
    FIN_FETCH(gw);
    for (int m = gw; m < T; m += NGW) {
        f32x4 v[4], ya[4];
#pragma unroll
        for (int j = 0; j < 4; ++j) { v[j][0] = bflo(nx[j].x); v[j][1] = bfhi(nx[j].x); v[j][2] = bflo(nx[j].y); v[j][3] = bfhi(nx[j].y); ya[j] = (f32x4){0.f, 0.f, 0.f, 0.f}; }
        if (ROUTED) {
#pragma unroll
            for (int k = 0; k < 8; ++k)
#pragma unroll
                for (int j = 0; j < 4; ++j) { const int w = ny[k][j];
                    ya[j][0] += __builtin_amdgcn_cvt_f32_fp8(w, 0); ya[j][1] += __builtin_amdgcn_cvt_f32_fp8(w, 1); ya[j][2] += __builtin_amdgcn_cvt_f32_fp8(w, 2); ya[j][3] += __builtin_amdgcn_cvt_f32_fp8(w, 3); }
#pragma unroll
            for (int j = 0; j < 4; ++j) v[j] = v[j] + ya[j] * (1.0f / YSCALE);
        }
        if (m + NGW < T) FIN_FETCH(m + NGW);
        float s = 0.f;
#pragma unroll
        for (int j = 0; j < 4; ++j) s += (v[j][0] + v[j][1]) + (v[j][2] + v[j][3]);
        const float mean = wave_sum(s) * (1.f / 1024.f); float s2 = 0.f;
#pragma unroll
        for (int j = 0; j < 4; ++j) { v[j] = v[j] - mean; s2 += (v[j][0] * v[j][0] + v[j][1] * v[j][1]) + (v[j][2] * v[j][2] + v[j][3] * v[j][3]); }
        const float rstd = 1.f / sqrtf(wave_sum(s2) * (1.f / 1024.f) + LN_EPS);
        f32x4* o = (f32x4*)(F.out + (size_t)m * D) + lane;
#pragma unroll
        for (int j = 0; j < 4; ++j) { const f32x4 gg = ((const f32x4*)g)[lane + 64 * j], bb = ((const f32x4*)b)[lane + 64 * j]; o[64 * j] = v[j] * rstd * gg + bb; }
    }
#undef FIN_FETCH
}


__device__ __forceinline__ void p_proj(Frame& F) {
    pg8::Gemm g{(const bf16*)(F.ws + WS_H0), (const bf16*)(F.ws + WS_WIN), 1024};
    pg8::StaticOrder S; S.init(T, NPROJ, F.G, F.bid);
    EpiProj E{(bf16*)(F.ws + WS_F), (bf16*)(F.ws + WS_Q), (bf16*)(F.ws + WS_GATES), in_ptr(I_BGATE)};
    pg8::gemm_phase<EpiProj, pg8::StaticOrder, false>(F.lds + RING_OFF, g, S, E, nullptr);
}
__device__ __forceinline__ void p_kv(Frame& F) {
    pg8::Gemm g{(const bf16*)(F.ws + WS_MEMN), (const bf16*)(F.ws + WS_WKV), 1024};
    pg8::StaticOrder S; S.init(NB * MEM, 1024, F.G, F.bid);
    EpiPlain E{(bf16*)(F.ws + WS_KV), 1024};
    pg8::gemm_phase<EpiPlain, pg8::StaticOrder, false>(F.lds + RING_OFF, g, S, E, nullptr);
}
__device__ __forceinline__ void p_branch(Frame& F) {
    pg8::Gemm g{(const bf16*)(F.ws + WS_MIX), (const bf16*)(F.ws + WS_WBR), 512};
    ChainOrder S; S.S.init(T, 1024, F.G, F.bid);
    EpiMix E{(bf16*)(F.ws + WS_MERGED), (const bf16*)(F.ws + WS_GATES), in_ptr(I_BFO)};
    pg8::gemm_phase<EpiMix, ChainOrder, false>(F.lds + RING_OFF, g, S, E, nullptr);
}
__device__ __forceinline__ void p_wout(Frame& F) {
    pg8::Gemm g{(const bf16*)(F.ws + WS_MERGED), (const bf16*)(F.ws + WS_WOUT), 1024};
    pg8::StaticOrder S; S.init(T, 1024, F.G, F.bid);
    EpiResid E{(bf16*)(F.ws + WS_S1), (const bf16*)(F.ws + WS_H0)};
    pg8::gemm_phase<EpiResid, pg8::StaticOrder, false>(F.lds + RING_OFF, g, S, E, nullptr);
}
__device__ __forceinline__ void p_router_shared(Frame& F) {
    pg8::Gemm g{(const bf16*)(F.ws + WS_H1), (const bf16*)(F.ws + WS_WRS), 1024};
    pg8::StaticOrder S; S.init(T, 768, F.G, F.bid);
    EpiRouterShared E{(float*)(F.ws + WS_LOGIT), (bf16*)(F.ws + WS_HS)};
    pg8::gemm_phase<EpiRouterShared, pg8::StaticOrder, false>(F.lds + RING_OFF, g, S, E, nullptr);
}
__device__ __forceinline__ void p_shared_down(Frame& F) {
    pg8::Gemm g{(const bf16*)(F.ws + WS_HS), (const bf16*)(F.ws + WS_WSD), 256};
    pg8::StaticOrder S; S.init(T, 1024, F.G, F.bid);
    EpiResid E{(bf16*)(F.ws + WS_S2), (const bf16*)(F.ws + WS_H1)};
    pg8::gemm_phase<EpiResid, pg8::StaticOrder, false>(F.lds + RING_OFF, g, S, E, nullptr);
}

constexpr int XA_PITCH = 136;
__device__ __forceinline__ void p_xattn(Frame& F) {
    LAS bf16* Ks = (LAS bf16*)(F.lds); LAS bf16* Vs = Ks + 256 * XA_PITCH;
    const bf16* KV = (const bf16*)(F.ws + WS_KV); const bf16* XQ = (const bf16*)(F.ws + WS_Q + 5 * SEC_STRIDE); bf16* XO = (bf16*)(F.ws + WS_MIX) + (size_t)2 * T * 512;
    const int lane = F.lane, r = lane & 15, q = lane >> 4, qp = (lane & 15) >> 2, pp = lane & 3;
    int cur_bh = -1;
    for (int u = F.bid; u < 512; u += F.G) {
        const int bh = u & 15, tile = u >> 4, b = bh >> 2, h = bh & 3;
        if (bh != cur_bh) {
            __syncthreads();
            for (int c = F.tid; c < 256 * 16; c += NTHR) { const int key = c >> 4, ch = c & 15;
                const v4u kv = *(const v4u*)(KV + (size_t)(b * 256 + key) * 1024 + h * 128 + ch * 8);
                const v4u vv = *(const v4u*)(KV + (size_t)(b * 256 + key) * 1024 + 512 + h * 128 + ch * 8);
                *(LAS v4u*)(Ks + key * XA_PITCH + ch * 8) = kv; *(LAS v4u*)(Vs + key * XA_PITCH + ch * 8) = vv; }
            __syncthreads();
            cur_bh = bh;
        }
        const int t0 = b * SEQ + tile * 256 + F.wave * 32;
#pragma unroll 1
        for (int mq = 0; mq < 2; ++mq) {
            const bf16* qrow = XQ + (size_t)(t0 + 16 * mq + r) * 512 + h * 128 + 8 * q;
            bf16x8 qf[4];
#pragma unroll
            for (int ks = 0; ks < 4; ++ks) qf[ks] = *(const bf16x8*)(qrow + 32 * ks);
            f32x4 sc[16];
#pragma unroll
            for (int nk = 0; nk < 16; ++nk) { sc[nk] = (f32x4){0.f, 0.f, 0.f, 0.f};
#pragma unroll
                for (int ks = 0; ks < 4; ++ks) { const bf16x8 kf = *(const LAS bf16x8*)(Ks + (16 * nk + r) * XA_PITCH + 32 * ks + 8 * q);
                    sc[nk] = __builtin_amdgcn_mfma_f32_16x16x32_bf16(kf, qf[ks], sc[nk], 0, 0, 0); } }
            float mx = -3.0e38f;
#pragma unroll
            for (int nk = 0; nk < 16; ++nk) mx = fmaxf(mx, fmaxf(fmaxf(sc[nk][0], sc[nk][1]), fmaxf(sc[nk][2], sc[nk][3])));
            mx = fmaxf(mx, __shfl_xor(mx, 16)); mx = fmaxf(mx, __shfl_xor(mx, 32));
            float l = 0.f;
#pragma unroll
            for (int nk = 0; nk < 16; ++nk) {
#pragma unroll
                for (int j = 0; j < 4; ++j) { sc[nk][j] = __builtin_amdgcn_exp2f(sc[nk][j] - mx); l += sc[nk][j]; } }
            l += __shfl_xor(l, 16); l += __shfl_xor(l, 32);
            const float inv = 1.0f / l;
            bf16x8 pf[8];
#pragma unroll
            for (int s = 0; s < 8; ++s) { v4u w; w.x = cvt_pk_bf16(sc[2 * s][0], sc[2 * s][1]); w.y = cvt_pk_bf16(sc[2 * s][2], sc[2 * s][3]);
                w.z = cvt_pk_bf16(sc[2 * s + 1][0], sc[2 * s + 1][1]); w.w = cvt_pk_bf16(sc[2 * s + 1][2], sc[2 * s + 1][3]); pf[s] = __builtin_bit_cast(bf16x8, w); }
            bf16* orow = XO + (size_t)(t0 + 16 * mq + r) * 512 + h * 128 + 4 * q;
#pragma unroll
            for (int nd = 0; nd < 8; ++nd) { f32x4 o = (f32x4){0.f, 0.f, 0.f, 0.f};
#pragma unroll
                for (int s = 0; s < 8; ++s) {
                    const s16x4 v0 = __builtin_amdgcn_ds_read_tr16_b64_v4i16((LAS s16x4*)(Vs + (32 * s + 4 * q + qp) * XA_PITCH + 16 * nd + 4 * pp));
                    const s16x4 v1 = __builtin_amdgcn_ds_read_tr16_b64_v4i16((LAS s16x4*)(Vs + (32 * s + 16 + 4 * q + qp) * XA_PITCH + 16 * nd + 4 * pp));
                    const bf16x8 vf = {v0[0], v0[1], v0[2], v0[3], v1[0], v1[1], v1[2], v1[3]};
                    o = __builtin_amdgcn_mfma_f32_16x16x32_bf16(vf, pf[s], o, 0, 0, 0); }
                o = o * inv;
                v2u w; w.x = cvt_pk_bf16(o[0], o[1]); w.y = cvt_pk_bf16(o[2], o[3]); *(v2u*)(orow + 16 * nd) = w; }
        }
    }
    __syncthreads();
}

constexpr int RT_GU0 = 16, RT_GU1 = 32;
__device__ __forceinline__ unsigned fkey(float x) { const unsigned b = __float_as_uint(x); return (b & 0x80000000u) ? ~b : (b | 0x80000000u); }
__device__ __forceinline__ int popc64(unsigned long long m) { return __builtin_popcountll(m); }
__device__ __forceinline__ void p_routing(Frame& F) {
    const int gw = F.bid * NWAVES + F.wave, NGW = F.G * NWAVES, lane = F.lane;
    const float* L = (const float*)(F.ws + WS_LOGIT);
    int* eidx = (int*)(F.ws + WS_ROUTE + RT_EIDX); float* wgt = (float*)(F.ws + WS_ROUTE + RT_WGT); int* pos = (int*)(F.ws + WS_ROUTE + RT_POS);
    unsigned* cnt = F.ctl + CW_CNT;
    const f32x4 rb = ((const f32x4*)in_ptr(I_RB))[lane];
    const float NEG = -__builtin_inff();
    const unsigned long long below = (lane == 0) ? 0ull : (~0ull >> (64 - lane));
    LAS int* le = (LAS int*)(F.lds + F.wave * 16384 + 12288); LAS float* lw = (LAS float*)(F.lds + F.wave * 16384 + 12288 + 256);
    LAS float* scr = (LAS float*)(F.lds + F.wave * 16384);
    int cj = RT_GU0;
    f32x4 lgn = ((const f32x4*)(L + (size_t)gw * 256))[lane];
    for (int base = gw; base < T; base += 8 * NGW) {
#pragma unroll 1
      for (int jt = 0; jt < 8; ++jt) {
        const int t = base + jt * NGW; if (t >= T) break;
        const int cit = gw + cj * NGW; const bool conv = (cj < RT_GU1) && (cit < 65536); ++cj;
        f32x4 cv[8];
        if (conv) tr_load(conv_gu_src(cit), 256, cv, lane);
        const f32x4 lg = lgn;
        if (t + NGW < T) lgn = ((const f32x4*)(L + (size_t)(t + NGW) * 256))[lane];
        const float a0 = sigmoidf_(lg[0]), a1 = sigmoidf_(lg[1]), a2 = sigmoidf_(lg[2]), a3 = sigmoidf_(lg[3]);
        float s0 = a0 + rb[0], s1 = a1 + rb[1], s2 = a2 + rb[2], s3 = a3 + rb[3];
        float m1 = fmaxf(s0, s1), m2 = fminf(s0, s1);
        { const float n1 = fmaxf(m1, s2), n2 = fmaxf(fminf(m1, s2), m2); m1 = n1; m2 = n2; }
        { const float n1 = fmaxf(m1, s3), n2 = fmaxf(fminf(m1, s3), m2); m1 = n1; m2 = n2; }
#pragma unroll
        for (int o = 1; o < 8; o <<= 1) { const float p1 = __shfl_xor(m1, o), p2 = __shfl_xor(m2, o); const float n1 = fmaxf(m1, p1), n2 = fmaxf(fminf(m1, p1), fmaxf(m2, p2)); m1 = n1; m2 = n2; }
        const float gs = m1 + m2; const int grp = lane >> 3; int rank = 0;
#pragma unroll
        for (int g2 = 0; g2 < 8; ++g2) { const float o = __uint_as_float((unsigned)__builtin_amdgcn_readlane((int)__float_as_uint(gs), g2 * 8)); rank += (o > gs || (o == gs && g2 < grp)) ? 1 : 0; }
        if (rank >= 4) { s0 = NEG; s1 = NEG; s2 = NEG; s3 = NEG; }
        const unsigned k0 = fkey(s0), k1 = fkey(s1), k2 = fkey(s2), k3 = fkey(s3);
        unsigned Tk = 0u;
#pragma unroll 1
        for (int bit = 31; bit >= 0; --bit) { const unsigned cand = Tk | (1u << bit);
            const int c = popc64(__ballot(k0 >= cand)) + popc64(__ballot(k1 >= cand)) + popc64(__ballot(k2 >= cand)) + popc64(__ballot(k3 >= cand));
            if (c >= 8) Tk = cand; }
        const unsigned long long g0 = __ballot(k0 > Tk), g1 = __ballot(k1 > Tk), g2b = __ballot(k2 > Tk), g3 = __ballot(k3 > Tk);
        const unsigned long long e0 = __ballot(k0 == Tk), e1 = __ballot(k1 == Tk), e2 = __ballot(k2 == Tk), e3 = __ballot(k3 == Tk);
        const int need = 8 - (popc64(g0) + popc64(g1) + popc64(g2b) + popc64(g3));
        const int r0 = popc64(e0 & below), r1 = popc64(e0) + popc64(e1 & below), r2 = popc64(e0) + popc64(e1) + popc64(e2 & below), r3 = popc64(e0) + popc64(e1) + popc64(e2) + popc64(e3 & below);
        const bool c0 = (k0 > Tk) || (k0 == Tk && r0 < need), c1 = (k1 > Tk) || (k1 == Tk && r1 < need), c2 = (k2 > Tk) || (k2 == Tk && r2 < need), c3 = (k3 > Tk) || (k3 == Tk && r3 < need);
        const unsigned long long b0 = __ballot(c0), b1 = __ballot(c1), b2 = __ballot(c2), b3 = __ballot(c3);
        float asum = (c0 ? a0 : 0.f) + (c1 ? a1 : 0.f) + (c2 ? a2 : 0.f) + (c3 ? a3 : 0.f);
        asum = wave_sum(asum);
        const float sc = 2.5f / asum;
        const int p0 = popc64(b0 & below), p1 = popc64(b0) + popc64(b1 & below), p2 = popc64(b0) + popc64(b1) + popc64(b2 & below), p3 = popc64(b0) + popc64(b1) + popc64(b2) + popc64(b3 & below);
        if (c0) { le[jt * 8 + p0] = 4 * lane; lw[jt * 8 + p0] = a0 * sc; }
        if (c1) { le[jt * 8 + p1] = 4 * lane + 1; lw[jt * 8 + p1] = a1 * sc; }
        if (c2) { le[jt * 8 + p2] = 4 * lane + 2; lw[jt * 8 + p2] = a2 * sc; }
        if (c3) { le[jt * 8 + p3] = 4 * lane + 3; lw[jt * 8 + p3] = a3 * sc; }
        if (conv) tr_finish(cv, conv_gu_dst(F, cit), 1024, scr, lane);
      }
      { const int t = base + (lane >> 3) * NGW;
        if (t < T) { const int e = le[lane]; const float wv = lw[lane];
            const unsigned p = __hip_atomic_fetch_add(cnt + e, 1u, __ATOMIC_RELAXED, __HIP_MEMORY_SCOPE_AGENT);
            const size_t o = (size_t)t * 8 + (lane & 7); eidx[o] = e; wgt[o] = wv; pos[o] = (int)p; } }
    }
    for (; cj < RT_GU1; ++cj) { const int cit = gw + cj * NGW; if (cit < 65536) tr_item(conv_gu_src(cit), 256, conv_gu_dst(F, cit), 1024, scr, lane); }
}
__device__ __forceinline__ int build_expert_tables(Frame& F, LAS unsigned short* te, LAS int* roff) {
    LAS int* tmp = (LAS int*)(F.lds + LDSX_OFF + 6656);
    const unsigned* cnt = F.ctl + CW_CNT;
    __syncthreads();
    if (F.tid < 256) tmp[F.tid] = (int)((__hip_atomic_load(cnt + F.tid, __ATOMIC_RELAXED, __HIP_MEMORY_SCOPE_AGENT) + 255u) >> 8);
    __syncthreads();
    if (F.tid < 256) { int s = 0; for (int j = 0; j < F.tid; ++j) s += tmp[j]; const int nt = tmp[F.tid];
        for (int i = 0; i < nt; ++i) te[s + i] = (unsigned short)F.tid;
        if (roff) roff[F.tid] = s * 256;
        if (F.tid == 255) tmp[256] = s + nt; }
    __syncthreads();
    return tmp[256];
}
__device__ __forceinline__ void p_fill(Frame& F) {
    LAS unsigned short* te = (LAS unsigned short*)(F.lds + LDSX_OFF); LAS int* roff = (LAS int*)(F.lds + LDSX_OFF + 8192);
    (void)build_expert_tables(F, te, roff);
    const int* eidx = (const int*)(F.ws + WS_ROUTE + RT_EIDX); const float* wgt = (const float*)(F.ws + WS_ROUTE + RT_WGT); const int* pos = (const int*)(F.ws + WS_ROUTE + RT_POS);
    int* rowtok = (int*)(F.ws + WS_ROUTE + RT_ROWTOK); v2u* rowinfo = (v2u*)(F.ws + WS_ROUTE + RT_ROWSLOT);
    for (int i = F.bid * NTHR + F.tid; i < T * TOPK; i += F.G * NTHR) { const int e = eidx[i]; const int r = roff[e] + pos[i]; rowtok[r] = i >> 3; rowinfo[r] = (v2u){(unsigned)i, __float_as_uint(wgt[i])}; }
    const unsigned* cnt = F.ctl + CW_CNT;
    for (int e = F.bid; e < NE; e += F.G) { const int c = (int)__hip_atomic_load(cnt + e, __ATOMIC_RELAXED, __HIP_MEMORY_SCOPE_AGENT), r0 = roff[e] + c, r1 = roff[e] + ((c + 255) & ~255);
        for (int r = r0 + F.tid; r < r1; r += NTHR) { rowtok[r] = 0; rowinfo[r] = (v2u){0xffffffffu, 0u}; } }
    __syncthreads();
}
__device__ __forceinline__ void p_exp_gu(Frame& F) {
    LAS unsigned short* te = (LAS unsigned short*)(F.lds + LDSX_OFF);
    const int ntiles = build_expert_tables(F, te, nullptr);
    pg8::Gemm g{(const bf16*)(F.ws + WS_H1), (const bf16*)(F.ws + WS_EXPGU), 1024};
    pg8::ExpertOrder<2> S{ntiles * 2, F.G, F.bid, te};
    EpiExpGU E{(bf16*)(F.ws + WS_HACT)};
    pg8::gemm_phase<EpiExpGU, pg8::ExpertOrder<2>, true>(F.lds + RING_OFF, g, S, E, (const int*)(F.ws + WS_ROUTE + RT_ROWTOK));
}
__device__ __forceinline__ void p_exp_down(Frame& F) {
    LAS unsigned short* te = (LAS unsigned short*)(F.lds + LDSX_OFF);
    const int ntiles = build_expert_tables(F, te, nullptr);
    pg8::Gemm g{(const bf16*)(F.ws + WS_HACT), (const bf16*)(F.ws + WS_EXPD), 256};
    pg8::ExpertOrder<4> S{ntiles * 4, F.G, F.bid, te};
    EpiExpDown E{(unsigned char*)(F.ws + WS_YR), (const v2u*)(F.ws + WS_ROUTE + RT_ROWSLOT), (unsigned char*)(F.ws + WS_ROUTE + RT_TRASH)};
    pg8::gemm_phase<EpiExpDown, pg8::ExpertOrder<4>, false>(F.lds + RING_OFF, g, S, E, nullptr);
}

template <int STEP>
__device__ __forceinline__ void p_dft(Frame& F) {
    constexpr int K = STEP == 1 ? 128 : 256, NBC = STEP == 1 ? 256 : 128, WM = STEP == 1 ? 1 : 2, WN = 8 / WM;
    constexpr int MT = 128 / WM / 16, NT = NBC / WN / 16, PITCH = NBC + 8, CPR = NBC / 8;
    LAS bf16* Bs = (LAS bf16*)F.lds;
    const bf16* Fb = (const bf16*)(F.ws + WS_F); bf16* Yb = (bf16*)(F.ws + WS_Y); bf16* FM = (bf16*)(F.ws + WS_MIX);
    const int lane = F.lane, r = lane & 15, q = lane >> 4, qp = (lane & 15) >> 2, pp = lane & 3;
    const int wm = F.wave / WN, wn = F.wave % WN;
    bf16x8 af[K / 32][MT];
    if (STEP == 1) {
#pragma unroll
        for (int ks = 0; ks < K / 32; ++ks)
#pragma unroll
            for (int mi = 0; mi < MT; ++mi) af[ks][mi] = *(const bf16x8*)((const bf16*)(F.ws + WS_A1) + (size_t)(wm * (128 / WM) + 16 * mi + r) * K + 32 * ks + 8 * q);
    }
    for (int u = F.bid; u < 1024; u += F.G) {
        const int b = u >> 8, mid = STEP == 1 ? (u >> 1) & 127 : (u >> 2) & 63, n0 = STEP == 1 ? (u & 1) * 256 : (u & 3) * 128;
        if (STEP == 3) { const bf16* A = (const bf16*)(F.ws + WS_A3) + (size_t)mid * 128 * 256;
#pragma unroll
            for (int ks = 0; ks < K / 32; ++ks)
#pragma unroll
                for (int mi = 0; mi < MT; ++mi) af[ks][mi] = *(const bf16x8*)(A + (size_t)(wm * (128 / WM) + 16 * mi + r) * K + 32 * ks + 8 * q); }
        __syncthreads();
        for (int c = F.tid; c < K * CPR; c += NTHR) { const int kk = c / CPR, ch = c % CPR;
            const bf16* src = STEP == 1 ? Fb + (size_t)(b * SEQ + 128 * (kk & 63) + mid) * 1024 + (kk >> 6) * 512 + n0 + ch * 8
                                        : Yb + ((size_t)(b * 64 + mid) * 256 + kk) * 512 + n0 + ch * 8;
            *(LAS v4u*)(Bs + kk * PITCH + ch * 8) = *(const v4u*)src; }
        __syncthreads();
        f32x4 acc[MT][NT];
#pragma unroll
        for (int mi = 0; mi < MT; ++mi)
#pragma unroll
            for (int ni = 0; ni < NT; ++ni) acc[mi][ni] = (f32x4){0.f, 0.f, 0.f, 0.f};
#pragma unroll
        for (int ks = 0; ks < K / 32; ++ks) {
#pragma unroll
            for (int ni = 0; ni < NT; ++ni) { const int n = wn * (NBC / WN) + 16 * ni;
                const s16x4 v0 = __builtin_amdgcn_ds_read_tr16_b64_v4i16((LAS s16x4*)(Bs + (32 * ks + 8 * q + qp) * PITCH + n + 4 * pp));
                const s16x4 v1 = __builtin_amdgcn_ds_read_tr16_b64_v4i16((LAS s16x4*)(Bs + (32 * ks + 8 * q + 4 + qp) * PITCH + n + 4 * pp));
                const bf16x8 xf = {v0[0], v0[1], v0[2], v0[3], v1[0], v1[1], v1[2], v1[3]};
#pragma unroll
                for (int mi = 0; mi < MT; ++mi) acc[mi][ni] = __builtin_amdgcn_mfma_f32_16x16x32_bf16(xf, af[ks][mi], acc[mi][ni], 0, 0, 0); }
        }
#pragma unroll
        for (int mi = 0; mi < MT; ++mi) { const int m = wm * (128 / WM) + 16 * mi + r;
            bf16* drow = STEP == 1 ? Yb + ((((size_t)(b * 64 + (m & 63)) * 128 + mid) * 2 + (m >> 6)) * 512)
                                   : FM + (size_t)(b * SEQ + mid + 64 * m) * 512;
#pragma unroll
            for (int ni = 0; ni < NT; ++ni) { const int n = n0 + wn * (NBC / WN) + 16 * ni + 4 * q; const f32x4 o = acc[mi][ni];
                v2u w; w.x = cvt_pk_bf16_c(o[0], o[1]); w.y = cvt_pk_bf16_c(o[2], o[3]); *(v2u*)(drow + n) = w; } }
    }
    __syncthreads();
}

__device__ __forceinline__ v2u pack4c(const f32x4 o) { v2u w; w.x = cvt_pk_bf16_c(o[0], o[1]); w.y = cvt_pk_bf16_c(o[2], o[3]); return w; }
__device__ __forceinline__ bf16x8 tr8(const LAS bf16* p0, const LAS bf16* p1) {
    const s16x4 a = __builtin_amdgcn_ds_read_tr16_b64_v4i16((LAS s16x4*)p0), b = __builtin_amdgcn_ds_read_tr16_b64_v4i16((LAS s16x4*)p1);
    return (bf16x8){a[0], a[1], a[2], a[3], b[0], b[1], b[2], b[3]};
}
constexpr int HP = 136;
__device__ __forceinline__ void p_hgrn1(Frame& F) {
    LAS bf16* Qd = (LAS bf16*)F.lds; LAS bf16* Ki = Qd + 64 * HP; LAS bf16* Ke = Ki + 64 * HP; LAS bf16* Vs = Ke + 64 * HP; LAS bf16* Sb = Vs + 64 * HP;
    LAS float* tot = (LAS float*)(Sb + 128 * HP); LAS float* dec = tot + 16 * 128;
    const int tid = F.tid, lane = F.lane, r = lane & 15, q = lane >> 4, qp = (lane & 15) >> 2, pp = lane & 3, w = F.wave, tb = w & 3, dh = w >> 2;
    const int d4 = tid & 31, tg = tid >> 5;
    for (int u = F.bid; u < 512; u += F.G) {
        const int sg = u & 15, dir = (u >> 4) & 1, h = (u >> 5) & 3, b = u >> 7;
        const bf16* Qg = (const bf16*)(F.ws + WS_Q) + h * 128; const bf16* Vg = (const bf16*)(F.ws + WS_Q + SEC_STRIDE) + h * 128;
        const bf16* Zg = (const bf16*)(F.ws + WS_Q + (dir ? 3 : 2) * SEC_STRIDE) + h * 128;
        bf16* OL = (bf16*)(F.ws + (dir ? WS_OLB : WS_OLF)) + h * 128; bf16* QS = (bf16*)(F.ws + (dir ? WS_QSB : WS_QSF)) + h * 128;
        const float* lbp = in_ptr(dir ? I_LBB : I_LBF);
        f32x4 lb, G2 = (f32x4){0.f, 0.f, 0.f, 0.f};
        { const f32x4 p0 = *(const f32x4*)(lbp + h * 128 + 4 * d4), p1 = *(const f32x4*)(lbp + 512 + h * 128 + 4 * d4);
#pragma unroll
          for (int c = 0; c < 4; ++c) lb[c] = sigmoidf_(p0[c] - p1[c]); }
        f32x4 sS[8];
#pragma unroll
        for (int nd = 0; nd < 8; ++nd) sS[nd] = (f32x4){0.f, 0.f, 0.f, 0.f};
        __syncthreads();
        for (int i = tid; i < 128 * HP / 8; i += NTHR) ((LAS v4u*)Sb)[i] = (v4u){0u, 0u, 0u, 0u};
#pragma unroll 1
        for (int c = 0; c < 8; ++c) {
            __syncthreads();
            const int tbase = sg * SEG + 64 * c;
            f32x4 qv[4], kv[4], cs[4], run = (f32x4){0.f, 0.f, 0.f, 0.f};
            v2u zr[4], qr[4];
#pragma unroll
            for (int i = 0; i < 4; ++i) { const int pos = tbase + 4 * tg + i; const size_t tok = (size_t)(b * SEQ + (dir ? SEQ - 1 - pos : pos));
                zr[i] = *(const v2u*)(Zg + tok * 512 + 4 * d4); qr[i] = *(const v2u*)(Qg + tok * 512 + 4 * d4); }
#pragma unroll
            for (int i = 0; i < 4; ++i) { const f32x4 z = (f32x4){bflo(zr[i].x), bfhi(zr[i].x), bflo(zr[i].y), bfhi(zr[i].y)};
                qv[i] = (f32x4){bflo(qr[i].x), bfhi(qr[i].x), bflo(qr[i].y), bfhi(qr[i].y)};
#pragma unroll
                for (int e = 0; e < 4; ++e) { const float f = lb[e] + (1.0f - lb[e]) * sigmoidf_(z[e]); kv[i][e] = 1.0f - f; run[e] += __builtin_amdgcn_logf(f); }
                cs[i] = run; }
            *(LAS f32x4*)(tot + tg * 128 + 4 * d4) = run;
            for (int cc = tid; cc < 1024; cc += NTHR) { const int tp = cc >> 4, ch = cc & 15, pos = tbase + tp; const size_t tok = (size_t)(b * SEQ + (dir ? SEQ - 1 - pos : pos));
                *(LAS v4u*)(Vs + tp * HP + ch * 8) = *(const v4u*)(Vg + tok * 512 + ch * 8); }
            __syncthreads();
            f32x4 pre = (f32x4){0.f, 0.f, 0.f, 0.f}, aend = pre;
#pragma unroll
            for (int j = 0; j < 16; ++j) { const f32x4 x = *(const LAS f32x4*)(tot + j * 128 + 4 * d4); aend = aend + x; if (j < tg) pre = pre + x; }
            f32x4 eend, eG;
#pragma unroll
            for (int e = 0; e < 4; ++e) { eend[e] = __builtin_amdgcn_exp2f(aend[e]); eG[e] = __builtin_amdgcn_exp2f(G2[e]); }
#pragma unroll
            for (int i = 0; i < 4; ++i) { const int tp = 4 * tg + i, pos = tbase + tp; const size_t tok = (size_t)(b * SEQ + (dir ? SEQ - 1 - pos : pos));
                f32x4 qd, ki, ke, qs;
#pragma unroll
                for (int e = 0; e < 4; ++e) { const float ea = __builtin_amdgcn_exp2f(pre[e] + cs[i][e]), ei = __builtin_amdgcn_rcpf(ea);
                    qd[e] = qv[i][e] * ea; ki[e] = kv[i][e] * ei; ke[e] = ki[e] * eend[e]; qs[e] = qd[e] * eG[e]; }
                v2u wq, wk, we, ws2; wq.x = cvt_pk_bf16(qd[0], qd[1]); wq.y = cvt_pk_bf16(qd[2], qd[3]); wk.x = cvt_pk_bf16(ki[0], ki[1]); wk.y = cvt_pk_bf16(ki[2], ki[3]);
                we.x = cvt_pk_bf16(ke[0], ke[1]); we.y = cvt_pk_bf16(ke[2], ke[3]); ws2.x = cvt_pk_bf16(qs[0], qs[1]); ws2.y = cvt_pk_bf16(qs[2], qs[3]);
                *(LAS v2u*)(Qd + tp * HP + 4 * d4) = wq; *(LAS v2u*)(Ki + tp * HP + 4 * d4) = wk; *(LAS v2u*)(Ke + tp * HP + 4 * d4) = we;
                *(v2u*)(QS + tok * 512 + 4 * d4) = ws2; }
            if (tg == 0) *(LAS f32x4*)(dec + 4 * d4) = eend;
            G2 = G2 + aend;
            __syncthreads();
            bf16x8 qf[4];
#pragma unroll
            for (int ks = 0; ks < 4; ++ks) qf[ks] = *(const LAS bf16x8*)(Qd + (16 * tb + r) * HP + 32 * ks + 8 * q);
            f32x4 sc[4];
#pragma unroll
            for (int sb = 0; sb < 4; ++sb) { sc[sb] = (f32x4){0.f, 0.f, 0.f, 0.f};
#pragma unroll
                for (int ks = 0; ks < 4; ++ks) { const bf16x8 kf = *(const LAS bf16x8*)(Ki + (16 * sb + r) * HP + 32 * ks + 8 * q); sc[sb] = __builtin_amdgcn_mfma_f32_16x16x32_bf16(kf, qf[ks], sc[sb], 0, 0, 0); }
#pragma unroll
                for (int j = 0; j < 4; ++j) sc[sb][j] = (16 * sb + 4 * q + j > 16 * tb + r) ? 0.f : sc[sb][j]; }
            bf16x8 pf[2];
#pragma unroll
            for (int k2 = 0; k2 < 2; ++k2) { v4u wv; wv.x = cvt_pk_bf16(sc[2 * k2][0], sc[2 * k2][1]); wv.y = cvt_pk_bf16(sc[2 * k2][2], sc[2 * k2][3]);
                wv.z = cvt_pk_bf16(sc[2 * k2 + 1][0], sc[2 * k2 + 1][1]); wv.w = cvt_pk_bf16(sc[2 * k2 + 1][2], sc[2 * k2 + 1][3]); pf[k2] = __builtin_bit_cast(bf16x8, wv); }
            { const int pos = tbase + 16 * tb + r; const size_t tok = (size_t)(b * SEQ + (dir ? SEQ - 1 - pos : pos));
#pragma unroll
            for (int nd = 0; nd < 4; ++nd) { f32x4 o = (f32x4){0.f, 0.f, 0.f, 0.f}; const int cb = 64 * dh + 16 * nd + 4 * pp;
#pragma unroll
                for (int k2 = 0; k2 < 2; ++k2) o = __builtin_amdgcn_mfma_f32_16x16x32_bf16(tr8(Vs + (32 * k2 + 4 * q + qp) * HP + cb, Vs + (32 * k2 + 16 + 4 * q + qp) * HP + cb), pf[k2], o, 0, 0, 0);
#pragma unroll
                for (int ks = 0; ks < 4; ++ks) o = __builtin_amdgcn_mfma_f32_16x16x32_bf16(tr8(Sb + (32 * ks + 8 * q + qp) * HP + cb, Sb + (32 * ks + 8 * q + 4 + qp) * HP + cb), qf[ks], o, 0, 0, 0);
                *(v2u*)(OL + tok * 512 + 64 * dh + 16 * nd + 4 * q) = pack4c(o); } }
            { const float dc = dec[16 * w + r];
#pragma unroll
            for (int nd = 0; nd < 8; ++nd) { sS[nd] = sS[nd] * dc;
#pragma unroll
                for (int k2 = 0; k2 < 2; ++k2) sS[nd] = __builtin_amdgcn_mfma_f32_16x16x32_bf16(tr8(Vs + (32 * k2 + 8 * q + qp) * HP + 16 * nd + 4 * pp, Vs + (32 * k2 + 8 * q + 4 + qp) * HP + 16 * nd + 4 * pp),
                                                                                              tr8(Ke + (32 * k2 + 8 * q + qp) * HP + 16 * w + 4 * pp, Ke + (32 * k2 + 8 * q + 4 + qp) * HP + 16 * w + 4 * pp), sS[nd], 0, 0, 0); } }
            __syncthreads();
#pragma unroll
            for (int nd = 0; nd < 8; ++nd) *(LAS v2u*)(Sb + (16 * w + r) * HP + 16 * nd + 4 * q) = pack4c(sS[nd]);
        }
        float* U = (float*)(F.ws + WS_U) + (size_t)u * 16384;
#pragma unroll
        for (int nd = 0; nd < 8; ++nd) *(f32x4*)(U + (16 * w + r) * 128 + 16 * nd + 4 * q) = sS[nd];
        if (tg == 0) { f32x4 dg; dg[0] = __builtin_amdgcn_exp2f(G2[0]); dg[1] = __builtin_amdgcn_exp2f(G2[1]); dg[2] = __builtin_amdgcn_exp2f(G2[2]); dg[3] = __builtin_amdgcn_exp2f(G2[3]); *(f32x4*)((float*)(F.ws + WS_DEC) + u * 128 + 4 * d4) = dg; }
    }
    __syncthreads();
}
__device__ __forceinline__ void p_hgrn_scan(Frame& F) {
    const float* U = (const float*)(F.ws + WS_U); const float* DEC = (const float*)(F.ws + WS_DEC); bf16* SST = (bf16*)(F.ws + WS_SST);
    for (int it = F.bid * NTHR + F.tid; it < 32 * 128 * 32; it += F.G * NTHR) {
        const int cmb = it >> 12, dk = (it >> 5) & 127, dv4 = it & 31;
        f32x4 st = (f32x4){0.f, 0.f, 0.f, 0.f};
#pragma unroll 4
        for (int sg = 0; sg < NSEG; ++sg) { const size_t un = (size_t)(cmb * 16 + sg);
            v2u wv; wv.x = cvt_pk_bf16(st[0], st[1]); wv.y = cvt_pk_bf16(st[2], st[3]); *(v2u*)(SST + un * 16384 + dk * 128 + dv4 * 4) = wv;
            const float dcy = DEC[un * 128 + dk]; const f32x4 uu = *(const f32x4*)(U + un * 16384 + dk * 128 + dv4 * 4); st = st * dcy + uu; }
    }
}
__device__ __forceinline__ void p_hgrn2(Frame& F) {
    LAS bf16* Sf = (LAS bf16*)F.lds; LAS bf16* Sw = Sf + 128 * HP;
    const int lane = F.lane, r = lane & 15, q = lane >> 4, qp = (lane & 15) >> 2, pp = lane & 3;
    const bf16* SST = (const bf16*)(F.ws + WS_SST);
    for (int u = F.bid; u < 512; u += F.G) {
        const int tile = u & 31, h = (u >> 5) & 3, b = u >> 7;
        const int unf = ((b * 4 + h) * 2 + 0) * 16 + (tile >> 1), unb = ((b * 4 + h) * 2 + 1) * 16 + ((31 - tile) >> 1);
        __syncthreads();
        for (int c = F.tid; c < 128 * 16; c += NTHR) { const int dk = c >> 4, ch = c & 15;
            *(LAS v4u*)(Sf + dk * HP + ch * 8) = *(const v4u*)(SST + (size_t)unf * 16384 + dk * 128 + ch * 8);
            *(LAS v4u*)(Sw + dk * HP + ch * 8) = *(const v4u*)(SST + (size_t)unb * 16384 + dk * 128 + ch * 8); }
        __syncthreads();
        const float* ng = in_ptr(I_HNG) + h * 128;
#pragma unroll 1
        for (int mq = 0; mq < 2; ++mq) {
            const size_t tok = (size_t)(b * SEQ + tile * 256 + F.wave * 32 + 16 * mq + r);
            const bf16* qsf = (const bf16*)(F.ws + WS_QSF) + tok * 512 + h * 128 + 8 * q; const bf16* qsb = (const bf16*)(F.ws + WS_QSB) + tok * 512 + h * 128 + 8 * q;
            bf16x8 ff[4], fb[4];
#pragma unroll
            for (int ks = 0; ks < 4; ++ks) { ff[ks] = *(const bf16x8*)(qsf + 32 * ks); fb[ks] = *(const bf16x8*)(qsb + 32 * ks); }
            f32x4 o[8]; float ss = 0.f;
            const size_t rb = tok * 512 + h * 128 + 4 * q;
#pragma unroll
            for (int nd = 0; nd < 8; ++nd) { f32x4 a = (f32x4){0.f, 0.f, 0.f, 0.f}; const int cb = 16 * nd + 4 * pp;
#pragma unroll
                for (int ks = 0; ks < 4; ++ks) { a = __builtin_amdgcn_mfma_f32_16x16x32_bf16(tr8(Sf + (32 * ks + 8 * q + qp) * HP + cb, Sf + (32 * ks + 8 * q + 4 + qp) * HP + cb), ff[ks], a, 0, 0, 0);
                    a = __builtin_amdgcn_mfma_f32_16x16x32_bf16(tr8(Sw + (32 * ks + 8 * q + qp) * HP + cb, Sw + (32 * ks + 8 * q + 4 + qp) * HP + cb), fb[ks], a, 0, 0, 0); }
                const v2u lf = *(const v2u*)((const bf16*)(F.ws + WS_OLF) + rb + 16 * nd), lw = *(const v2u*)((const bf16*)(F.ws + WS_OLB) + rb + 16 * nd);
                a[0] += bflo(lf.x) + bflo(lw.x); a[1] += bfhi(lf.x) + bfhi(lw.x); a[2] += bflo(lf.y) + bflo(lw.y); a[3] += bfhi(lf.y) + bfhi(lw.y);
                ss += (a[0] * a[0] + a[1] * a[1]) + (a[2] * a[2] + a[3] * a[3]); o[nd] = a; }
            ss += __shfl_xor(ss, 16); ss += __shfl_xor(ss, 32);
            const float rs = 1.0f / sqrtf(ss * (1.0f / 128.0f) + LN_EPS);
#pragma unroll
            for (int nd = 0; nd < 8; ++nd) { const f32x4 gn = *(const f32x4*)(ng + 16 * nd + 4 * q); const v2u gw = *(const v2u*)((const bf16*)(F.ws + WS_Q + 4 * SEC_STRIDE) + rb + 16 * nd);
                f32x4 y; y[0] = o[nd][0] * rs * gn[0] * bflo(gw.x); y[1] = o[nd][1] * rs * gn[1] * bfhi(gw.x); y[2] = o[nd][2] * rs * gn[2] * bflo(gw.y); y[3] = o[nd][3] * rs * gn[3] * bfhi(gw.y);
                v2u wv; wv.x = cvt_pk_bf16(y[0], y[1]); wv.y = cvt_pk_bf16(y[2], y[3]); *(v2u*)((bf16*)(F.ws + WS_MIX) + (size_t)T * 512 + rb + 16 * nd) = wv; }
        }
    }
    __syncthreads();
}
struct Args { const float* in[29]; float* out; unsigned char* ws; };
__global__ void __launch_bounds__(NTHR, 2) fwd(Args args) {
    extern __shared__ __attribute__((aligned(16))) unsigned char lds[];
    Frame F;
    F.lds = (LAS unsigned char*)lds;
    F.tid = threadIdx.x; F.lane = F.tid & 63; F.wave = __builtin_amdgcn_readfirstlane(F.tid >> 6);
    F.G = gridDim.x; F.bid = blockIdx.x;
    F.ws = args.ws; F.ctl = (unsigned*)(args.ws + WS_CTL); F.out = args.out;
    if (F.tid < 64) ((LAS unsigned*)(F.lds + LDSCTL_OFF))[F.tid] = 0u;
    __syncthreads();
    XcdBarrier bar = xcd_barrier_post(F.ctl + CW_BAR, (volatile LAS unsigned*)(F.lds + LDSCTL_OFF + 32));
#define GRID_BAR(d0, d1, g0, g1) do { gbar_arrive(bar); conv_slice(F, d0, d1, g0, g1); gbar_wait(bar); } while (0)
#define GRID_BAR_X(extra, d0, d1, g0, g1) do { gbar_arrive(bar); extra; conv_slice(F, d0, d1, g0, g1); gbar_wait(bar); } while (0)
#ifndef DUP
#define DUP 0
#endif
#define PH(id, call) do { call; if (DUP == (id)) { __syncthreads(); call; } } while (0)
    PH(1, p0_prologue(F));
    GRID_BAR_X(p0_late(F), 0, 1, 0, 0);
    PH(2, p_proj(F));
    PH(3, p_kv(F));
    GRID_BAR(1, 4, 0, 0);
    PH(4, p_xattn(F));
    PH(5, p_dft<1>(F));
    PH(6, p_hgrn1(F));
    GRID_BAR(4, 6, 0, 0);
    PH(7, p_dft<3>(F));
    PH(8, p_hgrn_scan(F));
    GRID_BAR(6, 8, 0, 0);
    PH(9, p_hgrn2(F));
    GRID_BAR(8, 10, 0, 0);
    PH(10, p_branch(F));
    GRID_BAR(10, 12, 0, 0);
    PH(11, p_wout(F));
    GRID_BAR(12, 13, 0, 4);
    PH(12, p_ln1(F));
    conv_slice(F, 16, 16, RT_GU1, -1);
    GRID_BAR(13, 14, 4, 8);
    PH(14, p_router_shared(F));
    GRID_BAR(14, 15, 8, 12);
    p_routing(F);
    GRID_BAR(15, 16, 12, 16);
    PH(16, p_fill(F));
    PH(17, p_shared_down(F));
    GRID_BAR(16, -1, 0, 0);
    PH(18, p_exp_gu(F));
    GRID_BAR(0, 0, 0, 0);
    PH(19, p_exp_down(F));
    PH(30, GRID_BAR(0, 0, 0, 0));
    PH(20, p_final<true>(F));
}

extern "C" void kernel_launch(void* const* d_in, const int* in_sizes, int n_in, void* d_out, int out_size, void* d_ws, size_t ws_size, hipStream_t stream) {
    static int grid = 0;
    if (grid == 0) {
        int dev = 0, cus = 0, per_cu = 0;
        if (n_in != 29 || ws_size < WS_END) { fprintf(stderr, "kernel_launch: unexpected n_in %d / ws_size %zu\n", n_in, ws_size); }
        if (hipGetDevice(&dev) != hipSuccess || hipDeviceGetAttribute(&cus, hipDeviceAttributeMultiprocessorCount, dev) != hipSuccess) { grid = -1; return; }
        if (hipFuncSetAttribute((const void*)fwd, hipFuncAttributeMaxDynamicSharedMemorySize, LDS_BYTES) != hipSuccess) { grid = -1; return; }
        if (hipOccupancyMaxActiveBlocksPerMultiprocessor(&per_cu, (const void*)fwd, NTHR, LDS_BYTES) != hipSuccess || per_cu < 1) fprintf(stderr, "kernel_launch: occupancy query says %d\n", per_cu);
        (void)hipGetLastError();
        grid = cus;
    }
    if (grid < 0) return;
    (void)hipMemsetAsync((char*)d_ws + WS_CTL, 0, CTL_ZERO_BYTES, stream);
    Args a{};
    for (int i = 0; i < 29; ++i) a.in[i] = (const float*)d_in[i];
    a.out = (float*)d_out; a.ws = (unsigned char*)d_ws;
    hipLaunchKernelGGL(fwd, dim3(grid), dim3(NTHR), LDS_BYTES, stream, a);
}
```

```cpp
#include <hip/hip_runtime.h>
#include <cstdio>
#include <cstdint>

#define GAS __attribute__((address_space(1)))
#define LAS __attribute__((address_space(3)))
typedef unsigned short bf16;
typedef unsigned v4u __attribute__((ext_vector_type(4)));
typedef unsigned v2u __attribute__((ext_vector_type(2)));
typedef float f32x4 __attribute__((ext_vector_type(4)));
typedef float f32x2 __attribute__((ext_vector_type(2)));
typedef short bf16x8 __attribute__((ext_vector_type(8)));
typedef short s16x4 __attribute__((ext_vector_type(4)));

constexpr int NB = 4, SEQ = 8192, D = 1024, T = NB * SEQ, MEM = 256;
constexpr int NPROJ = 7168;
constexpr int NE = 256, TOPK = 8, FF = 256;
constexpr float LN_EPS = 1e-5f;
constexpr float YSCALE = 128.f;
constexpr float ALPHA = 1.189207115002721f;
constexpr int NWAVES = 8, NTHR = 512;
constexpr int SEG = 512, NSEG = SEQ / SEG, CH = 64;

constexpr size_t MiB = 1u << 20;
constexpr size_t WS_CTL = 0, CTL_ZERO_BYTES = 1 * MiB;
constexpr size_t WS_WIN = 1 * MiB;
constexpr size_t WS_WKV = 15 * MiB;
constexpr size_t WS_WFO = 17 * MiB;
constexpr size_t WS_WHO = 18 * MiB;
constexpr size_t WS_WXO = 19 * MiB;
constexpr size_t WS_WOUT = 20 * MiB;
constexpr size_t WS_WRS = 22 * MiB;
constexpr size_t WS_WSD = 24 * MiB;
constexpr size_t WS_A1 = 25 * MiB;
constexpr size_t WS_A3 = 26 * MiB;
constexpr size_t WS_MEMN = 30 * MiB;
constexpr size_t WS_H0 = 32 * MiB;
constexpr size_t WS_F = 96 * MiB;
constexpr size_t WS_MERGED = 96 * MiB;
constexpr size_t WS_WBR = 17 * MiB;
constexpr size_t WS_Q = 160 * MiB;
constexpr size_t SEC_STRIDE = 32 * MiB;
constexpr size_t WS_GATES = 352 * MiB;
constexpr size_t WS_KV = 544 * MiB;
constexpr size_t WS_Y = 546 * MiB;
constexpr size_t WS_MIX = 610 * MiB;
constexpr size_t WS_OLF = 706 * MiB, WS_OLB = 738 * MiB;
constexpr size_t WS_QSF = 770 * MiB, WS_QSB = 802 * MiB;
constexpr size_t WS_U = 834 * MiB;
constexpr size_t WS_DEC = 866 * MiB;
constexpr size_t WS_SST = 867 * MiB;
constexpr size_t WS_EXPD = 883 * MiB;
constexpr size_t WS_LOGIT = 32 * MiB;
constexpr size_t WS_HS = 64 * MiB;
constexpr size_t WS_ROUTE = 80 * MiB;
constexpr size_t WS_S2 = 96 * MiB;
constexpr size_t WS_S1 = 160 * MiB;
constexpr size_t WS_HACT = 160 * MiB;
constexpr size_t WS_EXPGU = 546 * MiB;
constexpr size_t WS_YR = 546 * MiB;
constexpr size_t WS_H1 = 802 * MiB;
constexpr size_t WS_END = 1024 * MiB;
constexpr size_t RT_EIDX = 0, RT_WGT = 1 * MiB, RT_POS = 2 * MiB, RT_ROWTOK = 3 * MiB, RT_ROWSLOT = 5 * MiB, RT_ROWGATE = 6 * MiB + 512 * 1024, RT_TRASH = 7 * MiB + 768 * 1024;
constexpr int RPAD_MAX = T * TOPK + NE * 255;
constexpr int CW_BAR = 4096;
constexpr int CW_CNT = 16384;

#define LDS_WAIT() asm volatile("s_waitcnt lgkmcnt(0)" ::: "memory")
#define VM_WAIT() asm volatile("s_waitcnt vmcnt(0)" ::: "memory")
typedef __bf16 bf16x2v __attribute__((ext_vector_type(2)));
__device__ __forceinline__ unsigned cvt_pk_bf16_c(float lo, float hi) { const f32x2 v = {lo, hi}; const bf16x2v b = __builtin_convertvector(v, bf16x2v); return __builtin_bit_cast(unsigned, b); }
__device__ __forceinline__ unsigned cvt_pk_bf16(float lo, float hi) { unsigned r; asm volatile("v_cvt_pk_bf16_f32 %0, %1, %2" : "=v"(r) : "v"(lo), "v"(hi)); return r; }
__device__ __forceinline__ float bflo(unsigned w) { return __uint_as_float(w << 16); }
__device__ __forceinline__ float bfhi(unsigned w) { return __uint_as_float(w & 0xffff0000u); }
__device__ __forceinline__ float bf2f(bf16 h) { return __uint_as_float(((unsigned)h) << 16); }
__device__ __forceinline__ bf16 f2bf(float f) { return (bf16)(cvt_pk_bf16(f, 0.f) & 0xffffu); }
__device__ __forceinline__ float sigmoidf_(float x) { return __builtin_amdgcn_rcpf(1.0f + __builtin_amdgcn_exp2f(-1.4426950408889634f * x)); }
__device__ __forceinline__ float siluf_(float x) { return x * __builtin_amdgcn_rcpf(1.0f + __builtin_amdgcn_exp2f(-1.4426950408889634f * x)); }
__device__ __forceinline__ float wave_sum(float v) {
#pragma unroll
    for (int o = 1; o < 64; o <<= 1) v += __shfl_xor(v, o);
    return v;
}

#define XB_TMO      128
#define XB_XCNT(j)  (256  + 64 * (j))
#define XB_XSUB(j)  (1280 + 64 * (j))
#define XB_XGEN(j)  (2304 + 64 * (j))
#define XB_TOP      3328
#define XB_TOPGEN   3392
#define XCD_BAR_WORDS 3456
#define XB_SPIN_CAP (1u << 22)
__device__ __forceinline__ unsigned xb_ld(unsigned* p)              { return __hip_atomic_load(p, __ATOMIC_RELAXED, __HIP_MEMORY_SCOPE_AGENT); }
__device__ __forceinline__ unsigned xb_add(unsigned* p, unsigned v) { return __hip_atomic_fetch_add(p, v, __ATOMIC_RELAXED, __HIP_MEMORY_SCOPE_AGENT); }
__device__ __forceinline__ unsigned xb_xcc_id() { return (unsigned)__builtin_amdgcn_s_getreg((3 << 11) | 20) & 0xFu; }
#define XB_SPIN(cond, bar) do { unsigned _sp = 0; while (cond) { __builtin_amdgcn_s_sleep(1); \
    if ((++_sp & 255u) == 0u) { if (xb_ld(&(bar)[XB_TMO])) break; if (_sp > XB_SPIN_CAP) { atomicAdd(&(bar)[XB_TMO], 1u); break; } } } } while (0)
struct XcdBarrier { unsigned* bar; unsigned x; volatile LAS unsigned* st; };
__device__ __forceinline__ XcdBarrier xcd_barrier_post(unsigned* bar, volatile LAS unsigned* st) {
    XcdBarrier b; b.bar = bar; b.x = xb_xcc_id(); b.st = st;
    if (threadIdx.x == 0) (void)xb_add(&bar[XB_XCNT(b.x)], 1u);
    return b;
}
__device__ __forceinline__ void xcd_barrier_complete(unsigned* bar, unsigned x, unsigned& nloc, unsigned& nx) {
    const unsigned G = gridDim.x * gridDim.y * gridDim.z;
    unsigned sum, cnt, mine, sp = 0u;
    for (;;) {
        sum = 0u; cnt = 0u; mine = 0u;
#pragma unroll
        for (unsigned j = 0; j < 16; ++j) { const unsigned c = xb_ld(&bar[XB_XCNT(j)]); sum += c; cnt += (c > 0u) ? 1u : 0u; mine = (j == x) ? c : mine; }
        if (sum == G) break;
        __builtin_amdgcn_s_sleep(1);
        if ((++sp & 255u) == 0u) { if (xb_ld(&bar[XB_TMO])) break; if (sp > XB_SPIN_CAP) { atomicAdd(&bar[XB_TMO], 1u); break; } }
    }
    nloc = mine > 0u ? mine : 1u; nx = cnt > 0u ? cnt : 1u;
}
__device__ __forceinline__ void xcd_barrier(const XcdBarrier& b) {
    asm volatile("s_waitcnt vmcnt(0)" ::: "memory");
    __syncthreads();
    if (threadIdx.x == 0) {
        unsigned* bar = b.bar;
        __builtin_amdgcn_s_waitcnt(0);
        unsigned nloc = b.st[0], nx = b.st[1];
        if (nloc == 0u) { xcd_barrier_complete(bar, b.x, nloc, nx); b.st[0] = nloc; b.st[1] = nx; }
        const unsigned old = xb_add(&bar[XB_XSUB(b.x)], 1u);
        const unsigned gen = old / nloc;
        if (old + 1u == (gen + 1u) * nloc) {
            __builtin_amdgcn_fence(__ATOMIC_RELEASE, "agent");
            asm volatile("s_waitcnt vmcnt(0)" ::: "memory");
            const unsigned og = xb_add(&bar[XB_TOP], 1u);
            const unsigned tg = og / nx;
            if (og + 1u == (tg + 1u) * nx) xb_add(&bar[XB_TOPGEN], 1u);
            else XB_SPIN(xb_ld(&bar[XB_TOPGEN]) == tg, bar);
            __builtin_amdgcn_fence(__ATOMIC_ACQUIRE, "agent");
            xb_add(&bar[XB_XGEN(b.x)], 1u);
            asm volatile("s_waitcnt vmcnt(0)" ::: "memory");
        } else {
            XB_SPIN(xb_ld(&bar[XB_XGEN(b.x)]) == gen, bar);
            __builtin_amdgcn_fence(__ATOMIC_ACQUIRE, "agent");
            asm volatile("s_waitcnt vmcnt(0)" ::: "memory");
        }
    }
    __syncthreads();
}

namespace pg8 {
constexpr int BM = 256, BK = 64, HALF = 128, HTB = HALF * BK * 2, STAGE_BYTES = 8 * HTB, NXCD = 8, WGM = 8;
__host__ __device__ __forceinline__ int lds_byte(int r, int c) { const int st = (r >> 4) * 2 + (c >> 5), rr = r & 15, cc = c & 31, ob = rr * 64 + cc * 2; return st * 1024 + (ob ^ (((ob >> 9) & 1) << 5)); }
__host__ __device__ __forceinline__ void stage_rc(int b, int& R, int& C) { const int st = b / 1024, sb = b % 1024, swz = sb ^ (((sb >> 9) & 1) << 5); R = (st >> 1) * 16 + swz / 64; C = (st & 1) * 32 + (swz % 64) / 2; }
__host__ __device__ __forceinline__ int perm32(int rho) { const int n = rho >> 4, i = rho & 15; return 8 * (i >> 2) + 4 * n + (i & 3); }
struct Unit { int pm, pn; };
struct Gemm { const bf16* A; const bf16* Bt; int K; };
struct StaticOrder {
    int nM, nN, nwg, G, c;
    __device__ void init(int M, int N, int G_, int c_) { nM = M / BM; nN = N / BM; nwg = nM * nN; G = G_; c = c_; }
    __device__ bool next(int i, Unit& u) const {
        const long L = (long)i * G + c; if (L >= nwg) return false;
        int wgid = (int)L; { const int q = nwg / NXCD, r = nwg % NXCD, xcd = wgid % NXCD, off = wgid / NXCD; wgid = (xcd < r ? xcd * (q + 1) : r * (q + 1) + (xcd - r) * q) + off; }
        const int nig = WGM * nN, gid = wgid / nig, fm = gid * WGM, gsz = (nM - fm) < WGM ? (nM - fm) : WGM;
        u.pm = fm + ((wgid % nig) % gsz); u.pn = (wgid % nig) / gsz; return true;
    }
};
template <int J> struct ExpertOrder {
    int nunits, G, c; const LAS unsigned short* te;
    __device__ bool next(int i, Unit& u) const {
        const int nb = G >> 3, tpx = nb / J, x = c & 7, k = c >> 3;
        int tau, j;
        if ((G & 7) == 0 && tpx * J == nb) { tau = (i * 8 + x) * tpx + k / J; j = k % J; }
        else { const int L = i * G + c; tau = L / J; j = L - tau * J; }
        if (tau * J + j >= nunits) return false;
        u.pm = tau; u.pn = (int)te[tau] * J + j; return true;
    }
};
template <class Epi, class Sched, bool GATHER>
__device__ __forceinline__ void gemm_phase(LAS unsigned char* lds, const Gemm g, const Sched& S, const Epi& E, const int* rowidx) {
    int tid_ = threadIdx.x; asm volatile("" : "+v"(tid_));
    const int tid = tid_, wid = __builtin_amdgcn_readfirstlane(tid >> 6), lane = tid & 63, wr = wid >> 2, wc = wid & 3, fr = lane & 15, fq = lane >> 4;
    const int K = g.K, nt = K / BK;
    unsigned voffB[2], voffC[2][2];
    LAS v4u* gsl = (LAS v4u*)(lds + STAGE_BYTES + 8192) + tid;
    const size_t kstep = (size_t)(BK * 2);
    const size_t hstep = (size_t)HALF * K * 2;
    const size_t tstep = 2 * hstep;
#pragma unroll
    for (int i = 0; i < 2; ++i) { int R, C; stage_rc(tid * 16 + i * 8192, R, C); const int Rb = Epi::PERM ? ((R & ~31) + perm32(R & 31)) : R;
        voffB[i] = (unsigned)(Rb * K + C) * 2u; voffC[0][i] = (unsigned)(R * K + C) * 2u; voffC[1][i] = voffC[0][i] + (unsigned)hstep; }
    const unsigned ldsw = (unsigned)wid * 1024u;
    const int aoff = lds_byte(wr * 64 + fr, fq * 8), boff = lds_byte(wc * 32 + fr, fq * 8);
#define PG8_SA(b, h) (((b) * 2 + (h)) * HTB)
#define PG8_SB(b, h) ((4 + (b) * 2 + (h)) * HTB)
#define PG8_STAGE(bufoff, gbase, voff) do { const char* _gb = (const char*)(gbase); _Pragma("unroll") for (int _i = 0; _i < 2; ++_i) { unsigned _keep; \
        asm volatile("s_mov_b32 %0, m0\n\ts_mov_b32 m0, %3\n\ts_nop 0\n\tglobal_load_lds_dwordx4 %1, %2\n\ts_mov_b32 m0, %0" : "=&s"(_keep) : "v"((voff)[_i]), "s"(_gb), "s"((unsigned)(size_t)(lds + (bufoff) + ldsw + _i * 8192)) : "memory"); } } while (0)
#define PG8_LDA(dst, b, h) do { _Pragma("unroll") for (int m = 0; m < 4; ++m) _Pragma("unroll") for (int k = 0; k < 2; ++k) dst[m][k] = *(const LAS bf16x8*)(lds + PG8_SA(b, h) + aoff + m * 2048 + k * 1024); } while (0)
#define PG8_LDB(dst, b, h) do { _Pragma("unroll") for (int n = 0; n < 2; ++n) _Pragma("unroll") for (int k = 0; k < 2; ++k) dst[n][k] = *(const LAS bf16x8*)(lds + PG8_SB(b, h) + boff + n * 2048 + k * 1024); } while (0)
#define PG8_MMA(ai, bj, At, Bt) do { __builtin_amdgcn_s_setprio(1); _Pragma("unroll") for (int m = 0; m < 4; ++m) _Pragma("unroll") for (int n = 0; n < 2; ++n) _Pragma("unroll") for (int k = 0; k < 2; ++k) \
        acc[ai][bj][m][n] = __builtin_amdgcn_mfma_f32_16x16x32_bf16(Bt[n][k], At[m][k], acc[ai][bj][m][n], 0, 0, 0); __builtin_amdgcn_s_setprio(0); } while (0)
#define PG8_WAIT_V(n) asm volatile("s_waitcnt vmcnt(" #n ")" ::: "memory")
#define PG8_WAIT_L(n) asm volatile("s_waitcnt lgkmcnt(" #n ")" ::: "memory")
#define PG8_BAR __builtin_amdgcn_s_barrier()
#define PG8_SCHED __builtin_amdgcn_sched_barrier(0)
#define PG8_GSTORE(set, u) do { unsigned _v[2][2]; _Pragma("unroll") for (int _i = 0; _i < 2; ++_i) { int _R, _C; stage_rc(tid * 16 + _i * 8192, _R, _C); \
        _Pragma("unroll") for (int _h = 0; _h < 2; ++_h) _v[_h][_i] = ((unsigned)rowidx[(u).pm * BM + _h * HALF + _R] * (unsigned)K + (unsigned)_C) * 2u; } \
        gsl[(set) * 512] = (v4u){_v[0][0], _v[0][1], _v[1][0], _v[1][1]}; } while (0)
#define PG8_GRD(dst, h, set) unsigned dst[2]; do { if constexpr (GATHER) { const v2u _o = ((const LAS v2u*)(gsl + (set) * 512))[h]; dst[0] = _o.x; dst[1] = _o.y; } else { dst[0] = voffC[h][0]; dst[1] = voffC[h][1]; } } while (0)
    Unit cur, nxt; int ui = 0;
    if (!S.next(0, cur)) return;
    f32x4 acc[2][2][4][2];
#pragma unroll
    for (int a = 0; a < 2; ++a)
#pragma unroll
        for (int b = 0; b < 2; ++b)
#pragma unroll
            for (int m = 0; m < 4; ++m)
#pragma unroll
                for (int n = 0; n < 2; ++n) acc[a][b][m][n] = (f32x4){0.f, 0.f, 0.f, 0.f};
    bf16x8 At[4][2], B0[2][2], B1[2][2];
    const char* cA = GATHER ? (const char*)g.A : (const char*)g.A + (size_t)cur.pm * tstep; const char* cB = (const char*)g.Bt + (size_t)cur.pn * tstep;
    int par = 0;
    LAS v2u* const rib = (LAS v2u*)(lds + STAGE_BYTES + 2560);
    if constexpr (GATHER) { PG8_GSTORE(0, cur); }
    if constexpr (Epi::PRE) E.pre(cur, rib, tid);
    { PG8_GRD(p0, 0, 0); PG8_GRD(p1, 1, 0);
    PG8_STAGE(PG8_SB(0, 0), cB, voffB); PG8_STAGE(PG8_SB(0, 1), cB + hstep, voffB); PG8_STAGE(PG8_SA(0, 0), cA, p0); PG8_STAGE(PG8_SA(0, 1), cA, p1);
    if (wr == 1) PG8_BAR;
    PG8_WAIT_V(2); PG8_BAR;
    PG8_STAGE(PG8_SB(1, 0), cB + kstep, voffB); PG8_STAGE(PG8_SA(1, 0), cA + kstep, p0); PG8_STAGE(PG8_SB(1, 1), cB + hstep + kstep, voffB); }
    PG8_WAIT_V(6); PG8_BAR;
    for (;;) {
        const bool has_next = S.next(ui + 1, nxt);
        const char* nA = GATHER ? (const char*)g.A : (has_next ? (const char*)g.A + (size_t)nxt.pm * tstep : cA); const char* nB = has_next ? (const char*)g.Bt + (size_t)nxt.pn * tstep : cB;
        if constexpr (GATHER) { if (has_next) { PG8_GSTORE(par ^ 1, nxt); } else { gsl[(par ^ 1) * 512] = gsl[par * 512]; } }
        for (int t = 0; t < nt; t += 2) {
            const bool last = (t == nt - 2);
            const char* a1 = cA + (size_t)(t + 1) * kstep;
            const char* a2 = last ? nA : cA + (size_t)(t + 2) * kstep; const char* b2 = last ? nB : cB + (size_t)(t + 2) * kstep;
            const char* a3 = a2 + kstep; const char* b3 = b2 + kstep;
            const int s2 = (GATHER && last) ? (par ^ 1) : par;
            { PG8_GRD(o, 1, par); PG8_LDB(B0, 0, 0); PG8_LDB(B1, 0, 1); PG8_SCHED; PG8_LDA(At, 0, 0); PG8_STAGE(PG8_SA(1, 1), a1, o); }
            PG8_WAIT_V(8); PG8_WAIT_L(0); PG8_BAR; PG8_MMA(0, 0, At, B0); PG8_MMA(0, 1, At, B1); PG8_BAR; PG8_SCHED;
            { PG8_GRD(o, 0, s2); PG8_LDA(At, 0, 1); PG8_STAGE(PG8_SB(0, 0), b2, voffB); PG8_STAGE(PG8_SB(0, 1), b2 + hstep, voffB); PG8_STAGE(PG8_SA(0, 0), a2, o); }
            PG8_WAIT_V(8); PG8_WAIT_L(0); PG8_BAR; PG8_MMA(1, 0, At, B0); PG8_MMA(1, 1, At, B1); PG8_BAR; PG8_SCHED;
            { PG8_GRD(o, 1, s2); PG8_LDB(B0, 1, 0); PG8_LDB(B1, 1, 1); PG8_SCHED; PG8_LDA(At, 1, 0); PG8_STAGE(PG8_SA(0, 1), a2, o); }
            PG8_WAIT_V(8); PG8_WAIT_L(0); PG8_BAR; PG8_MMA(0, 0, At, B0); PG8_MMA(0, 1, At, B1); PG8_BAR; PG8_SCHED;
            { PG8_GRD(o, 0, s2); PG8_LDA(At, 1, 1); PG8_STAGE(PG8_SB(1, 0), b3, voffB); PG8_STAGE(PG8_SB(1, 1), b3 + hstep, voffB); PG8_STAGE(PG8_SA(1, 0), a3, o); }
            PG8_WAIT_V(8); PG8_WAIT_L(0); PG8_BAR; PG8_MMA(1, 0, At, B0); PG8_MMA(1, 1, At, B1); PG8_BAR; PG8_SCHED;
        }
        if (wr == 0) PG8_BAR;
        asm volatile("s_nop 15\n\ts_nop 15" ::: "memory");
        if constexpr (Epi::PRE) E(acc, cur, wr, wc, fr, fq, rib + par * 256); else E(acc, cur, wr, wc, fr, fq);
        if (!has_next) break;
        bool zero = true;
        if constexpr (Epi::CHAIN) zero = !E.keep(cur);
        if (zero) {
#pragma unroll
        for (int a = 0; a < 2; ++a)
#pragma unroll
            for (int b = 0; b < 2; ++b)
#pragma unroll
                for (int m = 0; m < 4; ++m)
#pragma unroll
                    for (int n = 0; n < 2; ++n) acc[a][b][m][n] = (f32x4){0.f, 0.f, 0.f, 0.f};
        }
        cur = nxt; cA = nA; cB = nB; ++ui; par ^= 1;
        if constexpr (Epi::PRE) E.pre(cur, rib + par * 256, tid);
        if (wr == 1) PG8_BAR;
    }
    PG8_WAIT_V(0);
    PG8_BAR;
#undef PG8_SA
#undef PG8_SB
#undef PG8_STAGE
#undef PG8_LDA
#undef PG8_LDB
#undef PG8_MMA
#undef PG8_WAIT_V
#undef PG8_WAIT_L
#undef PG8_BAR
#undef PG8_SCHED
#undef PG8_GSTORE
#undef PG8_GRD
}
}
using pg8::Unit;

typedef f32x4 AccT[2][2][4][2];
__device__ __forceinline__ v4u pack8(const f32x4 a, const f32x4 b) { v4u w; w.x = cvt_pk_bf16(a[0], a[1]); w.y = cvt_pk_bf16(a[2], a[3]); w.z = cvt_pk_bf16(b[0], b[1]); w.w = cvt_pk_bf16(b[2], b[3]); return w; }

struct EpiProj {
    static constexpr bool PERM = true, PRE = false, CHAIN = false;
    bf16* F; bf16* SEC; bf16* GATES; const float* bgate;
    __device__ __forceinline__ void operator()(const AccT& acc, const Unit& u, int wr, int wc, int fr, int fq) const {
        const int pn = u.pn; bf16* base; int ldc, colt, mode;
        if (pn < 4) { base = F; ldc = 1024; colt = pn * 256; mode = 0; }
        else if (pn < 16) { const int s = (pn - 4) >> 1; base = SEC + (size_t)s * (SEC_STRIDE / 2); ldc = 512; colt = ((pn - 4) & 1) * 256; mode = (s == 0 || s == 4) ? 1 : (s == 5 ? 3 : 0); }
        else { base = GATES; ldc = 3072; colt = (pn - 16) * 256; mode = 2; }
        const int row0 = u.pm * 256 + wr * 64 + fr, col0 = colt + wc * 32 + 8 * fq;
        f32x4 bv[2][2];
#pragma unroll
        for (int bj = 0; bj < 2; ++bj)
#pragma unroll
            for (int n = 0; n < 2; ++n) bv[bj][n] = (mode == 2) ? *(const f32x4*)(bgate + col0 + bj * 128 + 4 * n) : (f32x4){0.f, 0.f, 0.f, 0.f};
#pragma unroll
        for (int ai = 0; ai < 2; ++ai)
#pragma unroll
            for (int m = 0; m < 4; ++m) { bf16* rowp = base + (size_t)(row0 + ai * 128 + m * 16) * ldc + col0;
#pragma unroll
                for (int bj = 0; bj < 2; ++bj) { f32x4 v0 = acc[ai][bj][m][0] + bv[bj][0], v1 = acc[ai][bj][m][1] + bv[bj][1];
                    if (mode == 1) {
#pragma unroll
                        for (int j = 0; j < 4; ++j) { v0[j] = siluf_(v0[j]); v1[j] = siluf_(v1[j]); } }
                    else if (mode == 2) {
#pragma unroll
                        for (int j = 0; j < 4; ++j) { v0[j] = sigmoidf_(v0[j]); v1[j] = sigmoidf_(v1[j]); } }
                    else if (mode == 3) { v0 = v0 * 0.12751743f; v1 = v1 * 0.12751743f; }
                    *(v4u*)(rowp + bj * 128) = pack8(v0, v1); } }
    }
};
struct EpiPlain {
    static constexpr bool PERM = true, PRE = false, CHAIN = false;
    bf16* O; int ldc;
    __device__ __forceinline__ void operator()(const AccT& acc, const Unit& u, int wr, int wc, int fr, int fq) const {
        const int row0 = u.pm * 256 + wr * 64 + fr, col0 = u.pn * 256 + wc * 32 + 8 * fq;
#pragma unroll
        for (int ai = 0; ai < 2; ++ai)
#pragma unroll
            for (int m = 0; m < 4; ++m) { bf16* rowp = O + (size_t)(row0 + ai * 128 + m * 16) * ldc + col0;
#pragma unroll
                for (int bj = 0; bj < 2; ++bj) *(v4u*)(rowp + bj * 128) = pack8(acc[ai][bj][m][0], acc[ai][bj][m][1]); }
    }
};
struct EpiMix {
    static constexpr bool PERM = true, PRE = false, CHAIN = true;
    bf16* M; const bf16* gates; const float* bias;
    static __device__ __forceinline__ float rt(float n, float d) { return fmaxf(n, 1e-7f) * __builtin_amdgcn_rcpf(fmaxf(d, 1e-7f)); }
    __device__ __forceinline__ bool keep(const Unit& u) const { return (u.pn >> 2) < 2; }
    __device__ __forceinline__ void operator()(AccT& acc, const Unit& u, int wr, int wc, int fr, int fq) const {
        const int s = u.pn >> 2, row0 = (u.pm & 127) * 256 + wr * 64 + fr, col0 = (u.pn & 3) * 256 + wc * 32 + 8 * fq;
        if (s < 2) {
#pragma unroll
            for (int bj = 0; bj < 2; ++bj) {
                f32x4 b0 = (f32x4){0.f, 0.f, 0.f, 0.f}, b1 = b0;
                if (s == 0) { b0 = *(const f32x4*)(bias + col0 + bj * 128); b1 = *(const f32x4*)(bias + col0 + bj * 128 + 4); }
#pragma unroll
                for (int ai = 0; ai < 2; ++ai)
#pragma unroll
                    for (int m = 0; m < 4; ++m) { const bf16* gp = gates + (size_t)(row0 + ai * 128 + m * 16) * 3072 + s * 1024 + col0 + bj * 128;
                        const v4u gn = *(const v4u*)gp, gd = *(const v4u*)(gp + 1024);
                        f32x4 r0, r1;
                        r0[0] = rt(bflo(gn.x), bflo(gd.x)); r0[1] = rt(bfhi(gn.x), bfhi(gd.x)); r0[2] = rt(bflo(gn.y), bflo(gd.y)); r0[3] = rt(bfhi(gn.y), bfhi(gd.y));
                        r1[0] = rt(bflo(gn.z), bflo(gd.z)); r1[1] = rt(bfhi(gn.z), bfhi(gd.z)); r1[2] = rt(bflo(gn.w), bflo(gd.w)); r1[3] = rt(bfhi(gn.w), bfhi(gd.w));
                        acc[ai][bj][m][0] = (acc[ai][bj][m][0] + b0) * r0; acc[ai][bj][m][1] = (acc[ai][bj][m][1] + b1) * r1;
                        asm volatile("" ::: "memory"); }
            }
        } else {
#pragma unroll
            for (int ai = 0; ai < 2; ++ai)
#pragma unroll
                for (int m = 0; m < 4; ++m) { const size_t row = (size_t)(row0 + ai * 128 + m * 16);
#pragma unroll
                    for (int bj = 0; bj < 2; ++bj) { const v4u gw = *(const v4u*)(gates + row * 3072 + 2048 + col0 + bj * 128);
                        const f32x4 v0 = acc[ai][bj][m][0], v1 = acc[ai][bj][m][1]; f32x4 o0, o1;
                        o0[0] = fmaxf(bflo(gw.x), 1e-7f) * v0[0]; o0[1] = fmaxf(bfhi(gw.x), 1e-7f) * v0[1]; o0[2] = fmaxf(bflo(gw.y), 1e-7f) * v0[2]; o0[3] = fmaxf(bfhi(gw.y), 1e-7f) * v0[3];
                        o1[0] = fmaxf(bflo(gw.z), 1e-7f) * v1[0]; o1[1] = fmaxf(bfhi(gw.z), 1e-7f) * v1[1]; o1[2] = fmaxf(bflo(gw.w), 1e-7f) * v1[2]; o1[3] = fmaxf(bfhi(gw.w), 1e-7f) * v1[3];
                        *(v4u*)(M + row * 1024 + col0 + bj * 128) = pack8(o0, o1); } }
        }
    }
};
struct ChainOrder {
    pg8::StaticOrder S;
    __device__ bool next(int i, Unit& u) const { const int ti = i / 3, s = i - 3 * ti; if (!S.next(ti, u)) return false; u.pm += 128 * s; u.pn += 4 * s; return true; }
};
struct EpiResid {
    static constexpr bool PERM = true, PRE = false, CHAIN = false;
    bf16* O; const bf16* R;
    __device__ __forceinline__ void operator()(const AccT& acc, const Unit& u, int wr, int wc, int fr, int fq) const {
        const int row0 = u.pm * 256 + wr * 64 + fr, col0 = u.pn * 256 + wc * 32 + 8 * fq;
#pragma unroll
        for (int ai = 0; ai < 2; ++ai)
#pragma unroll
            for (int m = 0; m < 4; ++m) { const size_t off = (size_t)(row0 + ai * 128 + m * 16) * 1024 + col0;
#pragma unroll
                for (int bj = 0; bj < 2; ++bj) { const v4u rw = *(const v4u*)(R + off + bj * 128);
                    f32x4 o0 = acc[ai][bj][m][0], o1 = acc[ai][bj][m][1];
                    o0[0] += ALPHA * bflo(rw.x); o0[1] += ALPHA * bfhi(rw.x); o0[2] += ALPHA * bflo(rw.y); o0[3] += ALPHA * bfhi(rw.y);
                    o1[0] += ALPHA * bflo(rw.z); o1[1] += ALPHA * bfhi(rw.z); o1[2] += ALPHA * bflo(rw.w); o1[3] += ALPHA * bfhi(rw.w);
                    *(v4u*)(O + off + bj * 128) = pack8(o0, o1); } }
    }
};
struct EpiRouterShared {
    static constexpr bool PERM = true, PRE = false, CHAIN = false;
    float* L; bf16* HS;
    __device__ __forceinline__ void operator()(const AccT& acc, const Unit& u, int wr, int wc, int fr, int fq) const {
        const int row0 = u.pm * 256 + wr * 64 + fr, cl = wc * 32 + 8 * fq;
        if (u.pn == 0) {
#pragma unroll
            for (int ai = 0; ai < 2; ++ai)
#pragma unroll
                for (int m = 0; m < 4; ++m) { float* rowp = L + (size_t)(row0 + ai * 128 + m * 16) * 256 + cl;
#pragma unroll
                    for (int bj = 0; bj < 2; ++bj)
#pragma unroll
                        for (int n = 0; n < 2; ++n) *(f32x4*)(rowp + bj * 128 + 4 * n) = acc[ai][bj][m][n]; }
        } else {
            const int colt = (u.pn - 1) * 128;
#pragma unroll
            for (int ai = 0; ai < 2; ++ai)
#pragma unroll
                for (int m = 0; m < 4; ++m) { bf16* rowp = HS + (size_t)(row0 + ai * 128 + m * 16) * 256 + colt + cl;
                    f32x4 h0, h1;
#pragma unroll
                    for (int j = 0; j < 4; ++j) { h0[j] = siluf_(acc[ai][0][m][0][j]) * acc[ai][1][m][0][j]; h1[j] = siluf_(acc[ai][0][m][1][j]) * acc[ai][1][m][1][j]; }
                    *(v4u*)rowp = pack8(h0, h1); }
        }
    }
};
struct EpiExpGU {
    static constexpr bool PERM = true, PRE = false, CHAIN = false;
    bf16* H;
    __device__ __forceinline__ void operator()(const AccT& acc, const Unit& u, int wr, int wc, int fr, int fq) const {
        const int row0 = u.pm * 256 + wr * 64 + fr, col0 = (u.pn & 1) * 128 + wc * 32 + 8 * fq;
#pragma unroll
        for (int ai = 0; ai < 2; ++ai)
#pragma unroll
            for (int m = 0; m < 4; ++m) { bf16* rowp = H + (size_t)(row0 + ai * 128 + m * 16) * 256 + col0;
                f32x4 h0, h1;
#pragma unroll
                for (int j = 0; j < 4; ++j) { h0[j] = siluf_(acc[ai][0][m][0][j]) * acc[ai][1][m][0][j]; h1[j] = siluf_(acc[ai][0][m][1][j]) * acc[ai][1][m][1][j]; }
                *(v4u*)rowp = pack8(h0, h1); }
    }
};
struct EpiExpDown {
    static constexpr bool PERM = true, PRE = true, CHAIN = false;
    unsigned char* Y; const v2u* rowinfo; unsigned char* trash;
    __device__ __forceinline__ void pre(const Unit& u, LAS v2u* ri, int tid) const { if (tid < 256) ri[tid] = rowinfo[(size_t)u.pm * 256 + tid]; }
    __device__ __forceinline__ void operator()(const AccT& acc, const Unit& u, int wr, int wc, int fr, int fq, const LAS v2u* ri) const {
        const int rl0 = wr * 64 + fr, col0 = (u.pn & 3) * 256 + wc * 32 + 8 * fq;
#pragma unroll
        for (int ai = 0; ai < 2; ++ai)
#pragma unroll
            for (int m = 0; m < 4; ++m) { const v2u info = ri[rl0 + ai * 128 + m * 16]; const int slot = (int)info.x; const float gt = __uint_as_float(info.y) * YSCALE;
                unsigned char* rowp = (slot >= 0 ? Y + (size_t)slot * 1024 : trash) + col0;
#pragma unroll
                for (int bj = 0; bj < 2; ++bj) { const f32x4 a = acc[ai][bj][m][0] * gt, b = acc[ai][bj][m][1] * gt; v2u w;
                    int p = __builtin_amdgcn_cvt_pk_fp8_f32(__builtin_amdgcn_fmed3f(a[0], -448.f, 448.f), __builtin_amdgcn_fmed3f(a[1], -448.f, 448.f), 0, false);
                    p = __builtin_amdgcn_cvt_pk_fp8_f32(__builtin_amdgcn_fmed3f(a[2], -448.f, 448.f), __builtin_amdgcn_fmed3f(a[3], -448.f, 448.f), p, true); w.x = (unsigned)p;
                    p = __builtin_amdgcn_cvt_pk_fp8_f32(__builtin_amdgcn_fmed3f(b[0], -448.f, 448.f), __builtin_amdgcn_fmed3f(b[1], -448.f, 448.f), 0, false);
                    p = __builtin_amdgcn_cvt_pk_fp8_f32(__builtin_amdgcn_fmed3f(b[2], -448.f, 448.f), __builtin_amdgcn_fmed3f(b[3], -448.f, 448.f), p, true); w.y = (unsigned)p;
                    *(v2u*)(rowp + bj * 128) = w; } }
    }
};

constexpr int RING_OFF = 0, RING_BYTES = 131072;
constexpr int LDSX_OFF = RING_BYTES;
constexpr int LDS_BYTES = 163840;
constexpr int LDSCTL_OFF = LDS_BYTES - 256;

struct Frame {
    LAS unsigned char* lds;
    unsigned* ctl;
    unsigned char* ws;
    int tid, lane, wave, G, bid;
    float* out;
};
__device__ __forceinline__ const float* in_ptr(int i) { const float* const* ka = (const float* const*)__builtin_amdgcn_kernarg_segment_ptr(); asm volatile("" : "+s"(ka)); return ka[i]; }
enum { I_X = 0, I_MEM, I_LNIG, I_LNIB, I_LNMG, I_LNMB, I_LBF, I_LBB, I_WIN, I_BGATE, I_HNG, I_WKV, I_WFO, I_BFO, I_WHO, I_WXO, I_WOUT, I_LN1G, I_LN1B, I_WR, I_RB, I_WEG, I_WEU, I_WED, I_WSG, I_WSU, I_WSD, I_LN2G, I_LN2B };

__device__ __forceinline__ void tr_load(const float* src0, int lds_, f32x4 (&v)[8], int lane) {
#pragma unroll
    for (int i = 0; i < 8; ++i) v[i] = *(const f32x4*)(src0 + (size_t)((lane >> 3) + 8 * i) * lds_ + 4 * (lane & 7));
}
__device__ __forceinline__ void tr_finish(const f32x4 (&v)[8], bf16* dst0, int ldd, LAS float* scr, int lane) {
#pragma unroll
    for (int i = 0; i < 8; ++i) { LAS float* d = scr + ((lane >> 3) + 8 * i) * 33 + 4 * (lane & 7); d[0] = v[i][0]; d[1] = v[i][1]; d[2] = v[i][2]; d[3] = v[i][3]; }
    LDS_WAIT(); asm volatile("" ::: "memory");
    const int c = lane & 7;
#pragma unroll
    for (int j = 0; j < 4; ++j) { const int n = (lane >> 3) + 8 * j; const LAS float* s = scr + (8 * c) * 33 + n;
        v4u o; o.x = cvt_pk_bf16(s[0 * 33], s[1 * 33]); o.y = cvt_pk_bf16(s[2 * 33], s[3 * 33]); o.z = cvt_pk_bf16(s[4 * 33], s[5 * 33]); o.w = cvt_pk_bf16(s[6 * 33], s[7 * 33]);
        *(v4u*)(dst0 + (size_t)n * ldd + 8 * c) = o; }
    LDS_WAIT(); asm volatile("" ::: "memory");
}
__device__ __forceinline__ void tr_item(const float* src0, int lds_, bf16* dst0, int ldd, LAS float* scr, int lane) {
    f32x4 v[8]; tr_load(src0, lds_, v, lane); tr_finish(v, dst0, ldd, scr, lane);
}
__device__ __forceinline__ void conv_matrix(Frame& F, const float* src, size_t mat_stride, int nmat, int K, int ldsrc, int n_lo, int ncols, bf16* dst, int rbase, int rstride, int rmul, int dld = 0, int dko = 0) {
    if (dld == 0) dld = K;
    LAS float* scr = (LAS float*)(F.lds + RING_OFF + F.wave * 16384);
    const int gw = F.bid * NWAVES + F.wave, NGW = F.G * NWAVES;
    const int nkb = K / 64, nnb = ncols / 32, per = nkb * nnb, total = per * nmat;
    for (int it = gw; it < total; it += NGW) {
        const int e = it / per, r = it - e * per, kb = r / nnb, nb = r - kb * nnb, n = nb * 32;
        const int drow = rbase + e * rstride + (n >> 7) * rmul + (n & 127);
        tr_item(src + (size_t)e * mat_stride + (size_t)(kb * 64) * ldsrc + n_lo + n, ldsrc, dst + (size_t)drow * dld + dko + kb * 64, dld, scr, F.lane);
    }
}
__device__ __forceinline__ void conv_item_d(Frame& F, int it, LAS float* scr, int lane) {
    const int e = it >> 7, r = it & 127, kb = r >> 5, n = (r & 31) * 32;
    tr_item(in_ptr(I_WED) + (size_t)e * (256 * 1024) + (size_t)(kb * 64) * 1024 + n, 1024, (bf16*)(F.ws + WS_EXPD) + (size_t)(e * 1024 + n) * 256 + kb * 64, 256, scr, lane);
}
__device__ __forceinline__ void conv_item_gu(Frame& F, int it, LAS float* scr, int lane) {
    const int up = it >> 15, e = (it & 32767) >> 7, r = it & 127, kb = r >> 3, n = (r & 7) * 32, drow = e * 512 + up * 128 + (n >> 7) * 256 + (n & 127);
    tr_item(in_ptr(up ? I_WEU : I_WEG) + (size_t)e * (1024 * 256) + (size_t)(kb * 64) * 256 + n, 256, (bf16*)(F.ws + WS_EXPGU) + (size_t)drow * 1024 + kb * 64, 1024, scr, lane);
}
__device__ __forceinline__ const float* conv_gu_src(int it) { const int up = it >> 15, e = (it & 32767) >> 7, r = it & 127, kb = r >> 3, n = (r & 7) * 32; return in_ptr(up ? I_WEU : I_WEG) + (size_t)e * (1024 * 256) + (size_t)(kb * 64) * 256 + n; }
__device__ __forceinline__ bf16* conv_gu_dst(Frame& F, int it) { const int up = it >> 15, e = (it & 32767) >> 7, r = it & 127, kb = r >> 3, n = (r & 7) * 32, drow = e * 512 + up * 128 + (n >> 7) * 256 + (n & 127); return (bf16*)(F.ws + WS_EXPGU) + (size_t)drow * 1024 + kb * 64; }
__device__ __forceinline__ void conv_slice(Frame& F, int d0, int d1, int g0, int g1) {
    int tid_ = threadIdx.x; asm volatile("" : "+v"(tid_));
    const int lane = tid_ & 63, wave = __builtin_amdgcn_readfirstlane(tid_ >> 6), gw = F.bid * NWAVES + wave, NGW = F.G * NWAVES;
    LAS float* scr = (LAS float*)(F.lds + RING_OFF + wave * 16384);
    for (int j = d0; (d1 < 0 || j < d1) && gw + j * NGW < 32768; ++j) conv_item_d(F, gw + j * NGW, scr, lane);
    for (int j = g0; (g1 < 0 || j < g1) && gw + j * NGW < 65536; ++j) conv_item_gu(F, gw + j * NGW, scr, lane);
}
__device__ __forceinline__ void gbar_arrive(const XcdBarrier& b) {
    asm volatile("s_waitcnt vmcnt(0)" ::: "memory");
    __syncthreads();
    if (threadIdx.x == 0) {
        unsigned* bar = b.bar;
        __builtin_amdgcn_s_waitcnt(0);
        unsigned nloc = b.st[0], nx = b.st[1];
        if (nloc == 0u) { xcd_barrier_complete(bar, b.x, nloc, nx); b.st[0] = nloc; b.st[1] = nx; }
        const unsigned old = xb_add(&bar[XB_XSUB(b.x)], 1u);
        const unsigned gen = old / nloc;
        if (old + 1u == (gen + 1u) * nloc) {
            __builtin_amdgcn_fence(__ATOMIC_RELEASE, "agent");
            asm volatile("s_waitcnt vmcnt(0)" ::: "memory");
            const unsigned og = xb_add(&bar[XB_TOP], 1u);
            const unsigned tg = og / nx;
            if (og + 1u == (tg + 1u) * nx) xb_add(&bar[XB_TOPGEN], 1u);
        }
    }
}
__device__ __forceinline__ void gbar_wait(const XcdBarrier& b) {
    if (threadIdx.x == 0) {
        const unsigned k = b.st[2];
        XB_SPIN(xb_ld(&b.bar[XB_TOPGEN]) <= k, b.bar);
        __builtin_amdgcn_fence(__ATOMIC_ACQUIRE, "agent");
        asm volatile("s_waitcnt vmcnt(0)" ::: "memory");
        b.st[2] = k + 1u;
    }
    __syncthreads();
}
__device__ __forceinline__ void ln_regs_bf16(f32x4 (&v)[4], const float* g, const float* b, bf16* orow, int lane) {
    float s = 0.f;
#pragma unroll
    for (int j = 0; j < 4; ++j) s += (v[j][0] + v[j][1]) + (v[j][2] + v[j][3]);
    const float mean = wave_sum(s) * (1.f / 1024.f); float s2 = 0.f;
#pragma unroll
    for (int j = 0; j < 4; ++j) { v[j] = v[j] - mean; s2 += (v[j][0] * v[j][0] + v[j][1] * v[j][1]) + (v[j][2] * v[j][2] + v[j][3] * v[j][3]); }
    const float rstd = 1.f / sqrtf(wave_sum(s2) * (1.f / 1024.f) + LN_EPS);
    v2u* o8 = (v2u*)orow + lane;
#pragma unroll
    for (int j = 0; j < 4; ++j) { const f32x4 gg = ((const f32x4*)g)[lane + 64 * j], bb = ((const f32x4*)b)[lane + 64 * j]; const f32x4 y = v[j] * rstd * gg + bb;
        v2u w; w.x = cvt_pk_bf16(y[0], y[1]); w.y = cvt_pk_bf16(y[2], y[3]); o8[64 * j] = w; }
}
__device__ __forceinline__ void ln_rows_f32(const float* X, int nrows, int m0, int step, const float* g, const float* b, bf16* O, int lane) {
    if (m0 >= nrows) return;
    asm volatile("" : "+v"(lane));
    f32x4 nx[4];
#pragma unroll
    for (int j = 0; j < 4; ++j) nx[j] = ((const f32x4*)(X + (size_t)m0 * D))[lane + 64 * j];
    for (int m = m0; m < nrows; m += step) {
        f32x4 v[4];
#pragma unroll
        for (int j = 0; j < 4; ++j) v[j] = nx[j];
        if (m + step < nrows) {
#pragma unroll
            for (int j = 0; j < 4; ++j) nx[j] = ((const f32x4*)(X + (size_t)(m + step) * D))[lane + 64 * j]; }
        ln_regs_bf16(v, g, b, O + (size_t)m * D, lane);
    }
}
__device__ __forceinline__ void ln_rows_bf16(const bf16* X, int nrows, int m0, int step, const float* g, const float* b, bf16* O, int lane) {
    if (m0 >= nrows) return;
    asm volatile("" : "+v"(lane));
    v2u nx[4];
#pragma unroll
    for (int j = 0; j < 4; ++j) nx[j] = ((const v2u*)(X + (size_t)m0 * D))[lane + 64 * j];
    for (int m = m0; m < nrows; m += step) {
        f32x4 v[4];
#pragma unroll
        for (int j = 0; j < 4; ++j) { v[j][0] = bflo(nx[j].x); v[j][1] = bfhi(nx[j].x); v[j][2] = bflo(nx[j].y); v[j][3] = bfhi(nx[j].y); }
        if (m + step < nrows) {
#pragma unroll
            for (int j = 0; j < 4; ++j) nx[j] = ((const v2u*)(X + (size_t)(m + step) * D))[lane + 64 * j]; }
        ln_regs_bf16(v, g, b, O + (size_t)m * D, lane);
    }
}
__device__ __forceinline__ void p0_prologue(Frame& F) {
    const int gw = F.bid * NWAVES + F.wave, NGW = F.G * NWAVES;
    unsigned char* ws = F.ws;
    {
        LAS float* scr = (LAS float*)(F.lds + RING_OFF + F.wave * 16384);
        for (int it = gw; it < 3584; it += NGW) {
            int r = it, mi, K, ld, nlo, ncols, rbase, rmul; size_t doff;
            if (r < 3072) { mi = I_WIN; K = 1024; ld = 6656; nlo = 512; ncols = 6144; doff = WS_WIN; rbase = 1024; rmul = 128; }
            else { r -= 3072; mi = I_WKV; K = 1024; ld = 1024; nlo = 0; ncols = 1024; doff = WS_WKV; rbase = 0; rmul = 128; }
            const int nnb = ncols / 32, kb = r / nnb, nb = r - kb * nnb, n = nb * 32, drow = rbase + (n >> 7) * rmul + (n & 127);
            tr_item(in_ptr(mi) + (size_t)(kb * 64) * ld + nlo + n, ld, (bf16*)(ws + doff) + (size_t)drow * K + kb * 64, K, scr, F.lane);
        }
    }
    {
        LAS float* ct = (LAS float*)(F.lds + LDSX_OFF);
        if (F.tid < 128) { float sn, cs; __sincosf(6.283185307179586f * (float)F.tid / 128.f, &sn, &cs); ct[F.tid] = cs; ct[128 + F.tid] = sn; }
        __syncthreads();
        const float* win = in_ptr(I_WIN); bf16* wt = (bf16*)(ws + WS_WIN);
        LAS float* wscr = (LAS float*)(F.lds + RING_OFF + F.wave * 16384);
        for (int it = gw; it < 1024 * 4; it += NGW) {
            const int k = it >> 2, g = it & 3;
            const f32x2 w2 = *(const f32x2*)(win + (size_t)k * 6656 + g * 128 + 2 * F.lane);
            wscr[2 * F.lane] = w2[0]; wscr[2 * F.lane + 1] = w2[1];
            LDS_WAIT(); asm volatile("" ::: "memory");
            float ac0 = 0.f, as0 = 0.f, ac1 = 0.f, as1 = 0.f;
#pragma unroll 8
            for (int c = 0; c < 128; ++c) { const float wv = wscr[c]; const int a0 = (F.lane * c) & 127, a1 = ((F.lane + 64) * c) & 127;
                ac0 += wv * ct[a0]; as0 += wv * ct[128 + a0]; ac1 += wv * ct[a1]; as1 += wv * ct[128 + a1]; }
            wt[(size_t)(g * 128 + F.lane) * 1024 + k] = f2bf(ac0); wt[(size_t)(512 + g * 128 + F.lane) * 1024 + k] = f2bf(as0);
            wt[(size_t)(g * 128 + 64 + F.lane) * 1024 + k] = f2bf(ac1); wt[(size_t)(512 + g * 128 + 64 + F.lane) * 1024 + k] = f2bf(as1);
            LDS_WAIT(); asm volatile("" ::: "memory");
        }
    }
    ln_rows_f32(in_ptr(I_X), T, gw, NGW, in_ptr(I_LNIG), in_ptr(I_LNIB), (bf16*)(ws + WS_H0), F.lane);
    ln_rows_f32(in_ptr(I_MEM), NB * MEM, gw, NGW, in_ptr(I_LNMG), in_ptr(I_LNMB), (bf16*)(ws + WS_MEMN), F.lane);
}
__device__ __forceinline__ void p0_late(Frame& F) {
    int tid_ = threadIdx.x; asm volatile("" : "+v"(tid_));
    const int lane = tid_ & 63, wave = __builtin_amdgcn_readfirstlane(tid_ >> 6), gw = F.bid * NWAVES + wave, NGW = F.G * NWAVES;
    unsigned char* ws = F.ws;
    LAS float* scr = (LAS float*)(F.lds + RING_OFF + wave * 16384);
    for (int it = gw; it < 1792; it += NGW) {
        int r = it, mi, K, ld, ncols, rbase, rmul; size_t doff;
        if (r < 256) { mi = I_WFO; K = 512; ld = 1024; ncols = 1024; doff = WS_WBR; rbase = 0; rmul = 128; }
        else if ((r -= 256) < 256) { mi = I_WHO; K = 512; ld = 1024; ncols = 1024; doff = WS_WBR; rbase = 1024; rmul = 128; }
        else if ((r -= 256) < 256) { mi = I_WXO; K = 512; ld = 1024; ncols = 1024; doff = WS_WBR; rbase = 2048; rmul = 128; }
        else if ((r -= 256) < 512) { mi = I_WOUT; K = 1024; ld = 1024; ncols = 1024; doff = WS_WOUT; rbase = 0; rmul = 128; }
        else if ((r -= 512) < 128) { mi = I_WR; K = 1024; ld = 256; ncols = 256; doff = WS_WRS; rbase = 0; rmul = 128; }
        else if ((r -= 128) < 128) { mi = I_WSG; K = 1024; ld = 256; ncols = 256; doff = WS_WRS; rbase = 256; rmul = 256; }
        else if ((r -= 128) < 128) { mi = I_WSU; K = 1024; ld = 256; ncols = 256; doff = WS_WRS; rbase = 384; rmul = 256; }
        else { r -= 128; mi = I_WSD; K = 256; ld = 1024; ncols = 1024; doff = WS_WSD; rbase = 0; rmul = 128; }
        const int nnb = ncols / 32, kb = r / nnb, nb = r - kb * nnb, n = nb * 32, drow = rbase + (n >> 7) * rmul + (n & 127);
        tr_item(in_ptr(mi) + (size_t)(kb * 64) * ld + n, ld, (bf16*)(ws + doff) + (size_t)drow * K + kb * 64, K, scr, lane);
    }
    {
        bf16* a1 = (bf16*)(ws + WS_A1);
        for (int i = F.bid * NTHR + tid_; i < 128 * 128; i += F.G * NTHR) {
            const int m = i >> 7, kk = i & 127, po = m >> 6, k1 = m & 63, pi = kk >> 6, s1 = kk & 63;
            float sn, cs; __sincosf(6.283185307179586f * (float)((s1 * k1) & 63) / 64.f, &sn, &cs);
            const float v = (po == pi) ? cs : (po == 0 ? -sn : sn);
            a1[i] = f2bf(v * 0.125f);
        }
        bf16* a3 = (bf16*)(ws + WS_A3);
        for (int i = F.bid * NTHR + tid_; i < 64 * 128 * 256; i += F.G * NTHR) {
            const int k1 = i >> 15, k2 = (i >> 8) & 127, kk = i & 255, s2 = kk >> 1, part = kk & 1, k = k1 + 64 * k2;
            float sn, cs; __sincosf(6.283185307179586f * (float)((s2 * k) & 8191) / 8192.f, &sn, &cs);
            a3[i] = f2bf((part == 0 ? cs : -sn) * (1.f / 128.f));
        }
        }
}
__device__ __forceinline__ void p_ln1(Frame& F) {
    const int gw = F.bid * NWAVES + F.wave, NGW = F.G * NWAVES;
    ln_rows_bf16((const bf16*)(F.ws + WS_S1), T, gw, NGW, in_ptr(I_LN1G), in_ptr(I_LN1B), (bf16*)(F.ws + WS_H1), F.lane);
}
template <bool ROUTED>
__device__ __forceinline__ void p_final(Frame& F) {
    const int gw = F.bid * NWAVES + F.wave, NGW = F.G * NWAVES; int lane = F.lane; asm volatile("" : "+v"(lane));
    const float* g = in_ptr(I_LN2G); const float* b = in_ptr(I_LN2B);
    if (gw >= T) return;
    v2u nx[4]; int ny[8][4];
#define FIN_FETCH(m_) do { const v2u* xr_ = (const v2u*)((const bf16*)(F.ws + WS_S2) + (size_t)(m_) * D) + lane; const unsigned* yb_ = (const unsigned*)(F.ws + WS_YR) + (size_t)(m_) * 8 * 256; \
        _Pragma("unroll") for (int j = 0; j < 4; ++j) nx[j] = xr_[64 * j]; \
        if (ROUTED) { _Pragma("unroll") for (int k = 0; k < 8; ++k) _Pragma("unroll") for (int j = 0; j < 4; ++j) ny[k][j] = (int)yb_[(size_t)k * 256 + lane + 64 * j]; } } while (0)
    FIN_FETCH(gw);
    for (int m = gw; m < T; m += NGW) {
        f32x4 v[4], ya[4];
#pragma unroll
        for (int j = 0; j < 4; ++j) { v[j][0] = bflo(nx[j].x); v[j][1] = bfhi(nx[j].x); v[j][2] = bflo(nx[j].y); v[j][3] = bfhi(nx[j].y); ya[j] = (f32x4){0.f, 0.f, 0.f, 0.f}; }
        if (ROUTED) {
#pragma unroll
            for (int k = 0; k < 8; ++k)
#pragma unroll
                for (int j = 0; j < 4; ++j) { const int w = ny[k][j];
                    ya[j][0] += __builtin_amdgcn_cvt_f32_fp8(w, 0); ya[j][1] += __builtin_amdgcn_cvt_f32_fp8(w, 1); ya[j][2] += __builtin_amdgcn_cvt_f32_fp8(w, 2); ya[j][3] += __builtin_amdgcn_cvt_f32_fp8(w, 3); }
#pragma unroll
            for (int j = 0; j < 4; ++j) v[j] = v[j] + ya[j] * (1.0f / YSCALE);
        }
        if (m + NGW < T) FIN_FETCH(m + NGW);
        float s = 0.f;
#pragma unroll
        for (int j = 0; j < 4; ++j) s += (v[j][0] + v[j][1]) + (v[j][2] + v[j][3]);
        const float mean = wave_sum(s) * (1.f / 1024.f); float s2 = 0.f;
#pragma unroll
        for (int j = 0; j < 4; ++j) { v[j] = v[j] - mean; s2 += (v[j][0] * v[j][0] + v[j][1] * v[j][1]) + (v[j][2] * v[j][2] + v[j][3] * v[j][3]); }
        const float rstd = 1.f / sqrtf(wave_sum(s2) * (1.f / 1024.f) + LN_EPS);
        f32x4* o = (f32x4*)(F.out + (size_t)m * D) + lane;
#pragma unroll
        for (int j = 0; j < 4; ++j) { const f32x4 gg = ((const f32x4*)g)[lane + 64 * j], bb = ((const f32x4*)b)[lane + 64 * j]; o[64 * j] = v[j] * rstd * gg + bb; }
    }
#undef FIN_FETCH
}


__device__ __forceinline__ void p_proj(Frame& F) {
    pg8::Gemm g{(const bf16*)(F.ws + WS_H0), (const bf16*)(F.ws + WS_WIN), 1024};
    pg8::StaticOrder S; S.init(T, NPROJ, F.G, F.bid);
    EpiProj E{(bf16*)(F.ws + WS_F), (bf16*)(F.ws + WS_Q), (bf16*)(F.ws + WS_GATES), in_ptr(I_BGATE)};
    pg8::gemm_phase<EpiProj, pg8::StaticOrder, false>(F.lds + RING_OFF, g, S, E, nullptr);
}
__device__ __forceinline__ void p_kv(Frame& F) {
    pg8::Gemm g{(const bf16*)(F.ws + WS_MEMN), (const bf16*)(F.ws + WS_WKV), 1024};
    pg8::StaticOrder S; S.init(NB * MEM, 1024, F.G, F.bid);
    EpiPlain E{(bf16*)(F.ws + WS_KV), 1024};
    pg8::gemm_phase<EpiPlain, pg8::StaticOrder, false>(F.lds + RING_OFF, g, S, E, nullptr);
}
__device__ __forceinline__ void p_branch(Frame& F) {
    pg8::Gemm g{(const bf16*)(F.ws + WS_MIX), (const bf16*)(F.ws + WS_WBR), 512};
    ChainOrder S; S.S.init(T, 1024, F.G, F.bid);
    EpiMix E{(bf16*)(F.ws + WS_MERGED), (const bf16*)(F.ws + WS_GATES), in_ptr(I_BFO)};
    pg8::gemm_phase<EpiMix, ChainOrder, false>(F.lds + RING_OFF, g, S, E, nullptr);
}
__device__ __forceinline__ void p_wout(Frame& F) {
    pg8::Gemm g{(const bf16*)(F.ws + WS_MERGED), (const bf16*)(F.ws + WS_WOUT), 1024};
    pg8::StaticOrder S; S.init(T, 1024, F.G, F.bid);
    EpiResid E{(bf16*)(F.ws + WS_S1), (const bf16*)(F.ws + WS_H0)};
    pg8::gemm_phase<EpiResid, pg8::StaticOrder, false>(F.lds + RING_OFF, g, S, E, nullptr);
}
__device__ __forceinline__ void p_router_shared(Frame& F) {
    pg8::Gemm g{(const bf16*)(F.ws + WS_H1), (const bf16*)(F.ws + WS_WRS), 1024};
    pg8::StaticOrder S; S.init(T, 768, F.G, F.bid);
    EpiRouterShared E{(float*)(F.ws + WS_LOGIT), (bf16*)(F.ws + WS_HS)};
    pg8::gemm_phase<EpiRouterShared, pg8::StaticOrder, false>(F.lds + RING_OFF, g, S, E, nullptr);
}
__device__ __forceinline__ void p_shared_down(Frame& F) {
    pg8::Gemm g{(const bf16*)(F.ws + WS_HS), (const bf16*)(F.ws + WS_WSD), 256};
    pg8::StaticOrder S; S.init(T, 1024, F.G, F.bid);
    EpiResid E{(bf16*)(F.ws + WS_S2), (const bf16*)(F.ws + WS_H1)};
    pg8::gemm_phase<EpiResid, pg8::StaticOrder, false>(F.lds + RING_OFF, g, S, E, nullptr);
}

constexpr int XA_PITCH = 136;
__device__ __forceinline__ void p_xattn(Frame& F) {
    LAS bf16* Ks = (LAS bf16*)(F.lds); LAS bf16* Vs = Ks + 256 * XA_PITCH;
    const bf16* KV = (const bf16*)(F.ws + WS_KV); const bf16* XQ = (const bf16*)(F.ws + WS_Q + 5 * SEC_STRIDE); bf16* XO = (bf16*)(F.ws + WS_MIX) + (size_t)2 * T * 512;
    const int lane = F.lane, r = lane & 15, q = lane >> 4, qp = (lane & 15) >> 2, pp = lane & 3;
    int cur_bh = -1;
    for (int u = F.bid; u < 512; u += F.G) {
        const int bh = u & 15, tile = u >> 4, b = bh >> 2, h = bh & 3;
        if (bh != cur_bh) {
            __syncthreads();
            for (int c = F.tid; c < 256 * 16; c += NTHR) { const int key = c >> 4, ch = c & 15;
                const v4u kv = *(const v4u*)(KV + (size_t)(b * 256 + key) * 1024 + h * 128 + ch * 8);
                const v4u vv = *(const v4u*)(KV + (size_t)(b * 256 + key) * 1024 + 512 + h * 128 + ch * 8);
                *(LAS v4u*)(Ks + key * XA_PITCH + ch * 8) = kv; *(LAS v4u*)(Vs + key * XA_PITCH + ch * 8) = vv; }
            __syncthreads();
            cur_bh = bh;
        }
        const int t0 = b * SEQ + tile * 256 + F.wave * 32;
#pragma unroll 1
        for (int mq = 0; mq < 2; ++mq) {
            const bf16* qrow = XQ + (size_t)(t0 + 16 * mq + r) * 512 + h * 128 + 8 * q;
            bf16x8 qf[4];
#pragma unroll
            for (int ks = 0; ks < 4; ++ks) qf[ks] = *(const bf16x8*)(qrow + 32 * ks);
            f32x4 sc[16];
#pragma unroll
            for (int nk = 0; nk < 16; ++nk) { sc[nk] = (f32x4){0.f, 0.f, 0.f, 0.f};
#pragma unroll
                for (int ks = 0; ks < 4; ++ks) { const bf16x8 kf = *(const LAS bf16x8*)(Ks + (16 * nk + r) * XA_PITCH + 32 * ks + 8 * q);
                    sc[nk] = __builtin_amdgcn_mfma_f32_16x16x32_bf16(kf, qf[ks], sc[nk], 0, 0, 0); } }
            float mx = -3.0e38f;
#pragma unroll
            for (int nk = 0; nk < 16; ++nk) mx = fmaxf(mx, fmaxf(fmaxf(sc[nk][0], sc[nk][1]), fmaxf(sc[nk][2], sc[nk][3])));
            mx = fmaxf(mx, __shfl_xor(mx, 16)); mx = fmaxf(mx, __shfl_xor(mx, 32));
            float l = 0.f;
#pragma unroll
            for (int nk = 0; nk < 16; ++nk) {
#pragma unroll
                for (int j = 0; j < 4; ++j) { sc[nk][j] = __builtin_amdgcn_exp2f(sc[nk][j] - mx); l += sc[nk][j]; } }
            l += __shfl_xor(l, 16); l += __shfl_xor(l, 32);
            const float inv = 1.0f / l;
            bf16x8 pf[8];
#pragma unroll
            for (int s = 0; s < 8; ++s) { v4u w; w.x = cvt_pk_bf16(sc[2 * s][0], sc[2 * s][1]); w.y = cvt_pk_bf16(sc[2 * s][2], sc[2 * s][3]);
                w.z = cvt_pk_bf16(sc[2 * s + 1][0], sc[2 * s + 1][1]); w.w = cvt_pk_bf16(sc[2 * s + 1][2], sc[2 * s + 1][3]); pf[s] = __builtin_bit_cast(bf16x8, w); }
            bf16* orow = XO + (size_t)(t0 + 16 * mq + r) * 512 + h * 128 + 4 * q;
#pragma unroll
            for (int nd = 0; nd < 8; ++nd) { f32x4 o = (f32x4){0.f, 0.f, 0.f, 0.f};
#pragma unroll
                for (int s = 0; s < 8; ++s) {
                    const s16x4 v0 = __builtin_amdgcn_ds_read_tr16_b64_v4i16((LAS s16x4*)(Vs + (32 * s + 4 * q + qp) * XA_PITCH + 16 * nd + 4 * pp));
                    const s16x4 v1 = __builtin_amdgcn_ds_read_tr16_b64_v4i16((LAS s16x4*)(Vs + (32 * s + 16 + 4 * q + qp) * XA_PITCH + 16 * nd + 4 * pp));
                    const bf16x8 vf = {v0[0], v0[1], v0[2], v0[3], v1[0], v1[1], v1[2], v1[3]};
                    o = __builtin_amdgcn_mfma_f32_16x16x32_bf16(vf, pf[s], o, 0, 0, 0); }
                o = o * inv;
                v2u w; w.x = cvt_pk_bf16(o[0], o[1]); w.y = cvt_pk_bf16(o[2], o[3]); *(v2u*)(orow + 16 * nd) = w; }
        }
    }
    __syncthreads();
}

constexpr int RT_GU0 = 16, RT_GU1 = 32;
__device__ __forceinline__ unsigned fkey(float x) { const unsigned b = __float_as_uint(x); return (b & 0x80000000u) ? ~b : (b | 0x80000000u); }
__device__ __forceinline__ int popc64(unsigned long long m) { return __builtin_popcountll(m); }
__device__ __forceinline__ void p_routing(Frame& F) {
    const int gw = F.bid * NWAVES + F.wave, NGW = F.G * NWAVES, lane = F.lane;
    const float* L = (const float*)(F.ws + WS_LOGIT);
    int* eidx = (int*)(F.ws + WS_ROUTE + RT_EIDX); float* wgt = (float*)(F.ws + WS_ROUTE + RT_WGT); int* pos = (int*)(F.ws + WS_ROUTE + RT_POS);
    unsigned* cnt = F.ctl + CW_CNT;
    const f32x4 rb = ((const f32x4*)in_ptr(I_RB))[lane];
    const float NEG = -__builtin_inff();
    const unsigned long long below = (lane == 0) ? 0ull : (~0ull >> (64 - lane));
    LAS int* le = (LAS int*)(F.lds + F.wave * 16384 + 12288); LAS float* lw = (LAS float*)(F.lds + F.wave * 16384 + 12288 + 256);
    LAS float* scr = (LAS float*)(F.lds + F.wave * 16384);
    int cj = RT_GU0;
    f32x4 lgn = ((const f32x4*)(L + (size_t)gw * 256))[lane];
    for (int base = gw; base < T; base += 8 * NGW) {
#pragma unroll 1
      for (int jt = 0; jt < 8; ++jt) {
        const int t = base + jt * NGW; if (t >= T) break;
        const int cit = gw + cj * NGW; const bool conv = (cj < RT_GU1) && (cit < 65536); ++cj;
        f32x4 cv[8];
        if (conv) tr_load(conv_gu_src(cit), 256, cv, lane);
        const f32x4 lg = lgn;
        if (t + NGW < T) lgn = ((const f32x4*)(L + (size_t)(t + NGW) * 256))[lane];
        const float a0 = sigmoidf_(lg[0]), a1 = sigmoidf_(lg[1]), a2 = sigmoidf_(lg[2]), a3 = sigmoidf_(lg[3]);
        float s0 = a0 + rb[0], s1 = a1 + rb[1], s2 = a2 + rb[2], s3 = a3 + rb[3];
        float m1 = fmaxf(s0, s1), m2 = fminf(s0, s1);
        { const float n1 = fmaxf(m1, s2), n2 = fmaxf(fminf(m1, s2), m2); m1 = n1; m2 = n2; }
        { const float n1 = fmaxf(m1, s3), n2 = fmaxf(fminf(m1, s3), m2); m1 = n1; m2 = n2; }
#pragma unroll
        for (int o = 1; o < 8; o <<= 1) { const float p1 = __shfl_xor(m1, o), p2 = __shfl_xor(m2, o); const float n1 = fmaxf(m1, p1), n2 = fmaxf(fminf(m1, p1), fmaxf(m2, p2)); m1 = n1; m2 = n2; }
        const float gs = m1 + m2; const int grp = lane >> 3; int rank = 0;
#pragma unroll
        for (int g2 = 0; g2 < 8; ++g2) { const float o = __uint_as_float((unsigned)__builtin_amdgcn_readlane((int)__float_as_uint(gs), g2 * 8)); rank += (o > gs || (o == gs && g2 < grp)) ? 1 : 0; }
        if (rank >= 4) { s0 = NEG; s1 = NEG; s2 = NEG; s3 = NEG; }
        const unsigned k0 = fkey(s0), k1 = fkey(s1), k2 = fkey(s2), k3 = fkey(s3);
        unsigned Tk = 0u;
#pragma unroll 1
        for (int bit = 31; bit >= 0; --bit) { const unsigned cand = Tk | (1u << bit);
            const int c = popc64(__ballot(k0 >= cand)) + popc64(__ballot(k1 >= cand)) + popc64(__ballot(k2 >= cand)) + popc64(__ballot(k3 >= cand));
            if (c >= 8) Tk = cand; }
        const unsigned long long g0 = __ballot(k0 > Tk), g1 = __ballot(k1 > Tk), g2b = __ballot(k2 > Tk), g3 = __ballot(k3 > Tk);
        const unsigned long long e0 = __ballot(k0 == Tk), e1 = __ballot(k1 == Tk), e2 = __ballot(k2 == Tk), e3 = __ballot(k3 == Tk);
        const int need = 8 - (popc64(g0) + popc64(g1) + popc64(g2b) + popc64(g3));
        const int r0 = popc64(e0 & below), r1 = popc64(e0) + popc64(e1 & below), r2 = popc64(e0) + popc64(e1) + popc64(e2 & below), r3 = popc64(e0) + popc64(e1) + popc64(e2) + popc64(e3 & below);
        const bool c0 = (k0 > Tk) || (k0 == Tk && r0 < need), c1 = (k1 > Tk) || (k1 == Tk && r1 < need), c2 = (k2 > Tk) || (k2 == Tk && r2 < need), c3 = (k3 > Tk) || (k3 == Tk && r3 < need);
        const unsigned long long b0 = __ballot(c0), b1 = __ballot(c1), b2 = __ballot(c2), b3 = __ballot(c3);
        float asum = (c0 ? a0 : 0.f) + (c1 ? a1 : 0.f) + (c2 ? a2 : 0.f) + (c3 ? a3 : 0.f);
        asum = wave_sum(asum);
        const float sc = 2.5f / asum;
        const int p0 = popc64(b0 & below), p1 = popc64(b0) + popc64(b1 & below), p2 = popc64(b0) + popc64(b1) + popc64(b2 & below), p3 = popc64(b0) + popc64(b1) + popc64(b2) + popc64(b3 & below);
        if (c0) { le[jt * 8 + p0] = 4 * lane; lw[jt * 8 + p0] = a0 * sc; }
        if (c1) { le[jt * 8 + p1] = 4 * lane + 1; lw[jt * 8 + p1] = a1 * sc; }
        if (c2) { le[jt * 8 + p2] = 4 * lane + 2; lw[jt * 8 + p2] = a2 * sc; }
        if (c3) { le[jt * 8 + p3] = 4 * lane + 3; lw[jt * 8 + p3] = a3 * sc; }
        if (conv) tr_finish(cv, conv_gu_dst(F, cit), 1024, scr, lane);
      }
      { const int t = base + (lane >> 3) * NGW;
        if (t < T) { const int e = le[lane]; const float wv = lw[lane];
            const unsigned p = __hip_atomic_fetch_add(cnt + e, 1u, __ATOMIC_RELAXED, __HIP_MEMORY_SCOPE_AGENT);
            const size_t o = (size_t)t * 8 + (lane & 7); eidx[o] = e; wgt[o] = wv; pos[o] = (int)p; } }
    }
    for (; cj < RT_GU1; ++cj) { const int cit = gw + cj * NGW; if (cit < 65536) tr_item(conv_gu_src(cit), 256, conv_gu_dst(F, cit), 1024, scr, lane); }
}
__device__ __forceinline__ int build_expert_tables(Frame& F, LAS unsigned short* te, LAS int* roff) {
    LAS int* tmp = (LAS int*)(F.lds + LDSX_OFF + 6656);
    const unsigned* cnt = F.ctl + CW_CNT;
    __syncthreads();
    if (F.tid < 256) tmp[F.tid] = (int)((__hip_atomic_load(cnt + F.tid, __ATOMIC_RELAXED, __HIP_MEMORY_SCOPE_AGENT) + 255u) >> 8);
    __syncthreads();
    if (F.tid < 256) { int s = 0; for (int j = 0; j < F.tid; ++j) s += tmp[j]; const int nt = tmp[F.tid];
        for (int i = 0; i < nt; ++i) te[s + i] = (unsigned short)F.tid;
        if (roff) roff[F.tid] = s * 256;
        if (F.tid == 255) tmp[256] = s + nt; }
    __syncthreads();
    return tmp[256];
}
__device__ __forceinline__ void p_fill(Frame& F) {
    LAS unsigned short* te = (LAS unsigned short*)(F.lds + LDSX_OFF); LAS int* roff = (LAS int*)(F.lds + LDSX_OFF + 8192);
    (void)build_expert_tables(F, te, roff);
    const int* eidx = (const int*)(F.ws + WS_ROUTE + RT_EIDX); const float* wgt = (const float*)(F.ws + WS_ROUTE + RT_WGT); const int* pos = (const int*)(F.ws + WS_ROUTE + RT_POS);
    int* rowtok = (int*)(F.ws + WS_ROUTE + RT_ROWTOK); v2u* rowinfo = (v2u*)(F.ws + WS_ROUTE + RT_ROWSLOT);
    for (int i = F.bid * NTHR + F.tid; i < T * TOPK; i += F.G * NTHR) { const int e = eidx[i]; const int r = roff[e] + pos[i]; rowtok[r] = i >> 3; rowinfo[r] = (v2u){(unsigned)i, __float_as_uint(wgt[i])}; }
    const unsigned* cnt = F.ctl + CW_CNT;
    for (int e = F.bid; e < NE; e += F.G) { const int c = (int)__hip_atomic_load(cnt + e, __ATOMIC_RELAXED, __HIP_MEMORY_SCOPE_AGENT), r0 = roff[e] + c, r1 = roff[e] + ((c + 255) & ~255);
        for (int r = r0 + F.tid; r < r1; r += NTHR) { rowtok[r] = 0; rowinfo[r] = (v2u){0xffffffffu, 0u}; } }
    __syncthreads();
}
__device__ __forceinline__ void p_exp_gu(Frame& F) {
    LAS unsigned short* te = (LAS unsigned short*)(F.lds + LDSX_OFF);
    const int ntiles = build_expert_tables(F, te, nullptr);
    pg8::Gemm g{(const bf16*)(F.ws + WS_H1), (const bf16*)(F.ws + WS_EXPGU), 1024};
    pg8::ExpertOrder<2> S{ntiles * 2, F.G, F.bid, te};
    EpiExpGU E{(bf16*)(F.ws + WS_HACT)};
    pg8::gemm_phase<EpiExpGU, pg8::ExpertOrder<2>, true>(F.lds + RING_OFF, g, S, E, (const int*)(F.ws + WS_ROUTE + RT_ROWTOK));
}
__device__ __forceinline__ void p_exp_down(Frame& F) {
    LAS unsigned short* te = (LAS unsigned short*)(F.lds + LDSX_OFF);
    const int ntiles = build_expert_tables(F, te, nullptr);
    pg8::Gemm g{(const bf16*)(F.ws + WS_HACT), (const bf16*)(F.ws + WS_EXPD), 256};
    pg8::ExpertOrder<4> S{ntiles * 4, F.G, F.bid, te};
    EpiExpDown E{(unsigned char*)(F.ws + WS_YR), (const v2u*)(F.ws + WS_ROUTE + RT_ROWSLOT), (unsigned char*)(F.ws + WS_ROUTE + RT_TRASH)};
    pg8::gemm_phase<EpiExpDown, pg8::ExpertOrder<4>, false>(F.lds + RING_OFF, g, S, E, nullptr);
}

template <int STEP>
__device__ __forceinline__ void p_dft(Frame& F) {
    constexpr int K = STEP == 1 ? 128 : 256, NBC = STEP == 1 ? 256 : 128, WM = STEP == 1 ? 1 : 2, WN = 8 / WM;
    constexpr int MT = 128 / WM / 16, NT = NBC / WN / 16, PITCH = NBC + 8, CPR = NBC / 8;
    LAS bf16* Bs = (LAS bf16*)F.lds;
    const bf16* Fb = (const bf16*)(F.ws + WS_F); bf16* Yb = (bf16*)(F.ws + WS_Y); bf16* FM = (bf16*)(F.ws + WS_MIX);
    const int lane = F.lane, r = lane & 15, q = lane >> 4, qp = (lane & 15) >> 2, pp = lane & 3;
    const int wm = F.wave / WN, wn = F.wave % WN;
    bf16x8 af[K / 32][MT];
    if (STEP == 1) {
#pragma unroll
        for (int ks = 0; ks < K / 32; ++ks)
#pragma unroll
            for (int mi = 0; mi < MT; ++mi) af[ks][mi] = *(const bf16x8*)((const bf16*)(F.ws + WS_A1) + (size_t)(wm * (128 / WM) + 16 * mi + r) * K + 32 * ks + 8 * q);
    }
    for (int u = F.bid; u < 1024; u += F.G) {
        const int b = u >> 8, mid = STEP == 1 ? (u >> 1) & 127 : (u >> 2) & 63, n0 = STEP == 1 ? (u & 1) * 256 : (u & 3) * 128;
        if (STEP == 3) { const bf16* A = (const bf16*)(F.ws + WS_A3) + (size_t)mid * 128 * 256;
#pragma unroll
            for (int ks = 0; ks < K / 32; ++ks)
#pragma unroll
                for (int mi = 0; mi < MT; ++mi) af[ks][mi] = *(const bf16x8*)(A + (size_t)(wm * (128 / WM) + 16 * mi + r) * K + 32 * ks + 8 * q); }
        __syncthreads();
        for (int c = F.tid; c < K * CPR; c += NTHR) { const int kk = c / CPR, ch = c % CPR;
            const bf16* src = STEP == 1 ? Fb + (size_t)(b * SEQ + 128 * (kk & 63) + mid) * 1024 + (kk >> 6) * 512 + n0 + ch * 8
                                        : Yb + ((size_t)(b * 64 + mid) * 256 + kk) * 512 + n0 + ch * 8;
            *(LAS v4u*)(Bs + kk * PITCH + ch * 8) = *(const v4u*)src; }
        __syncthreads();
        f32x4 acc[MT][NT];
#pragma unroll
        for (int mi = 0; mi < MT; ++mi)
#pragma unroll
            for (int ni = 0; ni < NT; ++ni) acc[mi][ni] = (f32x4){0.f, 0.f, 0.f, 0.f};
#pragma unroll
        for (int ks = 0; ks < K / 32; ++ks) {
#pragma unroll
            for (int ni = 0; ni < NT; ++ni) { const int n = wn * (NBC / WN) + 16 * ni;
                const s16x4 v0 = __builtin_amdgcn_ds_read_tr16_b64_v4i16((LAS s16x4*)(Bs + (32 * ks + 8 * q + qp) * PITCH + n + 4 * pp));
                const s16x4 v1 = __builtin_amdgcn_ds_read_tr16_b64_v4i16((LAS s16x4*)(Bs + (32 * ks + 8 * q + 4 + qp) * PITCH + n + 4 * pp));
                const bf16x8 xf = {v0[0], v0[1], v0[2], v0[3], v1[0], v1[1], v1[2], v1[3]};
#pragma unroll
                for (int mi = 0; mi < MT; ++mi) acc[mi][ni] = __builtin_amdgcn_mfma_f32_16x16x32_bf16(xf, af[ks][mi], acc[mi][ni], 0, 0, 0); }
        }
#pragma unroll
        for (int mi = 0; mi < MT; ++mi) { const int m = wm * (128 / WM) + 16 * mi + r;
            bf16* drow = STEP == 1 ? Yb + ((((size_t)(b * 64 + (m & 63)) * 128 + mid) * 2 + (m >> 6)) * 512)
                                   : FM + (size_t)(b * SEQ + mid + 64 * m) * 512;
#pragma unroll
            for (int ni = 0; ni < NT; ++ni) { const int n = n0 + wn * (NBC / WN) + 16 * ni + 4 * q; const f32x4 o = acc[mi][ni];
                v2u w; w.x = cvt_pk_bf16_c(o[0], o[1]); w.y = cvt_pk_bf16_c(o[2], o[3]); *(v2u*)(drow + n) = w; } }
    }
    __syncthreads();
}

__device__ __forceinline__ v2u pack4c(const f32x4 o) { v2u w; w.x = cvt_pk_bf16_c(o[0], o[1]); w.y = cvt_pk_bf16_c(o[2], o[3]); return w; }
__device__ __forceinline__ bf16x8 tr8(const LAS bf16* p0, const LAS bf16* p1) {
    const s16x4 a = __builtin_amdgcn_ds_read_tr16_b64_v4i16((LAS s16x4*)p0), b = __builtin_amdgcn_ds_read_tr16_b64_v4i16((LAS s16x4*)p1);
    return (bf16x8){a[0], a[1], a[2], a[3], b[0], b[1], b[2], b[3]};
}
constexpr int HP = 136;
__device__ __forceinline__ void p_hgrn1(Frame& F) {
    LAS bf16* Qd = (LAS bf16*)F.lds; LAS bf16* Ki = Qd + 64 * HP; LAS bf16* Ke = Ki + 64 * HP; LAS bf16* Vs = Ke + 64 * HP; LAS bf16* Sb = Vs + 64 * HP;
    LAS float* tot = (LAS float*)(Sb + 128 * HP); LAS float* dec = tot + 16 * 128;
    const int tid = F.tid, lane = F.lane, r = lane & 15, q = lane >> 4, qp = (lane & 15) >> 2, pp = lane & 3, w = F.wave, tb = w & 3, dh = w >> 2;
    const int d4 = tid & 31, tg = tid >> 5;
    for (int u = F.bid; u < 512; u += F.G) {
        const int sg = u & 15, dir = (u >> 4) & 1, h = (u >> 5) & 3, b = u >> 7;
        const bf16* Qg = (const bf16*)(F.ws + WS_Q) + h * 128; const bf16* Vg = (const bf16*)(F.ws + WS_Q + SEC_STRIDE) + h * 128;
        const bf16* Zg = (const bf16*)(F.ws + WS_Q + (dir ? 3 : 2) * SEC_STRIDE) + h * 128;
        bf16* OL = (bf16*)(F.ws + (dir ? WS_OLB : WS_OLF)) + h * 128; bf16* QS = (bf16*)(F.ws + (dir ? WS_QSB : WS_QSF)) + h * 128;
        const float* lbp = in_ptr(dir ? I_LBB : I_LBF);
        f32x4 lb, G2 = (f32x4){0.f, 0.f, 0.f, 0.f};
        { const f32x4 p0 = *(const f32x4*)(lbp + h * 128 + 4 * d4), p1 = *(const f32x4*)(lbp + 512 + h * 128 + 4 * d4);
#pragma unroll
          for (int c = 0; c < 4; ++c) lb[c] = sigmoidf_(p0[c] - p1[c]); }
        f32x4 sS[8];
#pragma unroll
        for (int nd = 0; nd < 8; ++nd) sS[nd] = (f32x4){0.f, 0.f, 0.f, 0.f};
        __syncthreads();
        for (int i = tid; i < 128 * HP / 8; i += NTHR) ((LAS v4u*)Sb)[i] = (v4u){0u, 0u, 0u, 0u};
#pragma unroll 1
        for (int c = 0; c < 8; ++c) {
            __syncthreads();
            const int tbase = sg * SEG + 64 * c;
            f32x4 qv[4], kv[4], cs[4], run = (f32x4){0.f, 0.f, 0.f, 0.f};
            v2u zr[4], qr[4];
#pragma unroll
            for (int i = 0; i < 4; ++i) { const int pos = tbase + 4 * tg + i; const size_t tok = (size_t)(b * SEQ + (dir ? SEQ - 1 - pos : pos));
                zr[i] = *(const v2u*)(Zg + tok * 512 + 4 * d4); qr[i] = *(const v2u*)(Qg + tok * 512 + 4 * d4); }
#pragma unroll
            for (int i = 0; i < 4; ++i) { const f32x4 z = (f32x4){bflo(zr[i].x), bfhi(zr[i].x), bflo(zr[i].y), bfhi(zr[i].y)};
                qv[i] = (f32x4){bflo(qr[i].x), bfhi(qr[i].x), bflo(qr[i].y), bfhi(qr[i].y)};
#pragma unroll
                for (int e = 0; e < 4; ++e) { const float f = lb[e] + (1.0f - lb[e]) * sigmoidf_(z[e]); kv[i][e] = 1.0f - f; run[e] += __builtin_amdgcn_logf(f); }
                cs[i] = run; }
            *(LAS f32x4*)(tot + tg * 128 + 4 * d4) = run;
            for (int cc = tid; cc < 1024; cc += NTHR) { const int tp = cc >> 4, ch = cc & 15, pos = tbase + tp; const size_t tok = (size_t)(b * SEQ + (dir ? SEQ - 1 - pos : pos));
                *(LAS v4u*)(Vs + tp * HP + ch * 8) = *(const v4u*)(Vg + tok * 512 + ch * 8); }
            __syncthreads();
            f32x4 pre = (f32x4){0.f, 0.f, 0.f, 0.f}, aend = pre;
#pragma unroll
            for (int j = 0; j < 16; ++j) { const f32x4 x = *(const LAS f32x4*)(tot + j * 128 + 4 * d4); aend = aend + x; if (j < tg) pre = pre + x; }
            f32x4 eend, eG;
#pragma unroll
            for (int e = 0; e < 4; ++e) { eend[e] = __builtin_amdgcn_exp2f(aend[e]); eG[e] = __builtin_amdgcn_exp2f(G2[e]); }
#pragma unroll
            for (int i = 0; i < 4; ++i) { const int tp = 4 * tg + i, pos = tbase + tp; const size_t tok = (size_t)(b * SEQ + (dir ? SEQ - 1 - pos : pos));
                f32x4 qd, ki, ke, qs;
#pragma unroll
                for (int e = 0; e < 4; ++e) { const float ea = __builtin_amdgcn_exp2f(pre[e] + cs[i][e]), ei = __builtin_amdgcn_rcpf(ea);
                    qd[e] = qv[i][e] * ea; ki[e] = kv[i][e] * ei; ke[e] = ki[e] * eend[e]; qs[e] = qd[e] * eG[e]; }
                v2u wq, wk, we, ws2; wq.x = cvt_pk_bf16(qd[0], qd[1]); wq.y = cvt_pk_bf16(qd[2], qd[3]); wk.x = cvt_pk_bf16(ki[0], ki[1]); wk.y = cvt_pk_bf16(ki[2], ki[3]);
                we.x = cvt_pk_bf16(ke[0], ke[1]); we.y = cvt_pk_bf16(ke[2], ke[3]); ws2.x = cvt_pk_bf16(qs[0], qs[1]); ws2.y = cvt_pk_bf16(qs[2], qs[3]);
                *(LAS v2u*)(Qd + tp * HP + 4 * d4) = wq; *(LAS v2u*)(Ki + tp * HP + 4 * d4) = wk; *(LAS v2u*)(Ke + tp * HP + 4 * d4) = we;
                *(v2u*)(QS + tok * 512 + 4 * d4) = ws2; }
            if (tg == 0) *(LAS f32x4*)(dec + 4 * d4) = eend;
            G2 = G2 + aend;
            __syncthreads();
            bf16x8 qf[4];
#pragma unroll
            for (int ks = 0; ks < 4; ++ks) qf[ks] = *(const LAS bf16x8*)(Qd + (16 * tb + r) * HP + 32 * ks + 8 * q);
            f32x4 sc[4];
#pragma unroll
            for (int sb = 0; sb < 4; ++sb) { sc[sb] = (f32x4){0.f, 0.f, 0.f, 0.f};
#pragma unroll
                for (int ks = 0; ks < 4; ++ks) { const bf16x8 kf = *(const LAS bf16x8*)(Ki + (16 * sb + r) * HP + 32 * ks + 8 * q); sc[sb] = __builtin_amdgcn_mfma_f32_16x16x32_bf16(kf, qf[ks], sc[sb], 0, 0, 0); }
#pragma unroll
                for (int j = 0; j < 4; ++j) sc[sb][j] = (16 * sb + 4 * q + j > 16 * tb + r) ? 0.f : sc[sb][j]; }
            bf16x8 pf[2];
#pragma unroll
            for (int k2 = 0; k2 < 2; ++k2) { v4u wv; wv.x = cvt_pk_bf16(sc[2 * k2][0], sc[2 * k2][1]); wv.y = cvt_pk_bf16(sc[2 * k2][2], sc[2 * k2][3]);
                wv.z = cvt_pk_bf16(sc[2 * k2 + 1][0], sc[2 * k2 + 1][1]); wv.w = cvt_pk_bf16(sc[2 * k2 + 1][2], sc[2 * k2 + 1][3]); pf[k2] = __builtin_bit_cast(bf16x8, wv); }
            { const int pos = tbase + 16 * tb + r; const size_t tok = (size_t)(b * SEQ + (dir ? SEQ - 1 - pos : pos));
#pragma unroll
            for (int nd = 0; nd < 4; ++nd) { f32x4 o = (f32x4){0.f, 0.f, 0.f, 0.f}; const int cb = 64 * dh + 16 * nd + 4 * pp;
#pragma unroll
                for (int k2 = 0; k2 < 2; ++k2) o = __builtin_amdgcn_mfma_f32_16x16x32_bf16(tr8(Vs + (32 * k2 + 4 * q + qp) * HP + cb, Vs + (32 * k2 + 16 + 4 * q + qp) * HP + cb), pf[k2], o, 0, 0, 0);
#pragma unroll
                for (int ks = 0; ks < 4; ++ks) o = __builtin_amdgcn_mfma_f32_16x16x32_bf16(tr8(Sb + (32 * ks + 8 * q + qp) * HP + cb, Sb + (32 * ks + 8 * q + 4 + qp) * HP + cb), qf[ks], o, 0, 0, 0);
                *(v2u*)(OL + tok * 512 + 64 * dh + 16 * nd + 4 * q) = pack4c(o); } }
            { const float dc = dec[16 * w + r];
#pragma unroll
            for (int nd = 0; nd < 8; ++nd) { sS[nd] = sS[nd] * dc;
#pragma unroll
                for (int k2 = 0; k2 < 2; ++k2) sS[nd] = __builtin_amdgcn_mfma_f32_16x16x32_bf16(tr8(Vs + (32 * k2 + 8 * q + qp) * HP + 16 * nd + 4 * pp, Vs + (32 * k2 + 8 * q + 4 + qp) * HP + 16 * nd + 4 * pp),
                                                                                              tr8(Ke + (32 * k2 + 8 * q + qp) * HP + 16 * w + 4 * pp, Ke + (32 * k2 + 8 * q + 4 + qp) * HP + 16 * w + 4 * pp), sS[nd], 0, 0, 0); } }
            __syncthreads();
#pragma unroll
            for (int nd = 0; nd < 8; ++nd) *(LAS v2u*)(Sb + (16 * w + r) * HP + 16 * nd + 4 * q) = pack4c(sS[nd]);
        }
        float* U = (float*)(F.ws + WS_U) + (size_t)u * 16384;
#pragma unroll
        for (int nd = 0; nd < 8; ++nd) *(f32x4*)(U + (16 * w + r) * 128 + 16 * nd + 4 * q) = sS[nd];
        if (tg == 0) { f32x4 dg; dg[0] = __builtin_amdgcn_exp2f(G2[0]); dg[1] = __builtin_amdgcn_exp2f(G2[1]); dg[2] = __builtin_amdgcn_exp2f(G2[2]); dg[3] = __builtin_amdgcn_exp2f(G2[3]); *(f32x4*)((float*)(F.ws + WS_DEC) + u * 128 + 4 * d4) = dg; }
    }
    __syncthreads();
}
__device__ __forceinline__ void p_hgrn_scan(Frame& F) {
    const float* U = (const float*)(F.ws + WS_U); const float* DEC = (const float*)(F.ws + WS_DEC); bf16* SST = (bf16*)(F.ws + WS_SST);
    for (int it = F.bid * NTHR + F.tid; it < 32 * 128 * 32; it += F.G * NTHR) {
        const int cmb = it >> 12, dk = (it >> 5) & 127, dv4 = it & 31;
        f32x4 st = (f32x4){0.f, 0.f, 0.f, 0.f};
#pragma unroll 4
        for (int sg = 0; sg < NSEG; ++sg) { const size_t un = (size_t)(cmb * 16 + sg);
            v2u wv; wv.x = cvt_pk_bf16(st[0], st[1]); wv.y = cvt_pk_bf16(st[2], st[3]); *(v2u*)(SST + un * 16384 + dk * 128 + dv4 * 4) = wv;
            const float dcy = DEC[un * 128 + dk]; const f32x4 uu = *(const f32x4*)(U + un * 16384 + dk * 128 + dv4 * 4); st = st * dcy + uu; }
    }
}
__device__ __forceinline__ void p_hgrn2(Frame& F) {
    LAS bf16* Sf = (LAS bf16*)F.lds; LAS bf16* Sw = Sf + 128 * HP;
    const int lane = F.lane, r = lane & 15, q = lane >> 4, qp = (lane & 15) >> 2, pp = lane & 3;
    const bf16* SST = (const bf16*)(F.ws + WS_SST);
    for (int u = F.bid; u < 512; u += F.G) {
        const int tile = u & 31, h = (u >> 5) & 3, b = u >> 7;
        const int unf = ((b * 4 + h) * 2 + 0) * 16 + (tile >> 1), unb = ((b * 4 + h) * 2 + 1) * 16 + ((31 - tile) >> 1);
        __syncthreads();
        for (int c = F.tid; c < 128 * 16; c += NTHR) { const int dk = c >> 4, ch = c & 15;
            *(LAS v4u*)(Sf + dk * HP + ch * 8) = *(const v4u*)(SST + (size_t)unf * 16384 + dk * 128 + ch * 8);
            *(LAS v4u*)(Sw + dk * HP + ch * 8) = *(const v4u*)(SST + (size_t)unb * 16384 + dk * 128 + ch * 8); }
        __syncthreads();
        const float* ng = in_ptr(I_HNG) + h * 128;
#pragma unroll 1
        for (int mq = 0; mq < 2; ++mq) {
            const size_t tok = (size_t)(b * SEQ + tile * 256 + F.wave * 32 + 16 * mq + r);
            const bf16* qsf = (const bf16*)(F.ws + WS_QSF) + tok * 512 + h * 128 + 8 * q; const bf16* qsb = (const bf16*)(F.ws + WS_QSB) + tok * 512 + h * 128 + 8 * q;
            bf16x8 ff[4], fb[4];
#pragma unroll
            for (int ks = 0; ks < 4; ++ks) { ff[ks] = *(const bf16x8*)(qsf + 32 * ks); fb[ks] = *(const bf16x8*)(qsb + 32 * ks); }
            f32x4 o[8]; float ss = 0.f;
            const size_t rb = tok * 512 + h * 128 + 4 * q;
#pragma unroll
            for (int nd = 0; nd < 8; ++nd) { f32x4 a = (f32x4){0.f, 0.f, 0.f, 0.f}; const int cb = 16 * nd + 4 * pp;
#pragma unroll
                for (int ks = 0; ks < 4; ++ks) { a = __builtin_amdgcn_mfma_f32_16x16x32_bf16(tr8(Sf + (32 * ks + 8 * q + qp) * HP + cb, Sf + (32 * ks + 8 * q + 4 + qp) * HP + cb), ff[ks], a, 0, 0, 0);
                    a = __builtin_amdgcn_mfma_f32_16x16x32_bf16(tr8(Sw + (32 * ks + 8 * q + qp) * HP + cb, Sw + (32 * ks + 8 * q + 4 + qp) * HP + cb), fb[ks], a, 0, 0, 0); }
                const v2u lf = *(const v2u*)((const bf16*)(F.ws + WS_OLF) + rb + 16 * nd), lw = *(const v2u*)((const bf16*)(F.ws + WS_OLB) + rb + 16 * nd);
                a[0] += bflo(lf.x) + bflo(lw.x); a[1] += bfhi(lf.x) + bfhi(lw.x); a[2] += bflo(lf.y) + bflo(lw.y); a[3] += bfhi(lf.y) + bfhi(lw.y);
                ss += (a[0] * a[0] + a[1] * a[1]) + (a[2] * a[2] + a[3] * a[3]); o[nd] = a; }
            ss += __shfl_xor(ss, 16); ss += __shfl_xor(ss, 32);
            const float rs = 1.0f / sqrtf(ss * (1.0f / 128.0f) + LN_EPS);
#pragma unroll
            for (int nd = 0; nd < 8; ++nd) { const f32x4 gn = *(const f32x4*)(ng + 16 * nd + 4 * q); const v2u gw = *(const v2u*)((const bf16*)(F.ws + WS_Q + 4 * SEC_STRIDE) + rb + 16 * nd);
                f32x4 y; y[0] = o[nd][0] * rs * gn[0] * bflo(gw.x); y[1] = o[nd][1] * rs * gn[1] * bfhi(gw.x); y[2] = o[nd][2] * rs * gn[2] * bflo(gw.y); y[3] = o[nd][3] * rs * gn[3] * bfhi(gw.y);
                v2u wv; wv.x = cvt_pk_bf16(y[0], y[1]); wv.y = cvt_pk_bf16(y[2], y[3]); *(v2u*)((bf16*)(F.ws + WS_MIX) + (size_t)T * 512 + rb + 16 * nd) = wv; }
        }
    }
    __syncthreads();
}
struct Args { const float* in[29]; float* out; unsigned char* ws; };
__global__ void __launch_bounds__(NTHR, 2) fwd(Args args) {
    extern __shared__ __attribute__((aligned(16))) unsigned char lds[];
    Frame F;
    F.lds = (LAS unsigned char*)lds;
    F.tid = threadIdx.x; F.lane = F.tid & 63; F.wave = __builtin_amdgcn_readfirstlane(F.tid >> 6);
    F.G = gridDim.x; F.bid = blockIdx.x;
    F.ws = args.ws; F.ctl = (unsigned*)(args.ws + WS_CTL); F.out = args.out;
    if (F.tid < 64) ((LAS unsigned*)(F.lds + LDSCTL_OFF))[F.tid] = 0u;
    __syncthreads();
    XcdBarrier bar = xcd_barrier_post(F.ctl + CW_BAR, (volatile LAS unsigned*)(F.lds + LDSCTL_OFF + 32));
#define GRID_BAR(d0, d1, g0, g1) do { gbar_arrive(bar); conv_slice(F, d0, d1, g0, g1); gbar_wait(bar); } while (0)
#define GRID_BAR_X(extra, d0, d1, g0, g1) do { gbar_arrive(bar); extra; conv_slice(F, d0, d1, g0, g1); gbar_wait(bar); } while (0)
#ifndef DUP
#define DUP 0
#endif
#define PH(id, call) do { call; if (DUP == (id)) { __syncthreads(); call; } } while (0)
    PH(1, p0_prologue(F));
    GRID_BAR_X(p0_late(F), 0, 1, 0, 0);
    PH(2, p_proj(F));
    PH(3, p_kv(F));
    GRID_BAR(1, 4, 0, 0);
    PH(4, p_xattn(F));
    PH(5, p_dft<1>(F));
    PH(6, p_hgrn1(F));
    GRID_BAR(4, 6, 0, 0);
    PH(7, p_dft<3>(F));
    PH(8, p_hgrn_scan(F));
    GRID_BAR(6, 8, 0, 0);
    PH(9, p_hgrn2(F));
    GRID_BAR(8, 10, 0, 0);
    PH(10, p_branch(F));
    GRID_BAR(10, 12, 0, 0);
    PH(11, p_wout(F));
    GRID_BAR(12, 13, 0, 4);
    PH(12, p_ln1(F));
    conv_slice(F, 16, 16, RT_GU1, -1);
    GRID_BAR(13, 14, 4, 8);
    PH(14, p_router_shared(F));
    GRID_BAR(14, 15, 8, 12);
    p_routing(F);
    GRID_BAR(15, 16, 12, 16);
    PH(16, p_fill(F));
    PH(17, p_shared_down(F));
    GRID_BAR(16, -1, 0, 0);
    PH(18, p_exp_gu(F));
    GRID_BAR(0, 0, 0, 0);
    PH(19, p_exp_down(F));
    PH(30, GRID_BAR(0, 0, 0, 0));
    PH(20, p_final<true>(F));
}

extern "C" void kernel_launch(void* const* d_in, const int* in_sizes, int n_in, void* d_out, int out_size, void* d_ws, size_t ws_size, hipStream_t stream) {
    static int grid = 0;
    if (grid == 0) {
        int dev = 0, cus = 0, per_cu = 0;
        if (n_in != 29 || ws_size < WS_END) { fprintf(stderr, "kernel_launch: unexpected n_in %d / ws_size %zu\n", n_in, ws_size); }
        if (hipGetDevice(&dev) != hipSuccess || hipDeviceGetAttribute(&cus, hipDeviceAttributeMultiprocessorCount, dev) != hipSuccess) { grid = -1; return; }
        if (hipFuncSetAttribute((const void*)fwd, hipFuncAttributeMaxDynamicSharedMemorySize, LDS_BYTES) != hipSuccess) { grid = -1; return; }
        if (hipOccupancyMaxActiveBlocksPerMultiprocessor(&per_cu, (const void*)fwd, NTHR, LDS_BYTES) != hipSuccess || per_cu < 1) fprintf(stderr, "kernel_launch: occupancy query says %d\n", per_cu);
        (void)hipGetLastError();
        grid = cus;
    }
    if (grid < 0) return;
    (void)hipMemsetAsync((char*)d_ws + WS_CTL, 0, CTL_ZERO_BYTES, stream);
    Args a{};
    for (int i = 0; i < 29; ++i) a.in[i] = (const float*)d_in[i];
    a.out = (float*)d_out; a.ws = (unsigned char*)d_ws;
    hipLaunchKernelGGL(fwd, dim3(grid), dim3(NTHR), LDS_BYTES, stream, a);
}
```
